# Optimizing an MI355X kernel written in HIP

```python
import jax, jax.numpy as jnp
from jax import lax
import numpy as np

D_MODEL = 1024
BATCH = 1
SEQ = 16384
DEPTH = 2
DEC_BATCH = 32
DEC_SEQ = 8
PAST_LEN = 16384
PAGE_SIZE = 128

HEAD_DIM = 64
D_A = 3 * D_MODEL // 8
N_HEADS_A = D_A // HEAD_DIM
DILATED_PATTERNS = ((128, 1), (512, 4), (2048, 16))
W_MAX = 2048
ROPE_THETA = 10000.0
D_B = D_MODEL // 4
POOL_WINDOWS = (2, 4, 8, 16)
N_POOL_GROUPS = 4
POOL_GROUP = D_B // N_POOL_GROUPS
POOL_MAX = 16
D_C = D_MODEL - D_A - D_B
C_BLOCK = 64
N_BLOCKS_C = D_C // C_BLOCK
CONV_W = 4
RG_C = 8.0
D_IN = 3 * D_A + D_B + 2 * D_C
D_FF = -(-8 * D_MODEL // (3 * 256)) * 256
EPS = 1e-6

kernel_name = "hybrid_dilated_pool_rglru_decoder_step"


def rms_norm(x, g):
    xf = x.astype(jnp.float32)
    y = xf * lax.rsqrt(jnp.mean(xf * xf, axis=-1, keepdims=True) + EPS)
    return (y * g.astype(jnp.float32)).astype(x.dtype)


def rope(x, pos):
    half = HEAD_DIM // 2
    inv = jnp.power(ROPE_THETA, -2.0 * jnp.arange(half, dtype=jnp.float32) / HEAD_DIM)
    ang = pos.astype(jnp.float32)[:, None] * inv[None, :]
    cos = jnp.cos(ang)[None, :, None, :]
    sin = jnp.sin(ang)[None, :, None, :]
    x1, x2 = x[..., :half], x[..., half:]
    return jnp.concatenate([x1 * cos - x2 * sin, x2 * cos + x1 * sin], axis=-1)


def dilated_band_prompt(q, k, v, window, dilation):
    n = window // dilation
    b, s, h, dh = q.shape
    span = n * dilation
    s_pad = -(-s // span) * span
    nb = s_pad // span
    m = s_pad // dilation

    def to_blocks(t):
        t = jnp.pad(t, ((0, 0), (0, s_pad - s), (0, 0), (0, 0))).reshape(b, m, dilation, h, dh)
        return t.transpose(0, 2, 1, 3, 4).reshape(b, dilation, nb, n, h, dh)

    def with_prev(t):
        prev = jnp.pad(t, ((0, 0), (0, 0), (1, 0), (0, 0), (0, 0), (0, 0)))[:, :, :-1]
        return jnp.concatenate([prev, t], axis=3)

    qb = to_blocks(q)
    kk = with_prev(to_blocks(k))
    vv = with_prev(to_blocks(v))
    scores = jnp.einsum("brnqhd,brnkhd->brnhqk", qb, kk) * (1.0 / np.sqrt(HEAD_DIM))
    qi = jnp.arange(n)[:, None]
    ki = jnp.arange(2 * n)[None, :]
    dist = n + qi - ki
    band = (dist >= 0) & (dist <= n)
    has_key = (jnp.arange(nb) > 0)[:, None, None] | (ki >= n)[None]
    mask = band[None] & has_key
    scores = jnp.where(mask[:, None], scores, -jnp.inf)
    lse = jax.nn.logsumexp(scores, axis=-1)
    p = jnp.exp(scores - lse[..., None])
    o = jnp.einsum("brnhqk,brnkhd->brnqhd", p, vv)
    o = o.reshape(b, dilation, m, h, dh).transpose(0, 2, 1, 3, 4).reshape(b, s_pad, h, dh)[:, :s]
    lse = lse.transpose(0, 1, 2, 4, 3).reshape(b, dilation, m, h).transpose(0, 2, 1, 3).reshape(b, s_pad, h)[:, :s]
    return o, lse


def dilated_gather_sample(q, k_all, v_all, window, dilation):
    n = window // dilation
    t = q.shape[1]
    L = k_all.shape[1] - t
    idx = L + jnp.arange(t)[:, None] - dilation * jnp.arange(n + 1)[None, :]
    valid = idx >= 0
    idx = jnp.maximum(idx, 0)
    kg = k_all[:, idx]
    vg = v_all[:, idx]
    scores = jnp.einsum("bthd,btjhd->bthj", q, kg) * (1.0 / np.sqrt(HEAD_DIM))
    scores = jnp.where(valid[None, :, None, :], scores, -jnp.inf)
    lse = jax.nn.logsumexp(scores, axis=-1)
    p = jnp.exp(scores - lse[..., None])
    return jnp.einsum("bthj,btjhd->bthd", p, vg), lse


def dilated_attention(q, k, v, pos, cache_k, cache_v):
    b, t = q.shape[:2]
    qf = rope(q.astype(jnp.float32), pos)
    kf = rope(k.astype(jnp.float32), pos)
    vf = v.astype(jnp.float32)
    outs, lses = [], []
    if cache_k is None:
        for window, dilation in DILATED_PATTERNS:
            o, l = dilated_band_prompt(qf, kf, vf, window, dilation)
            outs.append(o)
            lses.append(l)
        keep = min(W_MAX, t)
        new_k = kf[:, -keep:].astype(k.dtype)
        new_v = vf[:, -keep:].astype(v.dtype)
    else:
        k_all = jnp.concatenate([cache_k.astype(jnp.float32), kf], axis=1)
        v_all = jnp.concatenate([cache_v.astype(jnp.float32), vf], axis=1)
        for window, dilation in DILATED_PATTERNS:
            o, l = dilated_gather_sample(qf, k_all, v_all, window, dilation)
            outs.append(o)
            lses.append(l)
        keep = min(W_MAX, k_all.shape[1])
        new_k = k_all[:, -keep:].astype(cache_k.dtype)
        new_v = v_all[:, -keep:].astype(cache_v.dtype)
    alpha = jax.nn.softmax(jnp.stack(lses, axis=0), axis=0)
    o = jnp.einsum("gbth,gbthd->bthd", alpha, jnp.stack(outs, axis=0))
    return o.reshape(b, t, D_A), new_k, new_v


def pool_mixer(u, pos, buf, w_map, scale):
    b, t, _ = u.shape
    full = u if buf is None else jnp.concatenate([buf.astype(u.dtype), u], axis=1)
    lp = full.shape[1] - t
    cs = jnp.pad(jnp.cumsum(full.astype(jnp.float32), axis=1), ((0, 0), (1, 0), (0, 0)))
    hi_rows = lp + 1 + jnp.arange(t)
    hi = cs[:, lp + 1:]
    means = []
    for g, w in enumerate(POOL_WINDOWS):
        sl = slice(g * POOL_GROUP, (g + 1) * POOL_GROUP)
        lo = jnp.take(cs[..., sl], jnp.maximum(hi_rows - w, 0), axis=1)
        cnt = jnp.minimum(pos + 1, w).astype(jnp.float32)[None, :, None]
        means.append((hi[..., sl] - lo) / cnt)
    pooled = jnp.concatenate(means, axis=-1) - u.astype(jnp.float32)
    y = jnp.einsum("btgc,gcd->btgd", pooled.reshape(b, t, N_POOL_GROUPS, POOL_GROUP), w_map.astype(jnp.float32))
    y = y.reshape(b, t, D_B) * scale.astype(jnp.float32)
    return y, full[:, -(POOL_MAX - 1):]


def rglru_mixer(xr, gate, conv_buf, h0, conv_w, conv_b, gate_a_w, gate_a_b, gate_x_w, gate_x_b, lru_lambda):
    b, t, _ = xr.shape
    pre = jnp.zeros((b, CONV_W - 1, D_C), xr.dtype) if conv_buf is None else conv_buf.astype(xr.dtype)
    full = jnp.concatenate([pre, xr], axis=1)
    xc = conv_b.astype(jnp.float32) + sum(
        full[:, j:j + t].astype(jnp.float32) * conv_w[j].astype(jnp.float32) for j in range(CONV_W))
    xb = xc.reshape(b, t, N_BLOCKS_C, C_BLOCK)
    r = jax.nn.sigmoid(jnp.einsum("btnc,ncd->btnd", xb, gate_a_w.astype(jnp.float32)).reshape(b, t, D_C)
                       + gate_a_b.astype(jnp.float32))
    i = jax.nn.sigmoid(jnp.einsum("btnc,ncd->btnd", xb, gate_x_w.astype(jnp.float32)).reshape(b, t, D_C)
                       + gate_x_b.astype(jnp.float32))
    log_a = RG_C * r * jax.nn.log_sigmoid(lru_lambda.astype(jnp.float32))
    a = jnp.exp(log_a)
    inp = jnp.sqrt(-jnp.expm1(2.0 * log_a)) * i * xc
    if h0 is not None:
        inp = inp.at[:, 0].add(a[:, 0] * h0.astype(jnp.float32))

    def combine(e1, e2):
        a1, b1 = e1
        a2, b2 = e2
        return a1 * a2, a2 * b1 + b2

    _, h = lax.associative_scan(combine, (a, inp), axis=1)
    y = h * jax.nn.gelu(gate.astype(jnp.float32))
    new_h = h[:, -1] if h0 is None else h[:, -1].astype(h0.dtype)
    return y, full[:, -(CONV_W - 1):], new_h


def decoder_layer(x, pos, state, norm1_g, w_in, pool_w, pool_scale, conv_w, conv_b, gate_a_w, gate_a_b,
                  gate_x_w, gate_x_b, lru_lambda, w_out, norm2_g, w_gu, w_down):
    b, t, _ = x.shape
    if state is None:
        ck = cv = pbuf = cbuf = h0 = None
    else:
        ck, cv, pbuf, cbuf, h0 = state
    hn = rms_norm(x, norm1_g)
    proj = hn @ w_in
    cuts = [D_A, 2 * D_A, 3 * D_A, 3 * D_A + D_B, 3 * D_A + D_B + D_C]
    q, k, v, u, xr, gt = jnp.split(proj, cuts, axis=-1)
    hs = (b, t, N_HEADS_A, HEAD_DIM)
    o_a, nk, nv = dilated_attention(q.reshape(hs), k.reshape(hs), v.reshape(hs), pos, ck, cv)
    o_b, npool = pool_mixer(u, pos, pbuf, pool_w, pool_scale)
    o_c, nconv, nh = rglru_mixer(xr, gt, cbuf, h0, conv_w, conv_b, gate_a_w, gate_a_b, gate_x_w, gate_x_b,
                                 lru_lambda)
    mix = jnp.concatenate([o_a, o_b, o_c], axis=-1).astype(x.dtype) @ w_out
    x = x + mix
    h2 = rms_norm(x, norm2_g)
    g_, up = jnp.split(h2 @ w_gu, 2, axis=-1)
    x = x + (jax.nn.silu(g_) * up) @ w_down
    return x, (nk, nv, npool, nconv, nh)


def setup_inputs(seed: int = 0) -> dict:
    key = jax.random.key(seed)
    ks = jax.random.split(key, 24)
    f32 = jnp.float32
    w_buf = min(W_MAX, PAST_LEN)
    nrm = lambda k, shape, s=1.0: jax.random.normal(k, shape, f32) * s
    u_lam = jax.random.uniform(ks[15], (DEPTH, D_C), f32, 0.9, 0.999)
    return {
        "x_prompt": nrm(ks[0], (BATCH, SEQ, D_MODEL)),
        "x_sample": nrm(ks[1], (DEC_BATCH, DEC_SEQ, D_MODEL)),
        "cache_win_k": nrm(ks[2], (DEPTH, DEC_BATCH, w_buf, N_HEADS_A, HEAD_DIM)),
        "cache_win_v": nrm(ks[3], (DEPTH, DEC_BATCH, w_buf, N_HEADS_A, HEAD_DIM)),
        "state_pool": nrm(ks[4], (DEPTH, DEC_BATCH, POOL_MAX - 1, D_B)),
        "state_conv": nrm(ks[5], (DEPTH, DEC_BATCH, CONV_W - 1, D_C)),
        "state_rglru": nrm(ks[6], (DEPTH, DEC_BATCH, D_C), 0.5),
        "norm1_g": 1.0 + nrm(ks[7], (DEPTH, D_MODEL), 0.02),
        "w_in": nrm(ks[8], (DEPTH, D_MODEL, D_IN), D_MODEL ** -0.5),
        "pool_w": nrm(ks[9], (DEPTH, N_POOL_GROUPS, POOL_GROUP, POOL_GROUP), POOL_GROUP ** -0.5),
        "pool_scale": 1.0 + nrm(ks[10], (DEPTH, D_B), 0.1),
        "conv_w": nrm(ks[11], (DEPTH, CONV_W, D_C), CONV_W ** -0.5),
        "conv_b": nrm(ks[12], (DEPTH, D_C), 0.01),
        "gate_a_w": nrm(ks[13], (DEPTH, N_BLOCKS_C, C_BLOCK, C_BLOCK), C_BLOCK ** -0.5),
        "gate_a_b": nrm(ks[14], (DEPTH, D_C), 0.01),
        "gate_x_w": nrm(ks[16], (DEPTH, N_BLOCKS_C, C_BLOCK, C_BLOCK), C_BLOCK ** -0.5),
        "gate_x_b": nrm(ks[17], (DEPTH, D_C), 0.01),
        "lru_lambda": jnp.log(u_lam) - jnp.log1p(-u_lam),
        "w_out": nrm(ks[18], (DEPTH, D_MODEL, D_MODEL), D_MODEL ** -0.5),
        "norm2_g": 1.0 + nrm(ks[19], (DEPTH, D_MODEL), 0.02),
        "w_gu": nrm(ks[20], (DEPTH, D_MODEL, 2 * D_FF), D_MODEL ** -0.5),
        "w_down": nrm(ks[21], (DEPTH, D_FF, D_MODEL), D_FF ** -0.5),
        "final_g": 1.0 + nrm(ks[22], (D_MODEL,), 0.02),
    }


def reference(x_prompt, x_sample, cache_win_k, cache_win_v, state_pool, state_conv, state_rglru,
              norm1_g, w_in, pool_w, pool_scale, conv_w, conv_b, gate_a_w, gate_a_b, gate_x_w, gate_x_b,
              lru_lambda, w_out, norm2_g, w_gu, w_down, final_g):
    pos_p = jnp.arange(x_prompt.shape[1], dtype=jnp.int32)
    pos_s = PAST_LEN + jnp.arange(x_sample.shape[1], dtype=jnp.int32)
    hp, hs = x_prompt, x_sample
    st_p, st_s = [], []
    for l in range(DEPTH):
        lw = (norm1_g[l], w_in[l], pool_w[l], pool_scale[l], conv_w[l], conv_b[l], gate_a_w[l], gate_a_b[l],
              gate_x_w[l], gate_x_b[l], lru_lambda[l], w_out[l], norm2_g[l], w_gu[l], w_down[l])
        hp, sp = decoder_layer(hp, pos_p, None, *lw)
        hs, ss = decoder_layer(hs, pos_s, (cache_win_k[l], cache_win_v[l], state_pool[l], state_conv[l],
                                           state_rglru[l]), *lw)
        st_p.append(sp)
        st_s.append(ss)
    y_prompt = rms_norm(hp, final_g)
    y_sample = rms_norm(hs, final_g)
    p_win_k = jnp.stack([s[0] for s in st_p], axis=0)
    p_win_v = jnp.stack([s[1] for s in st_p], axis=0)
    p_pool = jnp.stack([s[2] for s in st_p], axis=0)
    p_conv = jnp.stack([s[3] for s in st_p], axis=0)
    p_rglru = jnp.stack([s[4] for s in st_p], axis=0)
    s_win_k = jnp.stack([s[0] for s in st_s], axis=0)
    s_win_v = jnp.stack([s[1] for s in st_s], axis=0)
    s_pool = jnp.stack([s[2] for s in st_s], axis=0)
    s_conv = jnp.stack([s[3] for s in st_s], axis=0)
    s_rglru = jnp.stack([s[4] for s in st_s], axis=0)
    return (y_prompt, y_sample, p_win_k, p_win_v, p_pool, p_conv, p_rglru,
            s_win_k, s_win_v, s_pool, s_conv, s_rglru)
```

```cpp
#include <hip/hip_runtime.h>
#include <hip/hip_cooperative_groups.h>
#include <cstdio>
#include <cstdint>
namespace cg = cooperative_groups;
namespace pg8 {
#define PG8_LAS __attribute__((address_space(3)))
typedef unsigned short bf16_t;
typedef short bf16x8 __attribute__((ext_vector_type(8)));
typedef float f32x4 __attribute__((ext_vector_type(4)));
typedef unsigned u32x4 __attribute__((ext_vector_type(4)));
constexpr int BM = 256, BK = 64, HALF = 128, HTB = HALF * BK * 2  , STAGE_BYTES = 8 * HTB, NXCD = 8, WGM = 8;

__host__ __device__ __forceinline__ int lds_byte(int r, int c) { const int st = (r >> 4) * 2 + (c >> 5), rr = r & 15, cc = c & 31, ob = rr * 64 + cc * 2; return st * 1024 + (ob ^ (((ob >> 9) & 1) << 5)); }
__host__ __device__ __forceinline__ void stage_rc(int b, int& R, int& C) { const int st = b / 1024, sb = b % 1024, swz = sb ^ (((sb >> 9) & 1) << 5); R = (st >> 1) * 16 + swz / 64; C = (st & 1) * 32 + (swz % 64) / 2; }
__host__ __device__ __forceinline__ int perm32(int rho) { const int n = rho >> 4, i = rho & 15; return 8 * (i >> 2) + 4 * n + (i & 3); }

struct Unit { int pm, pn; };
struct Gemm { const bf16_t* A; const bf16_t* Bt; int M, N, K; };

struct StaticOrder {
    int nM, nN, nwg, G, c;
    __host__ __device__ void init(int M, int N, int G_, int c_) { nM = M / BM; nN = N / BM; nwg = nM * nN; G = G_; c = c_; }
    __host__ __device__ bool next(int i, Unit& u) const {
        const long L = (long)i * G + c; if (L >= nwg) return false;
        int wgid = (int)L; { const int q = nwg / NXCD, r = nwg % NXCD, xcd = wgid % NXCD, off = wgid / NXCD; wgid = (xcd < r ? xcd * (q + 1) : r * (q + 1) + (xcd - r) * q) + off; }
        const int nig = WGM * nN, gid = wgid / nig, fm = gid * WGM, gsz = (nM - fm) < WGM ? (nM - fm) : WGM;
        u.pm = fm + ((wgid % nig) % gsz); u.pn = (wgid % nig) / gsz; return true;
    }
    __device__ __forceinline__ void a_ready(const Unit&) const {}
    __device__ __forceinline__ void done(const Unit&) const {}
};

__device__ __forceinline__ unsigned cvt_pk_bf16(float lo, float hi) { unsigned r; asm volatile("v_cvt_pk_bf16_f32 %0, %1, %2" : "=v"(r) : "v"(lo), "v"(hi)); return r; }
template <class Epi, class Sched, bool ALIGN_EPI = false, bool SP2 = false>
__device__ __forceinline__ void gemm_phase(PG8_LAS unsigned char* lds, const Gemm g, const Sched& S, const Epi& E) {
    int tid_ = threadIdx.x; asm volatile("" : "+v"(tid_));
    const int tid = tid_, wid = __builtin_amdgcn_readfirstlane(tid >> 6), lane = tid & 63, wr = wid >> 2, wc = wid & 3, fr = lane & 15, fq = lane >> 4;
    const int K = g.K, nt = K / BK;
    unsigned voffA[2], voffB[2];
#pragma unroll
    for (int i = 0; i < 2; ++i) { int R, C; stage_rc(tid * 16 + i * 8192, R, C); const int Rb = Epi::PERM ? ((R & ~31) + perm32(R & 31)) : R;
        voffA[i] = (unsigned)(R * K + C) * 2u; voffB[i] = (unsigned)(Rb * K + C) * 2u; }
    const size_t kstep = (size_t)(BK * 2);
    const size_t hstep = (size_t)HALF * K * 2;
    const size_t tstep = 2 * hstep;
    const unsigned ldsw = (unsigned)wid * 1024u;
    const int aoff = lds_byte(wr * 64 + fr, fq * 8), boff = lds_byte(wc * 32 + fr, fq * 8);
#define PG8_SA(b, h) (((b) * 2 + (h)) * HTB)
#define PG8_SB(b, h) ((4 + (b) * 2 + (h)) * HTB)
#define PG8_STAGE(bufoff, gbase, voff) do { _Pragma("unroll") for (int _i = 0; _i < 2; ++_i) \
        __builtin_amdgcn_global_load_lds((const unsigned*)((const char*)(gbase) + (voff)[_i]), (PG8_LAS unsigned*)(lds + (bufoff) + ldsw + _i * 8192), 16, 0, 0); } while (0)
#define PG8_LDA(dst, b, h) do { _Pragma("unroll") for (int m = 0; m < 4; ++m) _Pragma("unroll") for (int k = 0; k < 2; ++k) dst[m][k] = *(const PG8_LAS bf16x8*)(lds + PG8_SA(b, h) + aoff + m * 2048 + k * 1024); } while (0)
#define PG8_LDB(dst, b, h) do { _Pragma("unroll") for (int n = 0; n < 2; ++n) _Pragma("unroll") for (int k = 0; k < 2; ++k) dst[n][k] = *(const PG8_LAS bf16x8*)(lds + PG8_SB(b, h) + boff + n * 2048 + k * 1024); } while (0)
#define PG8_MMA(ai, bj, At, Bt) do { __builtin_amdgcn_s_setprio(1); _Pragma("unroll") for (int m = 0; m < 4; ++m) _Pragma("unroll") for (int n = 0; n < 2; ++n) _Pragma("unroll") for (int k = 0; k < 2; ++k) \
        acc[ai][bj][m][n] = __builtin_amdgcn_mfma_f32_16x16x32_bf16(Bt[n][k], At[m][k], acc[ai][bj][m][n], 0, 0, 0); __builtin_amdgcn_s_setprio(0); } while (0)
#define PG8_WAIT_V(n) asm volatile("s_waitcnt vmcnt(" #n ")" ::: "memory")
#define PG8_WAIT_L(n) asm volatile("s_waitcnt lgkmcnt(" #n ")" ::: "memory")
#define PG8_BAR __builtin_amdgcn_s_barrier()
#define PG8_SCHED __builtin_amdgcn_sched_barrier(0)
    Unit cur, nxt; int ui = 0;
    if (!S.next(0, cur)) return;
    f32x4 acc[2][2][4][2];
#pragma unroll
    for (int a = 0; a < 2; ++a)
#pragma unroll
        for (int b = 0; b < 2; ++b)
#pragma unroll
            for (int m = 0; m < 4; ++m)
#pragma unroll
                for (int n = 0; n < 2; ++n) acc[a][b][m][n] = (f32x4){0.f, 0.f, 0.f, 0.f};
    bf16x8 At[4][2], B0[2][2], B1[2][2];
    const char* cA = (const char*)g.A + (size_t)cur.pm * tstep; const char* cB = (const char*)g.Bt + (size_t)cur.pn * tstep;
    S.a_ready(cur);
    if constexpr (SP2) {
        PG8_STAGE(PG8_SB(0, 0), cB, voffB); PG8_STAGE(PG8_SB(0, 1), cB + hstep, voffB); PG8_STAGE(PG8_SA(0, 0), cA, voffA); PG8_STAGE(PG8_SA(0, 1), cA + hstep, voffA);
        if (wr == 1) PG8_BAR;
        PG8_WAIT_V(2); PG8_BAR;
        PG8_STAGE(PG8_SB(1, 0), cB + kstep, voffB); PG8_STAGE(PG8_SA(1, 0), cA + kstep, voffA); PG8_STAGE(PG8_SB(1, 1), cB + hstep + kstep, voffB);
        PG8_WAIT_V(6); PG8_BAR;
    } else {
        PG8_STAGE(PG8_SB(0, 0), cB, voffB); PG8_STAGE(PG8_SA(0, 0), cA, voffA); PG8_STAGE(PG8_SB(0, 1), cB + hstep, voffB); PG8_STAGE(PG8_SA(0, 1), cA + hstep, voffA);
        if (wr == 1) PG8_BAR;
        PG8_WAIT_V(4); PG8_BAR;
        PG8_STAGE(PG8_SB(1, 0), cB + kstep, voffB); PG8_STAGE(PG8_SA(1, 0), cA + kstep, voffA); PG8_STAGE(PG8_SB(1, 1), cB + hstep + kstep, voffB);
        PG8_WAIT_V(6); PG8_BAR;
    }
    for (;;) {
        const bool has_next = S.next(ui + 1, nxt);
        const char* nA = has_next ? (const char*)g.A + (size_t)nxt.pm * tstep : cA; const char* nB = has_next ? (const char*)g.Bt + (size_t)nxt.pn * tstep : cB;
        for (int t = 0; t < nt; t += 2) {
            const bool last = (t == nt - 2);
            const char* a1 = cA + (size_t)(t + 1) * kstep;
            const char* a2 = last ? nA : cA + (size_t)(t + 2) * kstep; const char* b2 = last ? nB : cB + (size_t)(t + 2) * kstep;
            const char* a3 = a2 + kstep; const char* b3 = b2 + kstep;
            if (last && has_next) S.a_ready(nxt);
            if constexpr (SP2) {
            PG8_LDB(B0, 0, 0); PG8_LDB(B1, 0, 1); PG8_SCHED; PG8_LDA(At, 0, 0); PG8_STAGE(PG8_SA(1, 1), a1 + hstep, voffA);
            PG8_WAIT_V(8); PG8_WAIT_L(0); PG8_BAR; PG8_MMA(0, 0, At, B0); PG8_MMA(0, 1, At, B1); PG8_BAR; PG8_SCHED;
            PG8_LDA(At, 0, 1); PG8_STAGE(PG8_SB(0, 0), b2, voffB); PG8_STAGE(PG8_SB(0, 1), b2 + hstep, voffB); PG8_STAGE(PG8_SA(0, 0), a2, voffA);
            PG8_WAIT_V(8); PG8_WAIT_L(0); PG8_BAR; PG8_MMA(1, 0, At, B0); PG8_MMA(1, 1, At, B1); PG8_BAR; PG8_SCHED;
            PG8_LDB(B0, 1, 0); PG8_LDB(B1, 1, 1); PG8_SCHED; PG8_LDA(At, 1, 0); PG8_STAGE(PG8_SA(0, 1), a2 + hstep, voffA);
            PG8_WAIT_V(8); PG8_WAIT_L(0); PG8_BAR; PG8_MMA(0, 0, At, B0); PG8_MMA(0, 1, At, B1); PG8_BAR; PG8_SCHED;
            PG8_LDA(At, 1, 1); PG8_STAGE(PG8_SB(1, 0), b3, voffB); PG8_STAGE(PG8_SB(1, 1), b3 + hstep, voffB); PG8_STAGE(PG8_SA(1, 0), a3, voffA);
            PG8_WAIT_V(8); PG8_WAIT_L(0); PG8_BAR; PG8_MMA(1, 0, At, B0); PG8_MMA(1, 1, At, B1); PG8_BAR; PG8_SCHED;
            } else {
            PG8_LDB(B0, 0, 0); PG8_SCHED; PG8_LDA(At, 0, 0); PG8_STAGE(PG8_SA(1, 1), a1 + hstep, voffA);
            PG8_WAIT_L(8); PG8_BAR; PG8_WAIT_L(0); PG8_MMA(0, 0, At, B0); PG8_BAR; PG8_SCHED;
            PG8_LDB(B1, 0, 1); PG8_STAGE(PG8_SB(0, 0), b2, voffB);
            PG8_BAR; PG8_WAIT_L(0); PG8_MMA(0, 1, At, B1); PG8_BAR;
            PG8_LDA(At, 0, 1); PG8_STAGE(PG8_SA(0, 0), a2, voffA);
            PG8_BAR; PG8_WAIT_L(0); PG8_MMA(1, 0, At, B0); PG8_BAR; PG8_SCHED;
            PG8_STAGE(PG8_SB(0, 1), b2 + hstep, voffB);
            PG8_WAIT_V(6); PG8_BAR; PG8_MMA(1, 1, At, B1); PG8_BAR;
            PG8_LDB(B0, 1, 0); PG8_SCHED; PG8_LDA(At, 1, 0); PG8_STAGE(PG8_SA(0, 1), a2 + hstep, voffA);
            PG8_WAIT_L(8); PG8_BAR; PG8_WAIT_L(0); PG8_MMA(0, 0, At, B0); PG8_BAR; PG8_SCHED;
            PG8_LDB(B1, 1, 1); PG8_STAGE(PG8_SB(1, 0), b3, voffB);
            PG8_BAR; PG8_WAIT_L(0); PG8_MMA(0, 1, At, B1); PG8_BAR;
            PG8_LDA(At, 1, 1); PG8_STAGE(PG8_SA(1, 0), a3, voffA);
            PG8_BAR; PG8_WAIT_L(0); PG8_MMA(1, 0, At, B0); PG8_BAR; PG8_SCHED;
            PG8_STAGE(PG8_SB(1, 1), b3 + hstep, voffB);
            PG8_WAIT_V(6); PG8_BAR; PG8_MMA(1, 1, At, B1); PG8_BAR;
            }
        }
        if constexpr (ALIGN_EPI) { if (wr == 0) PG8_BAR; }
        if constexpr (!Epi::AFTER_DRAIN) { E(acc, cur, wr, wc, fr, fq); S.done(cur); }
        if (!has_next) break;
#pragma unroll
        for (int a = 0; a < 2; ++a)
#pragma unroll
            for (int b = 0; b < 2; ++b)
#pragma unroll
                for (int m = 0; m < 4; ++m)
#pragma unroll
                    for (int n = 0; n < 2; ++n) acc[a][b][m][n] = (f32x4){0.f, 0.f, 0.f, 0.f};
        cur = nxt; cA = nA; cB = nB; ++ui;
        if constexpr (ALIGN_EPI) { if (wr == 1) PG8_BAR; }
    }
    PG8_WAIT_V(0);
    if constexpr (!ALIGN_EPI) { if (wr == 0) PG8_BAR; }
    PG8_BAR;
    if constexpr (Epi::AFTER_DRAIN) { E.fused(acc, cur, wr, wc, fr, fq, lds, wid, lane); S.done(cur); }
#undef PG8_SA
#undef PG8_SB
#undef PG8_STAGE
#undef PG8_LDA
#undef PG8_LDB
#undef PG8_MMA
#undef PG8_WAIT_V
#undef PG8_WAIT_L
#undef PG8_BAR
#undef PG8_SCHED
}
}

using pg8::bf16_t; using pg8::bf16x8; using pg8::f32x4; using pg8::u32x4;
#define LAS __attribute__((address_space(3)))
typedef short s16x4 __attribute__((ext_vector_type(4)));
typedef unsigned u32x2 __attribute__((ext_vector_type(2)));
typedef float f32x2 __attribute__((ext_vector_type(2)));

constexpr int DM = 1024, SEQ = 16384, NSMP = 256, MT = SEQ + NSMP;
constexpr int DIN = 2176, DINP = 2304, DFF = 2816, NGU = 2 * DFF;
constexpr int C_Q = 0, C_K = 384, C_V = 768, C_U = 1152, C_XR = 1408, C_GT = 1792, PJP = 2176;
constexpr int NCH = MT / 64;
constexpr float EPS = 1e-6f;
constexpr float QSCALE = 0.125f * 1.4426950408889634f;

constexpr size_t OFF_YP = 0, OFF_YS = OFF_YP + (size_t)SEQ * DM, OFF_PWK = OFF_YS + (size_t)NSMP * DM, OFF_PWV = OFF_PWK + 2ull * 2048 * 384,
                 OFF_PPOOL = OFF_PWV + 2ull * 2048 * 384, OFF_PCONV = OFF_PPOOL + 2 * 15 * 256, OFF_PRG = OFF_PCONV + 2 * 3 * 384, OFF_SWK = OFF_PRG + 2 * 384,
                 OFF_SWV = OFF_SWK + 2ull * 32 * 2048 * 384, OFF_SPOOL = OFF_SWV + 2ull * 32 * 2048 * 384, OFF_SCONV = OFF_SPOOL + 2 * 32 * 15 * 256,
                 OFF_SRG = OFF_SCONV + 2 * 32 * 3 * 384, OUT_TOTAL = OFF_SRG + 2 * 32 * 384;

constexpr size_t al256(size_t x) { return (x + 255) & ~(size_t)255; }
constexpr size_t WS_WIN = 0;
constexpr size_t WS_WOUT = WS_WIN + al256(2ull * DINP * DM * 2);
constexpr size_t WS_WGU = WS_WOUT + al256(2ull * DM * DM * 2);
constexpr size_t WS_WDN = WS_WGU + al256(2ull * NGU * DM * 2);
constexpr size_t WS_WA = WS_WDN + al256(2ull * DM * DFF * 2);
constexpr size_t WS_WX = WS_WA + al256(2ull * 6 * 64 * 64 * 2);
constexpr size_t WS_WP = WS_WX + al256(2ull * 6 * 64 * 64 * 2);
constexpr size_t WS_ROPE = WS_WP + al256(2ull * 4 * 64 * 64 * 2);
constexpr size_t WS_RSS = WS_ROPE + al256(16392ull * 32 * 8);
constexpr size_t WS_XB = WS_RSS + al256(5ull * MT * 4);
constexpr size_t WS_PJ = WS_XB + al256((size_t)MT * DM * 2);
constexpr size_t WS_HL = WS_PJ + al256((size_t)MT * PJP * 2);
constexpr size_t WS_PC = WS_HL + al256((size_t)MT * 384 * 4);
constexpr size_t WS_CA = WS_PC + al256((size_t)MT * 384 * 4);
constexpr size_t WS_CH = WS_CA + al256((size_t)NCH * 384 * 4);
constexpr size_t WS_MIX = WS_CH + al256((size_t)NCH * 384 * 4);
constexpr size_t WS_X = WS_MIX + al256((size_t)MT * DM * 2);
constexpr size_t WS_HB = WS_X + al256((size_t)MT * DM * 4);
constexpr size_t WS_END = WS_HB + al256((size_t)MT * DFF * 2);

struct Params { const float* in[23]; float* out; unsigned char* ws; };
typedef const __attribute__((address_space(4))) Params* KP;
__device__ __forceinline__ KP kargs() { auto p = __builtin_amdgcn_kernarg_segment_ptr(); asm volatile("" : "+s"(p)); return (KP)p; }
enum { I_XP = 0, I_XS, I_CK, I_CV, I_SPOOL, I_SCONV, I_SRG, I_N1G, I_WIN, I_POOLW, I_POOLS, I_CONVW, I_CONVB, I_GAW, I_GAB, I_GXW, I_GXB, I_LAM, I_WOUT, I_N2G, I_WGU, I_WDN, I_FING };

__device__ __forceinline__ int opaque_tid() { int t = threadIdx.x; asm volatile("" : "+v"(t)); return t; }
__device__ __forceinline__ unsigned pk2(float lo, float hi) { return pg8::cvt_pk_bf16(lo, hi); }
__device__ __forceinline__ float bf_lo(unsigned w) { return __uint_as_float(w << 16); }
__device__ __forceinline__ float bf_hi(unsigned w) { return __uint_as_float(w & 0xffff0000u); }
__device__ __forceinline__ f32x4 bf4_to_f4(u32x2 w) { return (f32x4){bf_lo(w.x), bf_hi(w.x), bf_lo(w.y), bf_hi(w.y)}; }
__device__ __forceinline__ u32x2 f4_to_bf4(f32x4 v) { u32x2 w; w.x = pk2(v[0], v[1]); w.y = pk2(v[2], v[3]); return w; }
__device__ __forceinline__ float wave_sum(float v) {
#pragma unroll
    for (int o = 1; o < 64; o <<= 1) v += __shfl_xor(v, o);
    return v;
}
__device__ __forceinline__ float fexp2(float x) { return __builtin_amdgcn_exp2f(x); }
__device__ __forceinline__ float sigmoidf_(float x) { return 1.0f / (1.0f + __expf(-x)); }
__device__ __forceinline__ float gelu_tanh(float x) { const float z = 0.7978845608028654f * (x + 0.044715f * x * x * x); const float e = __expf(2.0f * z); return 0.5f * x * (2.0f - 2.0f / (e + 1.0f)); }

struct EpiInProj {
    static constexpr bool PERM = true, AFTER_DRAIN = false;
    bf16_t* PJ; const float* rss; const float* rope; float* out; int layer;
    __device__ __forceinline__ void operator()(const f32x4 (&acc)[2][2][4][2], const pg8::Unit& u, int wr, int wc, int fr_, int fq_) const {
        int fr = fr_, fq = fq_; asm volatile("" : "+v"(fr), "+v"(fq));
#pragma unroll
        for (int bj = 0; bj < 2; ++bj) {
            const int cb = u.pn * 256 + bj * 128;
            if (cb >= DIN) continue;
            const int c0 = cb + wc * 32 + fq * 8;
            if (cb < C_V) {
                const bool isk = cb >= C_K; const int sb = isk ? C_K : 0; const int o = c0 - sb; const int hb = o & ~63; const int j0 = (o & 63) >> 1;
#pragma unroll
                for (int ai = 0; ai < 2; ++ai)
#pragma unroll
                    for (int m = 0; m < 4; ++m) {
                        const int row = u.pm * 256 + ai * 128 + wr * 64 + m * 16 + fr;
                        const int pos = row < SEQ ? row : SEQ + ((row - SEQ) & 7);
                        const f32x4 t0 = *(const f32x4*)(rope + ((size_t)pos * 32 + j0) * 2), t1 = *(const f32x4*)(rope + ((size_t)pos * 32 + j0) * 2 + 4);
                        const float rsv = rsqrtf(rss[row] * (1.0f / DM) + EPS);
                        const f32x4 v0 = acc[ai][bj][m][0] * rsv, v1 = acc[ai][bj][m][1] * rsv;
                        f32x4 o1, o2;
                        o1[0] = v0[0] * t0[0] - v0[1] * t0[1]; o2[0] = v0[1] * t0[0] + v0[0] * t0[1];
                        o1[1] = v0[2] * t0[2] - v0[3] * t0[3]; o2[1] = v0[3] * t0[2] + v0[2] * t0[3];
                        o1[2] = v1[0] * t1[0] - v1[1] * t1[1]; o2[2] = v1[1] * t1[0] + v1[0] * t1[1];
                        o1[3] = v1[2] * t1[2] - v1[3] * t1[3]; o2[3] = v1[3] * t1[2] + v1[2] * t1[3];
                        bf16_t* pj = PJ + (size_t)row * PJP + sb + hb + j0;
                        if (!isk) { o1 = o1 * QSCALE; o2 = o2 * QSCALE; }
                        *(u32x2*)pj = f4_to_bf4(o1); *(u32x2*)(pj + 32) = f4_to_bf4(o2);
                        if (isk && row >= SEQ - 2048) {
                            float* d;
                            if (row < SEQ) d = out + OFF_PWK + ((size_t)layer * 2048 + (row - (SEQ - 2048))) * 384 + hb + j0;
                            else { const int si = row - SEQ; d = out + OFF_SWK + (((size_t)layer * 32 + (si >> 3)) * 2048 + 2040 + (si & 7)) * 384 + hb + j0; }
                            *(f32x4*)d = o1; *(f32x4*)(d + 32) = o2;
                        }
                    }
            } else {
#pragma unroll
                for (int ai = 0; ai < 2; ++ai)
#pragma unroll
                    for (int m = 0; m < 4; ++m) {
                        const int row = u.pm * 256 + ai * 128 + wr * 64 + m * 16 + fr;
                        const float rsv = rsqrtf(rss[row] * (1.0f / DM) + EPS);
                        const f32x4 v0 = acc[ai][bj][m][0] * rsv, v1 = acc[ai][bj][m][1] * rsv;
                        u32x4 w; w.x = pk2(v0[0], v0[1]); w.y = pk2(v0[2], v0[3]); w.z = pk2(v1[0], v1[1]); w.w = pk2(v1[2], v1[3]);
                        *(u32x4*)(PJ + (size_t)row * PJP + c0) = w;
                        float* d = nullptr;
                        const int si = row - SEQ, sb_ = si >> 3, st_ = si & 7;
                        if (cb < C_U) {
                            if (row >= SEQ) d = out + OFF_SWV + (((size_t)layer * 32 + sb_) * 2048 + 2040 + st_) * 384 + (c0 - C_V);
                            else if (row >= SEQ - 2048) d = out + OFF_PWV + ((size_t)layer * 2048 + (row - (SEQ - 2048))) * 384 + (c0 - C_V);
                        } else if (cb < C_XR) {
                            if (row >= SEQ) d = out + OFF_SPOOL + (((size_t)layer * 32 + sb_) * 15 + 7 + st_) * 256 + (c0 - C_U);
                            else if (row >= SEQ - 15) d = out + OFF_PPOOL + ((size_t)layer * 15 + (row - (SEQ - 15))) * 256 + (c0 - C_U);
                        } else if (cb < C_GT) {
                            if (row >= SEQ) { if (st_ >= 5) d = out + OFF_SCONV + (((size_t)layer * 32 + sb_) * 3 + (st_ - 5)) * 384 + (c0 - C_XR); }
                            else if (row >= SEQ - 3) d = out + OFF_PCONV + ((size_t)layer * 3 + (row - (SEQ - 3))) * 384 + (c0 - C_XR);
                        }
                        if (d) { *(f32x4*)d = v0; *(f32x4*)(d + 4) = v1; }
                    }
            }
        }
    }
};

struct EpiResid {
    static constexpr bool PERM = false, AFTER_DRAIN = false;
    const float* base_p; const float* base_s; float* X; bf16_t* XB; float* rss_out;
    __device__ __forceinline__ void operator()(const f32x4 (&acc)[2][2][4][2], const pg8::Unit& u, int wr, int wc, int fr, int fq) const {
#pragma unroll
        for (int ai = 0; ai < 2; ++ai)
#pragma unroll
            for (int m = 0; m < 4; ++m) {
                const int row = u.pm * 256 + ai * 128 + wr * 64 + m * 16 + fr;
                const float* b = row < SEQ ? base_p + (size_t)row * DM : base_s + (size_t)(row - SEQ) * DM;
                float ss = 0.f;
#pragma unroll
                for (int bj = 0; bj < 2; ++bj)
#pragma unroll
                    for (int n = 0; n < 2; ++n) {
                        const int col = u.pn * 256 + bj * 128 + wc * 32 + n * 16 + fq * 4;
                        const f32x4 x = *(const f32x4*)(b + col) + acc[ai][bj][m][n];
                        *(f32x4*)(X + (size_t)row * DM + col) = x;
                        *(u32x2*)(XB + (size_t)row * DM + col) = f4_to_bf4(x);
                        ss += (x[0] * x[0] + x[1] * x[1]) + (x[2] * x[2] + x[3] * x[3]);
                    }
                ss += __shfl_xor(ss, 16); ss += __shfl_xor(ss, 32);
                if (fq == 0) unsafeAtomicAdd(rss_out + row, ss);
            }
    }
};

struct EpiGateUp {
    static constexpr bool PERM = true, AFTER_DRAIN = false;
    bf16_t* HB; const float* rss;
    __device__ __forceinline__ void operator()(const f32x4 (&acc)[2][2][4][2], const pg8::Unit& u, int wr, int wc, int fr, int fq) const {
#pragma unroll
        for (int ai = 0; ai < 2; ++ai)
#pragma unroll
            for (int m = 0; m < 4; ++m) {
                const int row = u.pm * 256 + ai * 128 + wr * 64 + m * 16 + fr;
                const float rs = rsqrtf(rss[row] * (1.0f / DM) + EPS);
#pragma unroll
                for (int bj = 0; bj < 2; ++bj) {
                    const int hc = u.pn * 128 + bj * 64 + wc * 16 + fq * 4;
                    const f32x4 g = acc[ai][bj][m][0] * rs, up = acc[ai][bj][m][1] * rs;
                    f32x4 h;
#pragma unroll
                    for (int i = 0; i < 4; ++i) h[i] = g[i] * sigmoidf_(g[i]) * up[i];
                    *(u32x2*)(HB + (size_t)row * DFF + hc) = f4_to_bf4(h);
                }
            }
    }
};

__device__ __forceinline__ int colmap_in(int n) { if (n >= DIN) return -1; if (n >= C_V) return n; const int sb = n >= C_K ? C_K : 0; const int o = n - sb; return sb + (o & ~63) + ((o & 63) >> 1) + 32 * (o & 1); }
__device__ __forceinline__ int colmap_gu(int n) { return ((n >> 3) << 2) + (n & 3) + DFF * ((n >> 2) & 1); }

__device__ __forceinline__ void transpose_item(const float* __restrict__ W, int K, int Nsrc, const float* __restrict__ kscale, bf16_t* WT, int item, int nblk, int mode, LAS float* scr, int lane) {
    const int kb = item / nblk, nb = item - kb * nblk, k0 = 64 * kb, n0 = 32 * nb;
    const int nl = lane & 31, np = n0 + nl;
    const int sc = mode == 1 ? colmap_in(np) : (mode == 2 ? colmap_gu(np) : np);
#pragma unroll 8
    for (int i = 0; i < 32; ++i) {
        const int kk = 2 * i + (lane >> 5); float v = 0.f;
        if (sc >= 0) { v = W[(size_t)(k0 + kk) * Nsrc + sc]; if (kscale) v *= kscale[k0 + kk]; }
        scr[kk * 33 + nl] = v;
    }
    asm volatile("s_waitcnt lgkmcnt(0)" ::: "memory");
    const int c = lane & 7;
#pragma unroll
    for (int j = 0; j < 4; ++j) {
        const int n = (lane >> 3) + 8 * j; const LAS float* s = scr + (8 * c) * 33 + n;
        u32x4 o; o.x = pk2(s[0 * 33], s[1 * 33]); o.y = pk2(s[2 * 33], s[3 * 33]); o.z = pk2(s[4 * 33], s[5 * 33]); o.w = pk2(s[6 * 33], s[7 * 33]);
        *(u32x4*)(WT + (size_t)(n0 + n) * K + k0 + 8 * c) = o;
    }
    asm volatile("s_waitcnt lgkmcnt(0)" ::: "memory");
}

__device__ __forceinline__ void prologue(KP P, LAS unsigned char* lds) {
    const int tid = opaque_tid(), lane = tid & 63, wave = tid >> 6;
    const int gw = blockIdx.x * 8 + wave, NGW = gridDim.x * 8;
    const int gt = blockIdx.x * 512 + tid, NGT = gridDim.x * 512;
    unsigned char* ws = P->ws;
    LAS float* scr = (LAS float*)(lds + wave * 8704);
    constexpr int I_IN = 16 * (DINP / 32), I_OUT = 16 * (DM / 32), I_GU = 16 * (NGU / 32), I_DN = (DFF / 64) * (DM / 32), I_L = I_IN + I_OUT + I_GU + I_DN;
    for (int it = gw; it < 2 * I_L; it += NGW) {
        const int l = it / I_L; int r = it - l * I_L;
        if (r < I_IN) { transpose_item(P->in[I_WIN] + (size_t)l * DM * DIN, DM, DIN, P->in[I_N1G] + l * DM, (bf16_t*)(ws + WS_WIN) + (size_t)l * DINP * DM, r, DINP / 32, 1, scr, lane); continue; } r -= I_IN;
        if (r < I_OUT) { transpose_item(P->in[I_WOUT] + (size_t)l * DM * DM, DM, DM, nullptr, (bf16_t*)(ws + WS_WOUT) + (size_t)l * DM * DM, r, DM / 32, 0, scr, lane); continue; } r -= I_OUT;
        if (r < I_GU) { transpose_item(P->in[I_WGU] + (size_t)l * DM * NGU, DM, NGU, P->in[I_N2G] + l * DM, (bf16_t*)(ws + WS_WGU) + (size_t)l * NGU * DM, r, NGU / 32, 2, scr, lane); continue; } r -= I_GU;
        transpose_item(P->in[I_WDN] + (size_t)l * DFF * DM, DFF, DM, nullptr, (bf16_t*)(ws + WS_WDN) + (size_t)l * DM * DFF, r, DM / 32, 0, scr, lane);
    }
    float* rss = (float*)(ws + WS_RSS);
    bf16_t* XB = (bf16_t*)(ws + WS_XB);
    for (int row = gw; row < MT; row += NGW) {
        const float* xr = row < SEQ ? P->in[I_XP] + (size_t)row * DM : P->in[I_XS] + (size_t)(row - SEQ) * DM;
        float s = 0.f;
#pragma unroll
        for (int j = 0; j < 4; ++j) {
            const f32x4 v = *(const f32x4*)(xr + 4 * lane + 256 * j);
            s += (v[0] * v[0] + v[1] * v[1]) + (v[2] * v[2] + v[3] * v[3]);
            *(u32x2*)(XB + (size_t)row * DM + 4 * lane + 256 * j) = f4_to_bf4(v);
        }
        s = wave_sum(s);
        if (lane == 0) rss[row] = s;
    }
    for (int i = gt; i < 4 * MT; i += NGT) rss[MT + i] = 0.f;
    bf16_t* WA = (bf16_t*)(ws + WS_WA); bf16_t* WX = (bf16_t*)(ws + WS_WX); bf16_t* WP = (bf16_t*)(ws + WS_WP);
    for (int i = gt; i < 2 * 6 * 64 * 64; i += NGT) {
        const int slot = i & 63, d = (i >> 6) & 63, ln = i >> 12;
        const int kk = slot >> 5, q = (slot >> 3) & 3, e = slot & 7, c = 16 * (2 * kk + (e >> 2)) + 4 * q + (e & 3);
        const size_t src = ((size_t)ln * 64 + c) * 64 + d;
        WA[i] = (bf16_t)(pk2(P->in[I_GAW][src], 0.f) & 0xffffu); WX[i] = (bf16_t)(pk2(P->in[I_GXW][src], 0.f) & 0xffffu);
    }
    for (int i = gt; i < 2 * 4 * 64 * 64; i += NGT) {
        const int c = i & 63, d = (i >> 6) & 63, lg = i >> 12;
        WP[i] = (bf16_t)(pk2(P->in[I_POOLW][((size_t)lg * 64 + c) * 64 + d], 0.f) & 0xffffu);
    }
    float* rope = (float*)(ws + WS_ROPE);
    for (int i = gt; i < 16392 * 32; i += NGT) {
        const int pos = i >> 5, j = i & 31;
        const float inv = (float)exp2(-(double)j * (13.287712379549449 / 32.0));
        const float ang = (float)pos * inv;
        double rev = (double)ang * 0.15915494309189535; rev -= floor(rev);
        const float rf = (float)rev;
        rope[2 * (size_t)i] = __builtin_amdgcn_cosf(rf); rope[2 * (size_t)i + 1] = __builtin_amdgcn_sinf(rf);
    }
}

__device__ __forceinline__ void pool_row8(KP P, const bf16_t* PJ, int l, int R, int k, int ch, float (&v)[8]) {
    if (R < SEQ) {
        const int rr = R - k;
        if (rr < 0) {
#pragma unroll
            for (int i = 0; i < 8; ++i) v[i] = 0.f;
            return; }
        const u32x4 w = *(const u32x4*)(PJ + (size_t)rr * PJP + C_U + ch);
        v[0] = bf_lo(w.x); v[1] = bf_hi(w.x); v[2] = bf_lo(w.y); v[3] = bf_hi(w.y); v[4] = bf_lo(w.z); v[5] = bf_hi(w.z); v[6] = bf_lo(w.w); v[7] = bf_hi(w.w);
    } else {
        const int si = R - SEQ, b = si >> 3, t = si & 7, tk = t - k;
        if (tk >= 0) {
            const u32x4 w = *(const u32x4*)(PJ + (size_t)(SEQ + 8 * b + tk) * PJP + C_U + ch);
            v[0] = bf_lo(w.x); v[1] = bf_hi(w.x); v[2] = bf_lo(w.y); v[3] = bf_hi(w.y); v[4] = bf_lo(w.z); v[5] = bf_hi(w.z); v[6] = bf_lo(w.w); v[7] = bf_hi(w.w);
        } else {
            const float* s = P->in[I_SPOOL] + (((size_t)l * 32 + b) * 15 + (15 + tk)) * 256 + ch;
            const f32x4 a = *(const f32x4*)s, c = *(const f32x4*)(s + 4);
            v[0] = a[0]; v[1] = a[1]; v[2] = a[2]; v[3] = a[3]; v[4] = c[0]; v[5] = c[1]; v[6] = c[2]; v[7] = c[3];
        }
    }
}

__device__ __forceinline__ void pool_task(KP P, int l, int task, int lane) {
    const int g = task & 3, T0 = (task >> 2) * 64, w = 2 << g, fr = lane & 15, fq = lane >> 4;
    const bf16_t* PJ = (const bf16_t*)(P->ws + WS_PJ); bf16_t* MIX = (bf16_t*)(P->ws + WS_MIX);
    const bf16_t* WP = (const bf16_t*)(P->ws + WS_WP) + (size_t)(l * 4 + g) * 4096;
    bf16x8 af[4][2];
#pragma unroll
    for (int dt = 0; dt < 4; ++dt)
#pragma unroll
        for (int kk = 0; kk < 2; ++kk) af[dt][kk] = *(const bf16x8*)(WP + (16 * dt + fr) * 64 + 32 * kk + 8 * fq);
    f32x4 sc[4];
#pragma unroll
    for (int dt = 0; dt < 4; ++dt) sc[dt] = *(const f32x4*)(P->in[I_POOLS] + l * 256 + 64 * g + 16 * dt + 4 * fq);
#pragma unroll 1
    for (int tt = 0; tt < 4; ++tt) {
        const int R = T0 + 16 * tt + fr;
        const int pos1 = R < SEQ ? R + 1 : SEQ + 1;
        const float rc = 1.0f / (float)(pos1 < w ? pos1 : w);
        bf16x8 bfr[2];
#pragma unroll
        for (int kk = 0; kk < 2; ++kk) {
            const int ch = 64 * g + 32 * kk + 8 * fq;
            float s[8], u0[8];
            pool_row8(P, PJ, l, R, 0, ch, u0);
#pragma unroll
            for (int i = 0; i < 8; ++i) s[i] = u0[i];
            for (int k = 1; k < w; ++k) {
                float v[8]; pool_row8(P, PJ, l, R, k, ch, v);
#pragma unroll
                for (int i = 0; i < 8; ++i) s[i] += v[i];
            }
            u32x4 pw;
            pw.x = pk2(s[0] * rc - u0[0], s[1] * rc - u0[1]); pw.y = pk2(s[2] * rc - u0[2], s[3] * rc - u0[3]);
            pw.z = pk2(s[4] * rc - u0[4], s[5] * rc - u0[5]); pw.w = pk2(s[6] * rc - u0[6], s[7] * rc - u0[7]);
            bfr[kk] = __builtin_bit_cast(bf16x8, pw);
        }
#pragma unroll
        for (int dt = 0; dt < 4; ++dt) {
            f32x4 y = (f32x4){0.f, 0.f, 0.f, 0.f};
            y = __builtin_amdgcn_mfma_f32_16x16x32_bf16(af[dt][0], bfr[0], y, 0, 0, 0);
            y = __builtin_amdgcn_mfma_f32_16x16x32_bf16(af[dt][1], bfr[1], y, 0, 0, 0);
            y = y * sc[dt];
            *(u32x2*)(MIX + (size_t)R * DM + 384 + 64 * g + 16 * dt + 4 * fq) = f4_to_bf4(y);
        }
    }
}

__device__ __forceinline__ f32x4 conv_row4(KP P, const bf16_t* PJ, int l, int R, int j, int ch) {
    if (R < SEQ) {
        const int rr = R - 3 + j;
        if (rr < 0) return (f32x4){0.f, 0.f, 0.f, 0.f};
        return bf4_to_f4(*(const u32x2*)(PJ + (size_t)rr * PJP + C_XR + ch));
    }
    const int si = R - SEQ, b = si >> 3, t = si & 7, tj = t - 3 + j;
    if (tj >= 0) return bf4_to_f4(*(const u32x2*)(PJ + (size_t)(SEQ + 8 * b + tj) * PJP + C_XR + ch));
    return *(const f32x4*)(P->in[I_SCONV] + (((size_t)l * 32 + b) * 3 + (3 + tj)) * 384 + ch);
}

__device__ __forceinline__ void rglru_local_task(KP P, int l, int task, int lane) {
    const int c64 = task / 6, n = task - 6 * c64, T0 = c64 * 64, fr = lane & 15, fq = lane >> 4;
    const bool smp = T0 >= SEQ;
    const bf16_t* PJ = (const bf16_t*)(P->ws + WS_PJ);
    float* HL = (float*)(P->ws + WS_HL); float* PC = (float*)(P->ws + WS_PC);
    const bf16_t* WA = (const bf16_t*)(P->ws + WS_WA) + (size_t)(l * 6 + n) * 4096; const bf16_t* WX = (const bf16_t*)(P->ws + WS_WX) + (size_t)(l * 6 + n) * 4096;
    f32x4 Pc[4], Hc[4];
#pragma unroll
    for (int dt = 0; dt < 4; ++dt) { Pc[dt] = (f32x4){1.f, 1.f, 1.f, 1.f}; Hc[dt] = (f32x4){0.f, 0.f, 0.f, 0.f}; }
    const int segm = smp ? 7 : 15;
#pragma unroll 1
    for (int tt = 0; tt < 4; ++tt) {
        asm volatile("" ::: "memory");
        const int R = T0 + 16 * tt + fr;
        f32x4 xc[4];
#pragma unroll
        for (int dt = 0; dt < 4; ++dt) {
            const int ch = 64 * n + 16 * dt + 4 * fq;
            f32x4 a = *(const f32x4*)(P->in[I_CONVB] + l * 384 + ch);
#pragma unroll
            for (int j = 0; j < 4; ++j) a += *(const f32x4*)(P->in[I_CONVW] + ((size_t)l * 4 + j) * 384 + ch) * conv_row4(P, PJ, l, R, j, ch);
            xc[dt] = a;
            __builtin_amdgcn_sched_barrier(0);
        }
        bf16x8 bfr[2];
#pragma unroll
        for (int kk = 0; kk < 2; ++kk) { u32x4 pw; pw.x = pk2(xc[2 * kk][0], xc[2 * kk][1]); pw.y = pk2(xc[2 * kk][2], xc[2 * kk][3]); pw.z = pk2(xc[2 * kk + 1][0], xc[2 * kk + 1][1]); pw.w = pk2(xc[2 * kk + 1][2], xc[2 * kk + 1][3]); bfr[kk] = __builtin_bit_cast(bf16x8, pw); }
#pragma unroll
        for (int dt = 0; dt < 4; ++dt) {
            const int ch = 64 * n + 16 * dt + 4 * fq;
            f32x4 ra = (f32x4){0.f, 0.f, 0.f, 0.f}, ia = (f32x4){0.f, 0.f, 0.f, 0.f};
            const bf16x8 wa0 = *(const bf16x8*)(WA + (16 * dt + fr) * 64 + 8 * fq), wa1 = *(const bf16x8*)(WA + (16 * dt + fr) * 64 + 32 + 8 * fq);
            const bf16x8 wx0 = *(const bf16x8*)(WX + (16 * dt + fr) * 64 + 8 * fq), wx1 = *(const bf16x8*)(WX + (16 * dt + fr) * 64 + 32 + 8 * fq);
            ra = __builtin_amdgcn_mfma_f32_16x16x32_bf16(wa0, bfr[0], ra, 0, 0, 0); ra = __builtin_amdgcn_mfma_f32_16x16x32_bf16(wa1, bfr[1], ra, 0, 0, 0);
            ia = __builtin_amdgcn_mfma_f32_16x16x32_bf16(wx0, bfr[0], ia, 0, 0, 0); ia = __builtin_amdgcn_mfma_f32_16x16x32_bf16(wx1, bfr[1], ia, 0, 0, 0);
            const f32x4 ba = *(const f32x4*)(P->in[I_GAB] + l * 384 + ch), bx = *(const f32x4*)(P->in[I_GXB] + l * 384 + ch), lam = *(const f32x4*)(P->in[I_LAM] + l * 384 + ch);
            f32x4 A, B;
#pragma unroll
            for (int i = 0; i < 4; ++i) {
                const float r = sigmoidf_(ra[i] + ba[i]), ig = sigmoidf_(ia[i] + bx[i]);
                const float ls = -log1pf(__expf(-lam[i]));
                const float la = 8.0f * r * ls;
                A[i] = __expf(la); B[i] = sqrtf(fmaxf(-expm1f(2.0f * la), 0.f)) * ig * xc[dt][i];
            }
#pragma unroll
            for (int off = 1; off < 16; off <<= 1) {
                if (off == 8 && smp) break;
                const bool cnd = (fr & segm) >= off;
#pragma unroll
                for (int i = 0; i < 4; ++i) {
                    const float ap = __shfl_up(A[i], off, 16), bp = __shfl_up(B[i], off, 16);
                    if (cnd) { B[i] = A[i] * bp + B[i]; A[i] = A[i] * ap; }
                }
            }
            const f32x4 h = B + A * Hc[dt], p = A * Pc[dt];
            *(f32x4*)(HL + (size_t)R * 384 + ch) = h; *(f32x4*)(PC + (size_t)R * 384 + ch) = p;
            if (!smp) {
#pragma unroll
                for (int i = 0; i < 4; ++i) { Hc[dt][i] = __shfl(h[i], (lane & 48) | 15); Pc[dt][i] = __shfl(p[i], (lane & 48) | 15); }
            }
            __builtin_amdgcn_sched_barrier(0);
        }
    }
    if (!smp && fr == 0) {
#pragma unroll
        for (int dt = 0; dt < 4; ++dt) {
            const int ch = 64 * n + 16 * dt + 4 * fq;
            *(f32x4*)((float*)(P->ws + WS_CA) + (size_t)c64 * 384 + ch) = Pc[dt]; *(f32x4*)((float*)(P->ws + WS_CH) + (size_t)c64 * 384 + ch) = Hc[dt];
        }
    }
}

__device__ __forceinline__ void phase2(KP P, int l) {
    const int tid = opaque_tid(), lane = tid & 63, wave = tid >> 6;
    const int gw = blockIdx.x * 8 + wave, NGW = gridDim.x * 8;
    const int gt = blockIdx.x * 512 + tid, NGT = gridDim.x * 512;
    constexpr int NT_R = NCH * 6, NT_P = NCH * 4;
    for (int t = gw; t < NT_R + NT_P; t += NGW) { if (t < NT_R) rglru_local_task(P, l, t, lane); else pool_task(P, l, t - NT_R, lane); }
    constexpr int SEGV = 2040 * 384 / 4;
    for (int i = gt; i < 64 * SEGV; i += NGT) {
        const int seg = i / SEGV, off = i - seg * SEGV, kv = seg >> 5, b = seg & 31;
        const f32x4* src = (const f32x4*)(P->in[kv ? I_CV : I_CK] + (((size_t)l * 32 + b) * 2048 + 8) * 384) + off;
        f32x4* dst = (f32x4*)(P->out + (kv ? OFF_SWV : OFF_SWK) + ((size_t)l * 32 + b) * 2048 * 384) + off;
        __builtin_nontemporal_store(__builtin_nontemporal_load(src), dst);
    }
    for (int i = gt; i < 32 * 7 * 256; i += NGT) {
        const int b = i / 1792, rem = i - b * 1792;
        P->out[OFF_SPOOL + ((size_t)l * 32 + b) * 15 * 256 + rem] = P->in[I_SPOOL][((size_t)l * 32 + b) * 15 * 256 + 8 * 256 + rem];
    }
}

__device__ __forceinline__ void rglru_fix_task(KP P, int l, int task, LAS unsigned char* lds) {
    const int tid = opaque_tid(), c = task / 3, cg_ = task - 3 * c, chl = tid & 127, seg = tid >> 7, ch = 128 * cg_ + chl;
    const float* CA = (const float*)(P->ws + WS_CA); const float* CH = (const float*)(P->ws + WS_CH);
    const float* HL = (const float*)(P->ws + WS_HL); const float* PC = (const float*)(P->ws + WS_PC);
    const bf16_t* PJ = (const bf16_t*)(P->ws + WS_PJ); bf16_t* MIX = (bf16_t*)(P->ws + WS_MIX);
    LAS float* sA = (LAS float*)lds; LAS float* sH = sA + 512;
    float carry = 0.f;
    const bool smp = c >= 256;
    if (!smp) {
        const int q = (c + 3) >> 2, k0 = seg * q, k1 = (k0 + q) < c ? (k0 + q) : c;
        float a = 1.f, h = 0.f;
        for (int k = k0; k < k1; ++k) { const float ak = CA[(size_t)k * 384 + ch], hk = CH[(size_t)k * 384 + ch]; h = ak * h + hk; a *= ak; }
        sA[seg * 128 + chl] = a; sH[seg * 128 + chl] = h;
        __syncthreads();
#pragma unroll
        for (int s = 0; s < 4; ++s) carry = sA[s * 128 + chl] * carry + sH[s * 128 + chl];
    }
    const int T0 = c * 64 + seg * 16;
#pragma unroll 4
    for (int i = 0; i < 16; ++i) {
        const int R = T0 + i;
        float cin = carry;
        if (smp) cin = P->in[I_SRG][((size_t)l * 32 + ((R - SEQ) >> 3)) * 384 + ch];
        const float h = HL[(size_t)R * 384 + ch] + PC[(size_t)R * 384 + ch] * cin;
        const float g = __uint_as_float((unsigned)PJ[(size_t)R * PJP + C_GT + ch] << 16);
        const float y = h * gelu_tanh(g);
        MIX[(size_t)R * DM + 640 + ch] = (bf16_t)(pk2(y, 0.f) & 0xffffu);
        if (R == SEQ - 1) P->out[OFF_PRG + l * 384 + ch] = h;
        if (smp && ((R - SEQ) & 7) == 7) P->out[OFF_SRG + ((size_t)l * 32 + ((R - SEQ) >> 3)) * 384 + ch] = h;
    }
    __syncthreads();
}

__device__ __forceinline__ s16x4 vtr(const LAS unsigned char* p) { return __builtin_bit_cast(s16x4, __builtin_amdgcn_ds_read_tr16_b64_v4i16((LAS s16x4*)p)); }

constexpr int VRP = 144;
constexpr int ATT_STEPS = 23;
__device__ __forceinline__ void att_step_info(int st, int& sh, int& s) { if (st < 12) { sh = 0; s = st; } else if (st < 18) { sh = 2; s = st - 12; } else { sh = 4; s = st - 18; } }

__device__ __forceinline__ void attn_tile(KP P, int wt, int lane, LAS unsigned char* vl) {
    const int r = wt & 15, hh = (wt >> 4) % 6, pb = wt / 96, p0 = pb * 256 + r, fr = lane & 15, fq = lane >> 4;
    const bf16_t* PJ = (const bf16_t*)(P->ws + WS_PJ); bf16_t* MIX = (bf16_t*)(P->ws + WS_MIX);
    const bf16_t* qp = PJ + (size_t)(p0 + 16 * fr) * PJP + C_Q + 64 * hh + 8 * fq;
    const bf16x8 qf0 = *(const bf16x8*)qp, qf1 = *(const bf16x8*)(qp + 32);
    const bf16_t* Kb = PJ + C_K + 64 * hh + 8 * fq;
    const bf16_t* Vb = PJ + C_V + 64 * hh + 32 * (lane & 1);
    float m = -1e30f, lsum = 0.f;
    f32x4 o[4];
#pragma unroll
    for (int dt = 0; dt < 4; ++dt) o[dt] = (f32x4){0.f, 0.f, 0.f, 0.f};
    LAS unsigned char* vw = vl + (lane >> 1) * VRP + (lane & 1) * 64;
    const LAS unsigned char* vr = vl + (4 * fq + (fr >> 2)) * VRP + (fr & 3) * 8;
    bf16x8 kf[2][2];
    {
        int sh, s; att_step_info(0, sh, s);
#pragma unroll
        for (int kt = 0; kt < 2; ++kt) { int pk = p0 - (128 << sh) + ((32 * s + 16 * kt + fr) << sh); pk = pk < 0 ? 0 : (pk > MT - 1 ? MT - 1 : pk);
            kf[kt][0] = *(const bf16x8*)(Kb + (size_t)pk * PJP); kf[kt][1] = *(const bf16x8*)(Kb + (size_t)pk * PJP + 32); }
    }
#pragma unroll 1
    for (int st = 0; st < ATT_STEPS; ++st) {
        int sh, s; att_step_info(st, sh, s);
        const int kbase = p0 - (128 << sh);
        u32x4 vreg[4];
        { int pk = kbase + ((32 * s + (lane >> 1)) << sh); pk = pk < 0 ? 0 : (pk > MT - 1 ? MT - 1 : pk);
#pragma unroll
          for (int i = 0; i < 4; ++i) vreg[i] = *(const u32x4*)(Vb + (size_t)pk * PJP + 8 * i); }
        f32x4 sc[2];
#pragma unroll
        for (int kt = 0; kt < 2; ++kt) {
            sc[kt] = __builtin_amdgcn_mfma_f32_16x16x32_bf16(kf[kt][0], qf0, (f32x4){0.f, 0.f, 0.f, 0.f}, 0, 0, 0);
            sc[kt] = __builtin_amdgcn_mfma_f32_16x16x32_bf16(kf[kt][1], qf1, sc[kt], 0, 0, 0);
        }
        if (st + 1 < ATT_STEPS) {
            int sh2, s2; att_step_info(st + 1, sh2, s2);
#pragma unroll
            for (int kt = 0; kt < 2; ++kt) { int pk = p0 - (128 << sh2) + ((32 * s2 + 16 * kt + fr) << sh2); pk = pk < 0 ? 0 : (pk > MT - 1 ? MT - 1 : pk);
                kf[kt][0] = *(const bf16x8*)(Kb + (size_t)pk * PJP); kf[kt][1] = *(const bf16x8*)(Kb + (size_t)pk * PJP + 32); }
        }
        const int qe = ((16 >> sh) * fr) + 128;
        float mx = -INFINITY;
#pragma unroll
        for (int kt = 0; kt < 2; ++kt)
#pragma unroll
            for (int i = 0; i < 4; ++i) {
                const int j = 32 * s + 16 * kt + 4 * fq + i, e = qe - j, pk = kbase + (j << sh);
                const bool ok = (e >= 0) && (e <= 128) && (pk >= 0);
                sc[kt][i] = ok ? sc[kt][i] : -INFINITY;
                mx = fmaxf(mx, sc[kt][i]);
            }
        mx = fmaxf(mx, __shfl_xor(mx, 16)); mx = fmaxf(mx, __shfl_xor(mx, 32));
        const float mn = fmaxf(m, mx), al = fexp2(m - mn);
        m = mn;
        float ps = 0.f;
#pragma unroll
        for (int kt = 0; kt < 2; ++kt)
#pragma unroll
            for (int i = 0; i < 4; ++i) { sc[kt][i] = fexp2(sc[kt][i] - mn); ps += sc[kt][i]; }
        lsum = lsum * al + ps;
        u32x4 pw; pw.x = pk2(sc[0][0], sc[0][1]); pw.y = pk2(sc[0][2], sc[0][3]); pw.z = pk2(sc[1][0], sc[1][1]); pw.w = pk2(sc[1][2], sc[1][3]);
        const bf16x8 pb8 = __builtin_bit_cast(bf16x8, pw);
#pragma unroll
        for (int i = 0; i < 4; ++i) *(LAS u32x4*)(vw + 16 * i) = vreg[i];
#pragma unroll
        for (int dt = 0; dt < 4; ++dt) {
            const s16x4 lo = vtr(vr + dt * 32), hi = vtr(vr + 16 * VRP + dt * 32);
            const bf16x8 vf = __builtin_shufflevector(lo, hi, 0, 1, 2, 3, 4, 5, 6, 7);
            o[dt] = o[dt] * al;
            o[dt] = __builtin_amdgcn_mfma_f32_16x16x32_bf16(vf, pb8, o[dt], 0, 0, 0);
        }
    }
    lsum += __shfl_xor(lsum, 16); lsum += __shfl_xor(lsum, 32);
    const float inv = 1.0f / lsum;
    bf16_t* op = MIX + (size_t)(p0 + 16 * fr) * DM + 64 * hh + 4 * fq;
#pragma unroll
    for (int dt = 0; dt < 4; ++dt) *(u32x2*)(op + 16 * dt) = f4_to_bf4(o[dt] * inv);
}

__device__ __forceinline__ void sattn_task(KP P, int l, int task, int lane) {
    const int t = task & 7, bh = task >> 3, hh = bh % 6, b = bh / 6, li = lane & 15, g = lane >> 4;
    const bf16_t* PJ = (const bf16_t*)(P->ws + WS_PJ); bf16_t* MIX = (bf16_t*)(P->ws + WS_MIX);
    const int row = SEQ + 8 * b + t;
    const f32x4 q = bf4_to_f4(*(const u32x2*)(PJ + (size_t)row * PJP + C_Q + 64 * hh + 4 * li));
    const float* ck = P->in[I_CK] + ((size_t)l * 32 + b) * 2048 * 384 + 64 * hh + 4 * li;
    const float* cv = P->in[I_CV] + ((size_t)l * 32 + b) * 2048 * 384 + 64 * hh + 4 * li;
    const float* sk = P->out + OFF_SWK + ((size_t)l * 32 + b) * 2048 * 384 + 64 * hh + 4 * li;
    const float* sv = P->out + OFF_SWV + ((size_t)l * 32 + b) * 2048 * 384 + 64 * hh + 4 * li;
    float m = -1e30f, lsum = 0.f; f32x4 o = (f32x4){0.f, 0.f, 0.f, 0.f};
#pragma unroll 8
    for (int it = 0; it < 104; ++it) {
        const int jj = it * 4 + g; const bool valid = jj < 387; const int jc = valid ? jj : 386;
        const int pat = jc >= 258 ? 2 : (jc >= 129 ? 1 : 0), j = jc - 129 * pat;
        const int idx = 2048 + t - (j << (2 * pat));
        const f32x4 kv = *(const f32x4*)(idx < 2048 ? ck + (size_t)idx * 384 : sk + (size_t)(idx - 8) * 384);
        const f32x4 vv = *(const f32x4*)(idx < 2048 ? cv + (size_t)idx * 384 : sv + (size_t)(idx - 8) * 384);
        float s = (q[0] * kv[0] + q[1] * kv[1]) + (q[2] * kv[2] + q[3] * kv[3]);
        s += __shfl_xor(s, 1); s += __shfl_xor(s, 2); s += __shfl_xor(s, 4); s += __shfl_xor(s, 8);
        if (!valid) s = -INFINITY;
        const float mn = fmaxf(m, s), al = fexp2(m - mn), p = fexp2(s - mn);
        lsum = lsum * al + p; o = o * al + vv * p; m = mn;
    }
    float M = fmaxf(m, __shfl_xor(m, 16)); M = fmaxf(M, __shfl_xor(M, 32));
    const float scl = fexp2(m - M);
    lsum *= scl; o = o * scl;
    lsum += __shfl_xor(lsum, 16); lsum += __shfl_xor(lsum, 32);
#pragma unroll
    for (int i = 0; i < 4; ++i) { o[i] += __shfl_xor(o[i], 16); o[i] += __shfl_xor(o[i], 32); }
    if (g == 0) *(u32x2*)(MIX + (size_t)row * DM + 64 * hh + 4 * li) = f4_to_bf4(o * (1.0f / lsum));
}

__device__ __forceinline__ void phase3(KP P, int l, LAS unsigned char* lds) {
    const int tid = opaque_tid(), lane = tid & 63, wave = tid >> 6;
    const int gw = blockIdx.x * 8 + wave, NGW = gridDim.x * 8;
    for (int t = blockIdx.x; t < NCH * 3; t += gridDim.x) rglru_fix_task(P, l, t, lds);
    LAS unsigned char* vl = lds + 4096 + wave * (32 * VRP);
    for (int t = gw; t < 1536; t += NGW) sattn_task(P, l, t, lane);
    for (int t = gw; t < 6144; t += NGW) attn_tile(P, t, lane, vl);
}

__device__ __forceinline__ void final_norm(KP P) {
    const int tid = opaque_tid(), lane = tid & 63, wave = tid >> 6;
    const int gw = blockIdx.x * 8 + wave, NGW = gridDim.x * 8;
    const float* X = (const float*)(P->ws + WS_X); const float* rss = (const float*)(P->ws + WS_RSS) + 4 * MT;
    for (int row = gw; row < MT; row += NGW) {
        const float rs = rsqrtf(rss[row] * (1.0f / DM) + EPS);
#pragma unroll
        for (int j = 0; j < 4; ++j) {
            const int c = 4 * lane + 256 * j;
            const f32x4 v = *(const f32x4*)(X + (size_t)row * DM + c) * rs * *(const f32x4*)(P->in[I_FING] + c);
            *(f32x4*)(P->out + (size_t)row * DM + c) = v;
        }
    }
}

__global__ void __launch_bounds__(512) mega_fwd(Params Pval) {
    extern __shared__ __attribute__((aligned(16))) unsigned char lds_raw[];
    LAS unsigned char* lds = (LAS unsigned char*)lds_raw;
    cg::grid_group grid = cg::this_grid();
    prologue(kargs(), lds);
    grid.sync();
#pragma unroll 1
    for (int l = 0; l < 2; ++l) {
        {
            KP P = kargs(); unsigned char* ws = P->ws; float* rss = (float*)(ws + WS_RSS);
            pg8::Gemm g{(const bf16_t*)(ws + WS_XB), (const bf16_t*)(ws + WS_WIN) + (size_t)l * DINP * DM, MT, DINP, DM}; pg8::StaticOrder S; S.init(MT, DINP, gridDim.x, blockIdx.x);
            EpiInProj E{(bf16_t*)(ws + WS_PJ), rss + (size_t)(2 * l) * MT, (const float*)(ws + WS_ROPE), P->out, l};
            pg8::gemm_phase<EpiInProj, pg8::StaticOrder, true, true>(lds, g, S, E);
        }
        grid.sync();
        phase2(kargs(), l);
        grid.sync();
        phase3(kargs(), l, lds);
        grid.sync();
        {
            KP P = kargs(); unsigned char* ws = P->ws; float* rss = (float*)(ws + WS_RSS); float* X = (float*)(ws + WS_X);
            pg8::Gemm g{(const bf16_t*)(ws + WS_MIX), (const bf16_t*)(ws + WS_WOUT) + (size_t)l * DM * DM, MT, DM, DM}; pg8::StaticOrder S; S.init(MT, DM, gridDim.x, blockIdx.x);
            EpiResid E{l == 0 ? P->in[I_XP] : X, l == 0 ? P->in[I_XS] : X + (size_t)SEQ * DM, X, (bf16_t*)(ws + WS_XB), rss + (size_t)(2 * l + 1) * MT};
            pg8::gemm_phase<EpiResid, pg8::StaticOrder, true, true>(lds, g, S, E);
        }
        grid.sync();
        {
            KP P = kargs(); unsigned char* ws = P->ws; float* rss = (float*)(ws + WS_RSS);
            pg8::Gemm g{(const bf16_t*)(ws + WS_XB), (const bf16_t*)(ws + WS_WGU) + (size_t)l * NGU * DM, MT, NGU, DM}; pg8::StaticOrder S; S.init(MT, NGU, gridDim.x, blockIdx.x);
            EpiGateUp E{(bf16_t*)(ws + WS_HB), rss + (size_t)(2 * l + 1) * MT};
            pg8::gemm_phase<EpiGateUp, pg8::StaticOrder, true, true>(lds, g, S, E);
        }
        grid.sync();
        {
            KP P = kargs(); unsigned char* ws = P->ws; float* rss = (float*)(ws + WS_RSS); float* X = (float*)(ws + WS_X);
            pg8::Gemm g{(const bf16_t*)(ws + WS_HB), (const bf16_t*)(ws + WS_WDN) + (size_t)l * DM * DFF, MT, DM, DFF}; pg8::StaticOrder S; S.init(MT, DM, gridDim.x, blockIdx.x);
            EpiResid E{X, X + (size_t)SEQ * DM, X, (bf16_t*)(ws + WS_XB), rss + (size_t)(2 * l + 2) * MT};
            pg8::gemm_phase<EpiResid, pg8::StaticOrder, true, true>(lds, g, S, E);
        }
        grid.sync();
    }
    final_norm(kargs());
}

constexpr int LDS_BYTES = pg8::STAGE_BYTES;

extern "C" void kernel_launch(void* const* d_in, const int* in_sizes, int n_in, void* d_out, int out_size, void* d_ws, size_t ws_size, hipStream_t stream) {
    static int grid = 0;
    if (grid == 0) {
        if (n_in != 23 || (size_t)out_size != OUT_TOTAL || ws_size < WS_END) { fprintf(stderr, "kernel_launch: unexpected shapes (n_in %d out %d ws %zu need %zu)\n", n_in, out_size, ws_size, (size_t)WS_END); grid = -1; return; }
        int dev = 0, cus = 0, per_cu = 0;
        hipGetDevice(&dev); hipDeviceGetAttribute(&cus, hipDeviceAttributeMultiprocessorCount, dev);
        hipFuncSetAttribute((const void*)mega_fwd, hipFuncAttributeMaxDynamicSharedMemorySize, LDS_BYTES);
        hipOccupancyMaxActiveBlocksPerMultiprocessor(&per_cu, (const void*)mega_fwd, 512, LDS_BYTES);
        if (per_cu < 1) { fprintf(stderr, "kernel_launch: occupancy query says %d blocks/CU\n", per_cu); per_cu = 1; }
        grid = cus * 1;
        (void)hipGetLastError();
    }
    if (grid < 0) return;
    Params p{};
    for (int i = 0; i < 23; ++i) p.in[i] = (const float*)d_in[i];
    p.out = (float*)d_out; p.ws = (unsigned char*)d_ws;
    void* args[] = {&p};
    hipError_t e = hipLaunchCooperativeKernel((const void*)mega_fwd, dim3(grid), dim3(512), args, LDS_BYTES, stream);
    if (e != hipSuccess) fprintf(stderr, "cooperative launch failed: %s (grid %d)\n", hipGetErrorString(e), grid);
}
```

```cpp
#include <hip/hip_runtime.h>
#include <hip/hip_cooperative_groups.h>
#include <cstdio>
#include <cstdint>
namespace cg = cooperative_groups;
namespace pg8 {
#define PG8_LAS __attribute__((address_space(3)))
typedef unsigned short bf16_t;
typedef short bf16x8 __attribute__((ext_vector_type(8)));
typedef float f32x4 __attribute__((ext_vector_type(4)));
typedef unsigned u32x4 __attribute__((ext_vector_type(4)));
constexpr int BM = 256, BK = 64, HALF = 128, HTB = HALF * BK * 2  , STAGE_BYTES = 8 * HTB, NXCD = 8, WGM = 8;

__host__ __device__ __forceinline__ int lds_byte(int r, int c) { const int st = (r >> 4) * 2 + (c >> 5), rr = r & 15, cc = c & 31, ob = rr * 64 + cc * 2; return st * 1024 + (ob ^ (((ob >> 9) & 1) << 5)); }
__host__ __device__ __forceinline__ void stage_rc(int b, int& R, int& C) { const int st = b / 1024, sb = b % 1024, swz = sb ^ (((sb >> 9) & 1) << 5); R = (st >> 1) * 16 + swz / 64; C = (st & 1) * 32 + (swz % 64) / 2; }
__host__ __device__ __forceinline__ int perm32(int rho) { const int n = rho >> 4, i = rho & 15; return 8 * (i >> 2) + 4 * n + (i & 3); }

struct Unit { int pm, pn; };
struct Gemm { const bf16_t* A; const bf16_t* Bt; int M, N, K; };

struct StaticOrder {
    int nM, nN, nwg, G, c;
    __host__ __device__ void init(int M, int N, int G_, int c_) { nM = M / BM; nN = N / BM; nwg = nM * nN; G = G_; c = c_; }
    __host__ __device__ bool next(int i, Unit& u) const {
        const long L = (long)i * G + c; if (L >= nwg) return false;
        int wgid = (int)L; { const int q = nwg / NXCD, r = nwg % NXCD, xcd = wgid % NXCD, off = wgid / NXCD; wgid = (xcd < r ? xcd * (q + 1) : r * (q + 1) + (xcd - r) * q) + off; }
        const int nig = WGM * nN, gid = wgid / nig, fm = gid * WGM, gsz = (nM - fm) < WGM ? (nM - fm) : WGM;
        u.pm = fm + ((wgid % nig) % gsz); u.pn = (wgid % nig) / gsz; return true;
    }
    __device__ __forceinline__ void a_ready(const Unit&) const {}
    __device__ __forceinline__ void done(const Unit&) const {}
};

__device__ __forceinline__ unsigned cvt_pk_bf16(float lo, float hi) { unsigned r; asm volatile("v_cvt_pk_bf16_f32 %0, %1, %2" : "=v"(r) : "v"(lo), "v"(hi)); return r; }
template <class Epi, class Sched, bool ALIGN_EPI = false, bool SP2 = false>
__device__ __forceinline__ void gemm_phase(PG8_LAS unsigned char* lds, const Gemm g, const Sched& S, const Epi& E) {
    int tid_ = threadIdx.x; asm volatile("" : "+v"(tid_));
    const int tid = tid_, wid = __builtin_amdgcn_readfirstlane(tid >> 6), lane = tid & 63, wr = wid >> 2, wc = wid & 3, fr = lane & 15, fq = lane >> 4;
    const int K = g.K, nt = K / BK;
    unsigned voffA[2], voffB[2];
#pragma unroll
    for (int i = 0; i < 2; ++i) { int R, C; stage_rc(tid * 16 + i * 8192, R, C); const int Rb = Epi::PERM ? ((R & ~31) + perm32(R & 31)) : R;
        voffA[i] = (unsigned)(R * K + C) * 2u; voffB[i] = (unsigned)(Rb * K + C) * 2u; }
    const size_t kstep = (size_t)(BK * 2);
    const size_t hstep = (size_t)HALF * K * 2;
    const size_t tstep = 2 * hstep;
    const unsigned ldsw = (unsigned)wid * 1024u;
    const int aoff = lds_byte(wr * 64 + fr, fq * 8), boff = lds_byte(wc * 32 + fr, fq * 8);
#define PG8_SA(b, h) (((b) * 2 + (h)) * HTB)
#define PG8_SB(b, h) ((4 + (b) * 2 + (h)) * HTB)
#define PG8_STAGE(bufoff, gbase, voff) do { _Pragma("unroll") for (int _i = 0; _i < 2; ++_i) \
        __builtin_amdgcn_global_load_lds((const unsigned*)((const char*)(gbase) + (voff)[_i]), (PG8_LAS unsigned*)(lds + (bufoff) + ldsw + _i * 8192), 16, 0, 0); } while (0)
#define PG8_LDA(dst, b, h) do { _Pragma("unroll") for (int m = 0; m < 4; ++m) _Pragma("unroll") for (int k = 0; k < 2; ++k) dst[m][k] = *(const PG8_LAS bf16x8*)(lds + PG8_SA(b, h) + aoff + m * 2048 + k * 1024); } while (0)
#define PG8_LDB(dst, b, h) do { _Pragma("unroll") for (int n = 0; n < 2; ++n) _Pragma("unroll") for (int k = 0; k < 2; ++k) dst[n][k] = *(const PG8_LAS bf16x8*)(lds + PG8_SB(b, h) + boff + n * 2048 + k * 1024); } while (0)
#define PG8_MMA(ai, bj, At, Bt) do { __builtin_amdgcn_s_setprio(1); _Pragma("unroll") for (int m = 0; m < 4; ++m) _Pragma("unroll") for (int n = 0; n < 2; ++n) _Pragma("unroll") for (int k = 0; k < 2; ++k) \
        acc[ai][bj][m][n] = __builtin_amdgcn_mfma_f32_16x16x32_bf16(Bt[n][k], At[m][k], acc[ai][bj][m][n], 0, 0, 0); __builtin_amdgcn_s_setprio(0); } while (0)
#define PG8_WAIT_V(n) asm volatile("s_waitcnt vmcnt(" #n ")" ::: "memory")
#define PG8_WAIT_L(n) asm volatile("s_waitcnt lgkmcnt(" #n ")" ::: "memory")
#define PG8_BAR __builtin_amdgcn_s_barrier()
#define PG8_SCHED __builtin_amdgcn_sched_barrier(0)
    Unit cur, nxt; int ui = 0;
    if (!S.next(0, cur)) return;
    f32x4 acc[2][2][4][2];
#pragma unroll
    for (int a = 0; a < 2; ++a)
#pragma unroll
        for (int b = 0; b < 2; ++b)
#pragma unroll
            for (int m = 0; m < 4; ++m)
#pragma unroll
                for (int n = 0; n < 2; ++n) acc[a][b][m][n] = (f32x4){0.f, 0.f, 0.f, 0.f};
    bf16x8 At[4][2], B0[2][2], B1[2][2];
    const char* cA = (const char*)g.A + (size_t)cur.pm * tstep; const char* cB = (const char*)g.Bt + (size_t)cur.pn * tstep;
    S.a_ready(cur);
    if constexpr (SP2) {
        PG8_STAGE(PG8_SB(0, 0), cB, voffB); PG8_STAGE(PG8_SB(0, 1), cB + hstep, voffB); PG8_STAGE(PG8_SA(0, 0), cA, voffA); PG8_STAGE(PG8_SA(0, 1), cA + hstep, voffA);
        if (wr == 1) PG8_BAR;
        PG8_WAIT_V(2); PG8_BAR;
        PG8_STAGE(PG8_SB(1, 0), cB + kstep, voffB); PG8_STAGE(PG8_SA(1, 0), cA + kstep, voffA); PG8_STAGE(PG8_SB(1, 1), cB + hstep + kstep, voffB);
        PG8_WAIT_V(6); PG8_BAR;
    } else {
        PG8_STAGE(PG8_SB(0, 0), cB, voffB); PG8_STAGE(PG8_SA(0, 0), cA, voffA); PG8_STAGE(PG8_SB(0, 1), cB + hstep, voffB); PG8_STAGE(PG8_SA(0, 1), cA + hstep, voffA);
        if (wr == 1) PG8_BAR;
        PG8_WAIT_V(4); PG8_BAR;
        PG8_STAGE(PG8_SB(1, 0), cB + kstep, voffB); PG8_STAGE(PG8_SA(1, 0), cA + kstep, voffA); PG8_STAGE(PG8_SB(1, 1), cB + hstep + kstep, voffB);
        PG8_WAIT_V(6); PG8_BAR;
    }
    for (;;) {
        const bool has_next = S.next(ui + 1, nxt);
        const char* nA = has_next ? (const char*)g.A + (size_t)nxt.pm * tstep : cA; const char* nB = has_next ? (const char*)g.Bt + (size_t)nxt.pn * tstep : cB;
        for (int t = 0; t < nt; t += 2) {
            const bool last = (t == nt - 2);
            const char* a1 = cA + (size_t)(t + 1) * kstep;
            const char* a2 = last ? nA : cA + (size_t)(t + 2) * kstep; const char* b2 = last ? nB : cB + (size_t)(t + 2) * kstep;
            const char* a3 = a2 + kstep; const char* b3 = b2 + kstep;
            if (last && has_next) S.a_ready(nxt);
            if constexpr (SP2) {
            PG8_LDB(B0, 0, 0); PG8_LDB(B1, 0, 1); PG8_SCHED; PG8_LDA(At, 0, 0); PG8_STAGE(PG8_SA(1, 1), a1 + hstep, voffA);
            PG8_WAIT_V(8); PG8_WAIT_L(0); PG8_BAR; PG8_MMA(0, 0, At, B0); PG8_MMA(0, 1, At, B1); PG8_BAR; PG8_SCHED;
            PG8_LDA(At, 0, 1); PG8_STAGE(PG8_SB(0, 0), b2, voffB); PG8_STAGE(PG8_SB(0, 1), b2 + hstep, voffB); PG8_STAGE(PG8_SA(0, 0), a2, voffA);
            PG8_WAIT_V(8); PG8_WAIT_L(0); PG8_BAR; PG8_MMA(1, 0, At, B0); PG8_MMA(1, 1, At, B1); PG8_BAR; PG8_SCHED;
            PG8_LDB(B0, 1, 0); PG8_LDB(B1, 1, 1); PG8_SCHED; PG8_LDA(At, 1, 0); PG8_STAGE(PG8_SA(0, 1), a2 + hstep, voffA);
            PG8_WAIT_V(8); PG8_WAIT_L(0); PG8_BAR; PG8_MMA(0, 0, At, B0); PG8_MMA(0, 1, At, B1); PG8_BAR; PG8_SCHED;
            PG8_LDA(At, 1, 1); PG8_STAGE(PG8_SB(1, 0), b3, voffB); PG8_STAGE(PG8_SB(1, 1), b3 + hstep, voffB); PG8_STAGE(PG8_SA(1, 0), a3, voffA);
            PG8_WAIT_V(8); PG8_WAIT_L(0); PG8_BAR; PG8_MMA(1, 0, At, B0); PG8_MMA(1, 1, At, B1); PG8_BAR; PG8_SCHED;
            } else {
            PG8_LDB(B0, 0, 0); PG8_SCHED; PG8_LDA(At, 0, 0); PG8_STAGE(PG8_SA(1, 1), a1 + hstep, voffA);
            PG8_WAIT_L(8); PG8_BAR; PG8_WAIT_L(0); PG8_MMA(0, 0, At, B0); PG8_BAR; PG8_SCHED;
            PG8_LDB(B1, 0, 1); PG8_STAGE(PG8_SB(0, 0), b2, voffB);
            PG8_BAR; PG8_WAIT_L(0); PG8_MMA(0, 1, At, B1); PG8_BAR;
            PG8_LDA(At, 0, 1); PG8_STAGE(PG8_SA(0, 0), a2, voffA);
            PG8_BAR; PG8_WAIT_L(0); PG8_MMA(1, 0, At, B0); PG8_BAR; PG8_SCHED;
            PG8_STAGE(PG8_SB(0, 1), b2 + hstep, voffB);
            PG8_WAIT_V(6); PG8_BAR; PG8_MMA(1, 1, At, B1); PG8_BAR;
            PG8_LDB(B0, 1, 0); PG8_SCHED; PG8_LDA(At, 1, 0); PG8_STAGE(PG8_SA(0, 1), a2 + hstep, voffA);
            PG8_WAIT_L(8); PG8_BAR; PG8_WAIT_L(0); PG8_MMA(0, 0, At, B0); PG8_BAR; PG8_SCHED;
            PG8_LDB(B1, 1, 1); PG8_STAGE(PG8_SB(1, 0), b3, voffB);
            PG8_BAR; PG8_WAIT_L(0); PG8_MMA(0, 1, At, B1); PG8_BAR;
            PG8_LDA(At, 1, 1); PG8_STAGE(PG8_SA(1, 0), a3, voffA);
            PG8_BAR; PG8_WAIT_L(0); PG8_MMA(1, 0, At, B0); PG8_BAR; PG8_SCHED;
            PG8_STAGE(PG8_SB(1, 1), b3 + hstep, voffB);
            PG8_WAIT_V(6); PG8_BAR; PG8_MMA(1, 1, At, B1); PG8_BAR;
            }
        }
        if constexpr (ALIGN_EPI) { if (wr == 0) PG8_BAR; }
        if constexpr (!Epi::AFTER_DRAIN) { E(acc, cur, wr, wc, fr, fq); S.done(cur); }
        if (!has_next) break;
#pragma unroll
        for (int a = 0; a < 2; ++a)
#pragma unroll
            for (int b = 0; b < 2; ++b)
#pragma unroll
                for (int m = 0; m < 4; ++m)
#pragma unroll
                    for (int n = 0; n < 2; ++n) acc[a][b][m][n] = (f32x4){0.f, 0.f, 0.f, 0.f};
        cur = nxt; cA = nA; cB = nB; ++ui;
        if constexpr (ALIGN_EPI) { if (wr == 1) PG8_BAR; }
    }
    PG8_WAIT_V(0);
    if constexpr (!ALIGN_EPI) { if (wr == 0) PG8_BAR; }
    PG8_BAR;
    if constexpr (Epi::AFTER_DRAIN) { E.fused(acc, cur, wr, wc, fr, fq, lds, wid, lane); S.done(cur); }
#undef PG8_SA
#undef PG8_SB
#undef PG8_STAGE
#undef PG8_LDA
#undef PG8_LDB
#undef PG8_MMA
#undef PG8_WAIT_V
#undef PG8_WAIT_L
#undef PG8_BAR
#undef PG8_SCHED
}
}

using pg8::bf16_t; using pg8::bf16x8; using pg8::f32x4; using pg8::u32x4;
#define LAS __attribute__((address_space(3)))
typedef short s16x4 __attribute__((ext_vector_type(4)));
typedef unsigned u32x2 __attribute__((ext_vector_type(2)));
typedef float f32x2 __attribute__((ext_vector_type(2)));

constexpr int DM = 1024, SEQ = 16384, NSMP = 256, MT = SEQ + NSMP;
constexpr int DIN = 2176, DINP = 2304, DFF = 2816, NGU = 2 * DFF;
constexpr int C_Q = 0, C_K = 384, C_V = 768, C_U = 1152, C_XR = 1408, C_GT = 1792, PJP = 2176;
constexpr int NCH = MT / 64;
constexpr float EPS = 1e-6f;
constexpr float QSCALE = 0.125f * 1.4426950408889634f;

constexpr size_t OFF_YP = 0, OFF_YS = OFF_YP + (size_t)SEQ * DM, OFF_PWK = OFF_YS + (size_t)NSMP * DM, OFF_PWV = OFF_PWK + 2ull * 2048 * 384,
                 OFF_PPOOL = OFF_PWV + 2ull * 2048 * 384, OFF_PCONV = OFF_PPOOL + 2 * 15 * 256, OFF_PRG = OFF_PCONV + 2 * 3 * 384, OFF_SWK = OFF_PRG + 2 * 384,
                 OFF_SWV = OFF_SWK + 2ull * 32 * 2048 * 384, OFF_SPOOL = OFF_SWV + 2ull * 32 * 2048 * 384, OFF_SCONV = OFF_SPOOL + 2 * 32 * 15 * 256,
                 OFF_SRG = OFF_SCONV + 2 * 32 * 3 * 384, OUT_TOTAL = OFF_SRG + 2 * 32 * 384;

constexpr size_t al256(size_t x) { return (x + 255) & ~(size_t)255; }
constexpr size_t WS_WIN = 0;
constexpr size_t WS_WOUT = WS_WIN + al256(2ull * DINP * DM * 2);
constexpr size_t WS_WGU = WS_WOUT + al256(2ull * DM * DM * 2);
constexpr size_t WS_WDN = WS_WGU + al256(2ull * NGU * DM * 2);
constexpr size_t WS_WA = WS_WDN + al256(2ull * DM * DFF * 2);
constexpr size_t WS_WX = WS_WA + al256(2ull * 6 * 64 * 64 * 2);
constexpr size_t WS_WP = WS_WX + al256(2ull * 6 * 64 * 64 * 2);
constexpr size_t WS_ROPE = WS_WP + al256(2ull * 4 * 64 * 64 * 2);
constexpr size_t WS_RSS = WS_ROPE + al256(16392ull * 32 * 8);
constexpr size_t WS_XB = WS_RSS + al256(5ull * MT * 4);
constexpr size_t WS_PJ = WS_XB + al256((size_t)MT * DM * 2);
constexpr size_t WS_HL = WS_PJ + al256((size_t)MT * PJP * 2);
constexpr size_t WS_PC = WS_HL + al256((size_t)MT * 384 * 4);
constexpr size_t WS_CA = WS_PC + al256((size_t)MT * 384 * 4);
constexpr size_t WS_CH = WS_CA + al256((size_t)NCH * 384 * 4);
constexpr size_t WS_MIX = WS_CH + al256((size_t)NCH * 384 * 4);
constexpr size_t WS_X = WS_MIX + al256((size_t)MT * DM * 2);
constexpr size_t WS_HB = WS_X + al256((size_t)MT * DM * 4);
constexpr size_t WS_BAR = WS_HB + al256((size_t)MT * DFF * 2);
constexpr size_t WS_END = WS_BAR + 16384;

struct Params { const float* in[23]; float* out; unsigned char* ws; };
typedef const __attribute__((address_space(4))) Params* KP;
__device__ __forceinline__ KP kargs() { auto p = __builtin_amdgcn_kernarg_segment_ptr(); asm volatile("" : "+s"(p)); return (KP)p; }
enum { I_XP = 0, I_XS, I_CK, I_CV, I_SPOOL, I_SCONV, I_SRG, I_N1G, I_WIN, I_POOLW, I_POOLS, I_CONVW, I_CONVB, I_GAW, I_GAB, I_GXW, I_GXB, I_LAM, I_WOUT, I_N2G, I_WGU, I_WDN, I_FING };

__device__ __forceinline__ int opaque_tid() { int t = threadIdx.x; asm volatile("" : "+v"(t)); return t; }
__device__ __forceinline__ unsigned pk2(float lo, float hi) { return pg8::cvt_pk_bf16(lo, hi); }
__device__ __forceinline__ float bf_lo(unsigned w) { return __uint_as_float(w << 16); }
__device__ __forceinline__ float bf_hi(unsigned w) { return __uint_as_float(w & 0xffff0000u); }
__device__ __forceinline__ f32x4 bf4_to_f4(u32x2 w) { return (f32x4){bf_lo(w.x), bf_hi(w.x), bf_lo(w.y), bf_hi(w.y)}; }
__device__ __forceinline__ u32x2 f4_to_bf4(f32x4 v) { u32x2 w; w.x = pk2(v[0], v[1]); w.y = pk2(v[2], v[3]); return w; }
__device__ __forceinline__ float wave_sum(float v) {
#pragma unroll
    for (int o = 1; o < 64; o <<= 1) v += __shfl_xor(v, o);
    return v;
}
__device__ __forceinline__ float fexp2(float x) { return __builtin_amdgcn_exp2f(x); }
__device__ __forceinline__ float sigmoidf_(float x) { return 1.0f / (1.0f + __expf(-x)); }
__device__ __forceinline__ float gelu_tanh(float x) { const float z = 0.7978845608028654f * (x + 0.044715f * x * x * x); const float e = __expf(2.0f * z); return 0.5f * x * (2.0f - 2.0f / (e + 1.0f)); }

struct EpiInProj {
    static constexpr bool PERM = true, AFTER_DRAIN = false;
    bf16_t* PJ; const float* rss; const float* rope;
    __device__ __forceinline__ void operator()(const f32x4 (&acc)[2][2][4][2], const pg8::Unit& u, int wr, int wc, int fr_, int fq_) const {
        int fr = fr_, fq = fq_; asm volatile("" : "+v"(fr), "+v"(fq));
#pragma unroll
        for (int bj = 0; bj < 2; ++bj) {
            const int cb = u.pn * 256 + bj * 128;
            if (cb >= DIN) continue;
            const int c0 = cb + wc * 32 + fq * 8;
            if (cb < C_V) {
                const bool isk = cb >= C_K; const int sb = isk ? C_K : 0; const int o = c0 - sb; const int hb = o & ~63; const int j0 = (o & 63) >> 1;
                const float qs = isk ? 1.0f : QSCALE;
#pragma unroll
                for (int ai = 0; ai < 2; ++ai)
#pragma unroll
                    for (int m = 0; m < 4; ++m) {
                        const int row = u.pm * 256 + ai * 128 + wr * 64 + m * 16 + fr;
                        const int pos = row < SEQ ? row : SEQ + ((row - SEQ) & 7);
                        const f32x4 t0 = *(const f32x4*)(rope + ((size_t)pos * 32 + j0) * 2), t1 = *(const f32x4*)(rope + ((size_t)pos * 32 + j0) * 2 + 4);
                        const float rsv = rsqrtf(rss[row] * (1.0f / DM) + EPS) * qs;
                        const f32x4 v0 = acc[ai][bj][m][0] * rsv, v1 = acc[ai][bj][m][1] * rsv;
                        f32x4 o1, o2;
                        o1[0] = v0[0] * t0[0] - v0[1] * t0[1]; o2[0] = v0[1] * t0[0] + v0[0] * t0[1];
                        o1[1] = v0[2] * t0[2] - v0[3] * t0[3]; o2[1] = v0[3] * t0[2] + v0[2] * t0[3];
                        o1[2] = v1[0] * t1[0] - v1[1] * t1[1]; o2[2] = v1[1] * t1[0] + v1[0] * t1[1];
                        o1[3] = v1[2] * t1[2] - v1[3] * t1[3]; o2[3] = v1[3] * t1[2] + v1[2] * t1[3];
                        bf16_t* pj = PJ + (size_t)row * PJP + sb + hb + j0;
                        *(u32x2*)pj = f4_to_bf4(o1); *(u32x2*)(pj + 32) = f4_to_bf4(o2);
                    }
            } else {
#pragma unroll
                for (int ai = 0; ai < 2; ++ai)
#pragma unroll
                    for (int m = 0; m < 4; ++m) {
                        const int row = u.pm * 256 + ai * 128 + wr * 64 + m * 16 + fr;
                        const float rsv = rsqrtf(rss[row] * (1.0f / DM) + EPS);
                        const f32x4 v0 = acc[ai][bj][m][0] * rsv, v1 = acc[ai][bj][m][1] * rsv;
                        u32x4 w; w.x = pk2(v0[0], v0[1]); w.y = pk2(v0[2], v0[3]); w.z = pk2(v1[0], v1[1]); w.w = pk2(v1[2], v1[3]);
                        *(u32x4*)(PJ + (size_t)row * PJP + c0) = w;
                    }
            }
        }
    }
};

struct EpiResid {
    static constexpr bool PERM = false, AFTER_DRAIN = false;
    const float* base_p; const float* base_s; float* X; bf16_t* XB; float* rss_out;
    __device__ __forceinline__ void operator()(const f32x4 (&acc)[2][2][4][2], const pg8::Unit& u, int wr, int wc, int fr, int fq) const {
#pragma unroll
        for (int ai = 0; ai < 2; ++ai)
#pragma unroll
            for (int m = 0; m < 4; ++m) {
                const int row = u.pm * 256 + ai * 128 + wr * 64 + m * 16 + fr;
                const float* b = row < SEQ ? base_p + (size_t)row * DM : base_s + (size_t)(row - SEQ) * DM;
                float ss = 0.f;
#pragma unroll
                for (int bj = 0; bj < 2; ++bj)
#pragma unroll
                    for (int n = 0; n < 2; ++n) {
                        const int col = u.pn * 256 + bj * 128 + wc * 32 + n * 16 + fq * 4;
                        const f32x4 x = *(const f32x4*)(b + col) + acc[ai][bj][m][n];
                        *(f32x4*)(X + (size_t)row * DM + col) = x;
                        *(u32x2*)(XB + (size_t)row * DM + col) = f4_to_bf4(x);
                        ss += (x[0] * x[0] + x[1] * x[1]) + (x[2] * x[2] + x[3] * x[3]);
                    }
                ss += __shfl_xor(ss, 16); ss += __shfl_xor(ss, 32);
                if (fq == 0) unsafeAtomicAdd(rss_out + row, ss);
            }
    }
};

struct EpiGateUp {
    static constexpr bool PERM = true, AFTER_DRAIN = false;
    bf16_t* HB; const float* rss;
    __device__ __forceinline__ void operator()(const f32x4 (&acc)[2][2][4][2], const pg8::Unit& u, int wr, int wc, int fr, int fq) const {
#pragma unroll
        for (int ai = 0; ai < 2; ++ai)
#pragma unroll
            for (int m = 0; m < 4; ++m) {
                const int row = u.pm * 256 + ai * 128 + wr * 64 + m * 16 + fr;
                const float rs = rsqrtf(rss[row] * (1.0f / DM) + EPS);
#pragma unroll
                for (int bj = 0; bj < 2; ++bj) {
                    const int hc = u.pn * 128 + bj * 64 + wc * 16 + fq * 4;
                    const f32x4 g = acc[ai][bj][m][0] * rs, up = acc[ai][bj][m][1] * rs;
                    f32x4 h;
#pragma unroll
                    for (int i = 0; i < 4; ++i) h[i] = g[i] * sigmoidf_(g[i]) * up[i];
                    *(u32x2*)(HB + (size_t)row * DFF + hc) = f4_to_bf4(h);
                }
            }
    }
};

__device__ __forceinline__ int colmap_in(int n) { if (n >= DIN) return -1; if (n >= C_V) return n; const int sb = n >= C_K ? C_K : 0; const int o = n - sb; return sb + (o & ~63) + ((o & 63) >> 1) + 32 * (o & 1); }
__device__ __forceinline__ int colmap_gu(int n) { return ((n >> 3) << 2) + (n & 3) + DFF * ((n >> 2) & 1); }

__device__ __forceinline__ void transpose_item(const float* __restrict__ W, int K, int Nsrc, const float* __restrict__ kscale, bf16_t* WT, int item, int nblk, int mode, LAS float* scr, int lane) {
    const int kb = item / nblk, nb = item - kb * nblk, k0 = 64 * kb, n0 = 32 * nb;
    const int nl = lane & 31, np = n0 + nl;
    const int sc = mode == 1 ? colmap_in(np) : (mode == 2 ? colmap_gu(np) : np);
#pragma unroll 8
    for (int i = 0; i < 32; ++i) {
        const int kk = 2 * i + (lane >> 5); float v = 0.f;
        if (sc >= 0) { v = W[(size_t)(k0 + kk) * Nsrc + sc]; if (kscale) v *= kscale[k0 + kk]; }
        scr[kk * 33 + nl] = v;
    }
    asm volatile("s_waitcnt lgkmcnt(0)" ::: "memory");
    const int c = lane & 7;
#pragma unroll
    for (int j = 0; j < 4; ++j) {
        const int n = (lane >> 3) + 8 * j; const LAS float* s = scr + (8 * c) * 33 + n;
        u32x4 o; o.x = pk2(s[0 * 33], s[1 * 33]); o.y = pk2(s[2 * 33], s[3 * 33]); o.z = pk2(s[4 * 33], s[5 * 33]); o.w = pk2(s[6 * 33], s[7 * 33]);
        *(u32x4*)(WT + (size_t)(n0 + n) * K + k0 + 8 * c) = o;
    }
    asm volatile("s_waitcnt lgkmcnt(0)" ::: "memory");
}

__device__ __forceinline__ void prologue(KP P, LAS unsigned char* lds) {
    const int tid = opaque_tid(), lane = tid & 63, wave = tid >> 6;
    const int gw = blockIdx.x * 8 + wave, NGW = gridDim.x * 8;
    const int gt = blockIdx.x * 512 + tid, NGT = gridDim.x * 512;
    unsigned char* ws = P->ws;
    LAS float* scr = (LAS float*)(lds + wave * 8704);
    constexpr int I_IN = 16 * (DINP / 32), I_OUT = 16 * (DM / 32), I_GU = 16 * (NGU / 32), I_DN = (DFF / 64) * (DM / 32), I_L = I_IN + I_OUT + I_GU + I_DN;
    for (int it = gw; it < 2 * I_L; it += NGW) {
        const int l = it / I_L; int r = it - l * I_L;
        if (r < I_IN) { transpose_item(P->in[I_WIN] + (size_t)l * DM * DIN, DM, DIN, P->in[I_N1G] + l * DM, (bf16_t*)(ws + WS_WIN) + (size_t)l * DINP * DM, r, DINP / 32, 1, scr, lane); continue; } r -= I_IN;
        if (r < I_OUT) { transpose_item(P->in[I_WOUT] + (size_t)l * DM * DM, DM, DM, nullptr, (bf16_t*)(ws + WS_WOUT) + (size_t)l * DM * DM, r, DM / 32, 0, scr, lane); continue; } r -= I_OUT;
        if (r < I_GU) { transpose_item(P->in[I_WGU] + (size_t)l * DM * NGU, DM, NGU, P->in[I_N2G] + l * DM, (bf16_t*)(ws + WS_WGU) + (size_t)l * NGU * DM, r, NGU / 32, 2, scr, lane); continue; } r -= I_GU;
        transpose_item(P->in[I_WDN] + (size_t)l * DFF * DM, DFF, DM, nullptr, (bf16_t*)(ws + WS_WDN) + (size_t)l * DM * DFF, r, DM / 32, 0, scr, lane);
    }
    float* rss = (float*)(ws + WS_RSS);
    bf16_t* XB = (bf16_t*)(ws + WS_XB);
    for (int row = gw; row < MT; row += NGW) {
        const float* xr = row < SEQ ? P->in[I_XP] + (size_t)row * DM : P->in[I_XS] + (size_t)(row - SEQ) * DM;
        float s = 0.f;
#pragma unroll
        for (int j = 0; j < 4; ++j) {
            const f32x4 v = *(const f32x4*)(xr + 4 * lane + 256 * j);
            s += (v[0] * v[0] + v[1] * v[1]) + (v[2] * v[2] + v[3] * v[3]);
            *(u32x2*)(XB + (size_t)row * DM + 4 * lane + 256 * j) = f4_to_bf4(v);
        }
        s = wave_sum(s);
        if (lane == 0) rss[row] = s;
    }
    for (int i = gt; i < 4 * MT; i += NGT) rss[MT + i] = 0.f;
    bf16_t* WA = (bf16_t*)(ws + WS_WA); bf16_t* WX = (bf16_t*)(ws + WS_WX); bf16_t* WP = (bf16_t*)(ws + WS_WP);
    for (int i = gt; i < 2 * 6 * 64 * 64; i += NGT) {
        const int slot = i & 63, d = (i >> 6) & 63, ln = i >> 12;
        const int kk = slot >> 5, q = (slot >> 3) & 3, e = slot & 7, c = 16 * (2 * kk + (e >> 2)) + 4 * q + (e & 3);
        const size_t src = ((size_t)ln * 64 + c) * 64 + d;
        WA[i] = (bf16_t)(pk2(P->in[I_GAW][src], 0.f) & 0xffffu); WX[i] = (bf16_t)(pk2(P->in[I_GXW][src], 0.f) & 0xffffu);
    }
    for (int i = gt; i < 2 * 4 * 64 * 64; i += NGT) {
        const int c = i & 63, d = (i >> 6) & 63, lg = i >> 12;
        WP[i] = (bf16_t)(pk2(P->in[I_POOLW][((size_t)lg * 64 + c) * 64 + d], 0.f) & 0xffffu);
    }
    float* rope = (float*)(ws + WS_ROPE);
    for (int i = gt; i < 16392 * 32; i += NGT) {
        const int pos = i >> 5, j = i & 31;
        const float inv = (float)exp2(-(double)j * (13.287712379549449 / 32.0));
        const float ang = (float)pos * inv;
        double rev = (double)ang * 0.15915494309189535; rev -= floor(rev);
        const float rf = (float)rev;
        rope[2 * (size_t)i] = __builtin_amdgcn_cosf(rf); rope[2 * (size_t)i + 1] = __builtin_amdgcn_sinf(rf);
    }
}

__device__ __forceinline__ void pool_row8(KP P, const bf16_t* PJ, int l, int R, int k, int ch, float (&v)[8]) {
    if (R < SEQ) {
        const int rr = R - k;
        if (rr < 0) {
#pragma unroll
            for (int i = 0; i < 8; ++i) v[i] = 0.f;
            return; }
        const u32x4 w = *(const u32x4*)(PJ + (size_t)rr * PJP + C_U + ch);
        v[0] = bf_lo(w.x); v[1] = bf_hi(w.x); v[2] = bf_lo(w.y); v[3] = bf_hi(w.y); v[4] = bf_lo(w.z); v[5] = bf_hi(w.z); v[6] = bf_lo(w.w); v[7] = bf_hi(w.w);
    } else {
        const int si = R - SEQ, b = si >> 3, t = si & 7, tk = t - k;
        if (tk >= 0) {
            const u32x4 w = *(const u32x4*)(PJ + (size_t)(SEQ + 8 * b + tk) * PJP + C_U + ch);
            v[0] = bf_lo(w.x); v[1] = bf_hi(w.x); v[2] = bf_lo(w.y); v[3] = bf_hi(w.y); v[4] = bf_lo(w.z); v[5] = bf_hi(w.z); v[6] = bf_lo(w.w); v[7] = bf_hi(w.w);
        } else {
            const float* s = P->in[I_SPOOL] + (((size_t)l * 32 + b) * 15 + (15 + tk)) * 256 + ch;
            const f32x4 a = *(const f32x4*)s, c = *(const f32x4*)(s + 4);
            v[0] = a[0]; v[1] = a[1]; v[2] = a[2]; v[3] = a[3]; v[4] = c[0]; v[5] = c[1]; v[6] = c[2]; v[7] = c[3];
        }
    }
}

constexpr int TLP = 136;
__device__ __forceinline__ void pool_task(KP P, int l, int task, int lane, LAS unsigned char* wl) {
    const int g = task & 3, T0 = (task >> 2) * 64, w = 2 << g, fr = lane & 15, fq = lane >> 4;
    const bool smp = T0 >= SEQ;
    const bf16_t* PJ = (const bf16_t*)(P->ws + WS_PJ); bf16_t* MIX = (bf16_t*)(P->ws + WS_MIX);
    const bf16_t* WP = (const bf16_t*)(P->ws + WS_WP) + (size_t)(l * 4 + g) * 4096;
    if (!smp) {
#pragma unroll
        for (int i = 0; i < 10; ++i) {
            const int rr = 8 * i + (lane >> 3), gr = T0 - 15 + rr;
            u32x4 v = (u32x4){0u, 0u, 0u, 0u};
            if (rr < 79 && gr >= 0) v = *(const u32x4*)(PJ + (size_t)gr * PJP + C_U + 64 * g + 8 * (lane & 7));
            if (rr < 79) *(LAS u32x4*)(wl + rr * TLP + 16 * (lane & 7)) = v;
        }
    }
    bf16x8 af[4][2];
#pragma unroll
    for (int dt = 0; dt < 4; ++dt)
#pragma unroll
        for (int kk = 0; kk < 2; ++kk) af[dt][kk] = *(const bf16x8*)(WP + (16 * dt + fr) * 64 + 32 * kk + 8 * fq);
    f32x4 sc[4];
#pragma unroll
    for (int dt = 0; dt < 4; ++dt) sc[dt] = *(const f32x4*)(P->in[I_POOLS] + l * 256 + 64 * g + 16 * dt + 4 * fq);
#pragma unroll 1
    for (int tt = 0; tt < 4; ++tt) {
        const int R = T0 + 16 * tt + fr;
        const int pos1 = R < SEQ ? R + 1 : SEQ + 1;
        const float rc = 1.0f / (float)(pos1 < w ? pos1 : w);
        bf16x8 bfr[2];
#pragma unroll
        for (int kk = 0; kk < 2; ++kk) {
            float s[8], u0[8];
            if (!smp) {
                const LAS unsigned char* rp = wl + (15 + 16 * tt + fr) * TLP + 2 * (32 * kk + 8 * fq);
                { const u32x4 x = *(const LAS u32x4*)rp; u0[0] = bf_lo(x.x); u0[1] = bf_hi(x.x); u0[2] = bf_lo(x.y); u0[3] = bf_hi(x.y); u0[4] = bf_lo(x.z); u0[5] = bf_hi(x.z); u0[6] = bf_lo(x.w); u0[7] = bf_hi(x.w); }
#pragma unroll
                for (int i = 0; i < 8; ++i) s[i] = u0[i];
                for (int k = 1; k < w; ++k) {
                    const u32x4 x = *(const LAS u32x4*)(rp - k * TLP);
                    s[0] += bf_lo(x.x); s[1] += bf_hi(x.x); s[2] += bf_lo(x.y); s[3] += bf_hi(x.y); s[4] += bf_lo(x.z); s[5] += bf_hi(x.z); s[6] += bf_lo(x.w); s[7] += bf_hi(x.w);
                }
            } else {
                const int ch = 64 * g + 32 * kk + 8 * fq;
                pool_row8(P, PJ, l, R, 0, ch, u0);
#pragma unroll
                for (int i = 0; i < 8; ++i) s[i] = u0[i];
                for (int k = 1; k < w; ++k) {
                    float v[8]; pool_row8(P, PJ, l, R, k, ch, v);
#pragma unroll
                    for (int i = 0; i < 8; ++i) s[i] += v[i];
                }
            }
            u32x4 pw;
            pw.x = pk2(s[0] * rc - u0[0], s[1] * rc - u0[1]); pw.y = pk2(s[2] * rc - u0[2], s[3] * rc - u0[3]);
            pw.z = pk2(s[4] * rc - u0[4], s[5] * rc - u0[5]); pw.w = pk2(s[6] * rc - u0[6], s[7] * rc - u0[7]);
            bfr[kk] = __builtin_bit_cast(bf16x8, pw);
        }
#pragma unroll
        for (int dt = 0; dt < 4; ++dt) {
            f32x4 y = (f32x4){0.f, 0.f, 0.f, 0.f};
            y = __builtin_amdgcn_mfma_f32_16x16x32_bf16(af[dt][0], bfr[0], y, 0, 0, 0);
            y = __builtin_amdgcn_mfma_f32_16x16x32_bf16(af[dt][1], bfr[1], y, 0, 0, 0);
            y = y * sc[dt];
            *(u32x2*)(MIX + (size_t)R * DM + 384 + 64 * g + 16 * dt + 4 * fq) = f4_to_bf4(y);
        }
    }
}

__device__ __forceinline__ void rglru_local_task(KP P, int l, int task, int lane, LAS unsigned char* wl) {
    const int c64 = task / 6, n = task - 6 * c64, T0 = c64 * 64, fr = lane & 15, fq = lane >> 4;
    const bool smp = T0 >= SEQ;
    const bf16_t* PJ = (const bf16_t*)(P->ws + WS_PJ);
    float* HL = (float*)(P->ws + WS_HL); float* PC = (float*)(P->ws + WS_PC);
    const bf16_t* WA = (const bf16_t*)(P->ws + WS_WA) + (size_t)(l * 6 + n) * 4096; const bf16_t* WX = (const bf16_t*)(P->ws + WS_WX) + (size_t)(l * 6 + n) * 4096;
    LAS float* cst = (LAS float*)(wl + 12288);
    if (!smp) {
#pragma unroll
        for (int i = 0; i < 9; ++i) {
            const int rr = 8 * i + (lane >> 3), gr = T0 - 3 + rr;
            u32x4 v = (u32x4){0u, 0u, 0u, 0u};
            if (rr < 67 && gr >= 0) v = *(const u32x4*)(PJ + (size_t)gr * PJP + C_XR + 64 * n + 8 * (lane & 7));
            if (rr < 67) *(LAS u32x4*)(wl + rr * TLP + 16 * (lane & 7)) = v;
        }
    } else {
        for (int i = 0; i < 11; ++i) {
            const int rr = 8 * i + (lane >> 3), bb = rr / 11, k = rr - 11 * bb, b = ((T0 - SEQ) >> 3) + bb, c8 = 64 * n + 8 * (lane & 7);
            u32x4 v;
            if (k < 3) { const float* sp = P->in[I_SCONV] + (((size_t)l * 32 + b) * 3 + k) * 384 + c8; const f32x4 a = *(const f32x4*)sp, c = *(const f32x4*)(sp + 4);
                v.x = pk2(a[0], a[1]); v.y = pk2(a[2], a[3]); v.z = pk2(c[0], c[1]); v.w = pk2(c[2], c[3]); }
            else v = *(const u32x4*)(PJ + (size_t)(SEQ + 8 * b + (k - 3)) * PJP + C_XR + c8);
            *(LAS u32x4*)(wl + rr * TLP + 16 * (lane & 7)) = v;
        }
    }
    {
        const int ch = l * 384 + 64 * n + lane;
#pragma unroll
        for (int j = 0; j < 4; ++j) cst[j * 64 + lane] = P->in[I_CONVW][(size_t)l * 3 * 384 + j * 384 + ch];
        cst[4 * 64 + lane] = P->in[I_CONVB][ch]; cst[5 * 64 + lane] = P->in[I_GAB][ch]; cst[6 * 64 + lane] = P->in[I_GXB][ch];
        cst[7 * 64 + lane] = -log1pf(__expf(-P->in[I_LAM][ch]));
    }
    bf16x8 wa[4][2], wx[4][2];
#pragma unroll
    for (int dt = 0; dt < 4; ++dt)
#pragma unroll
        for (int kk = 0; kk < 2; ++kk) { wa[dt][kk] = *(const bf16x8*)(WA + (16 * dt + fr) * 64 + 32 * kk + 8 * fq); wx[dt][kk] = *(const bf16x8*)(WX + (16 * dt + fr) * 64 + 32 * kk + 8 * fq); }
    f32x4 Pc[4], Hc[4];
#pragma unroll
    for (int dt = 0; dt < 4; ++dt) { Pc[dt] = (f32x4){1.f, 1.f, 1.f, 1.f}; Hc[dt] = (f32x4){0.f, 0.f, 0.f, 0.f}; }
    const int segm = smp ? 7 : 15;
#pragma unroll 1
    for (int tt = 0; tt < 4; ++tt) {
        const int ti = 16 * tt + fr, R = T0 + ti;
        const int trow = smp ? (ti >> 3) * 11 + (ti & 7) : ti;
        f32x4 xc[4];
#pragma unroll
        for (int dt = 0; dt < 4; ++dt) {
            const int cl = 16 * dt + 4 * fq;
            f32x4 a = *(const LAS f32x4*)(cst + 4 * 64 + cl);
#pragma unroll
            for (int j = 0; j < 4; ++j) a += *(const LAS f32x4*)(cst + j * 64 + cl) * bf4_to_f4(*(const LAS u32x2*)(wl + (trow + j) * TLP + 2 * cl));
            xc[dt] = a;
        }
        bf16x8 bfr[2];
#pragma unroll
        for (int kk = 0; kk < 2; ++kk) { u32x4 pw; pw.x = pk2(xc[2 * kk][0], xc[2 * kk][1]); pw.y = pk2(xc[2 * kk][2], xc[2 * kk][3]); pw.z = pk2(xc[2 * kk + 1][0], xc[2 * kk + 1][1]); pw.w = pk2(xc[2 * kk + 1][2], xc[2 * kk + 1][3]); bfr[kk] = __builtin_bit_cast(bf16x8, pw); }
#pragma unroll
        for (int dt = 0; dt < 4; ++dt) {
            const int cl = 16 * dt + 4 * fq, ch = 64 * n + cl;
            f32x4 ra = (f32x4){0.f, 0.f, 0.f, 0.f}, ia = (f32x4){0.f, 0.f, 0.f, 0.f};
            ra = __builtin_amdgcn_mfma_f32_16x16x32_bf16(wa[dt][0], bfr[0], ra, 0, 0, 0); ra = __builtin_amdgcn_mfma_f32_16x16x32_bf16(wa[dt][1], bfr[1], ra, 0, 0, 0);
            ia = __builtin_amdgcn_mfma_f32_16x16x32_bf16(wx[dt][0], bfr[0], ia, 0, 0, 0); ia = __builtin_amdgcn_mfma_f32_16x16x32_bf16(wx[dt][1], bfr[1], ia, 0, 0, 0);
            const f32x4 ba = *(const LAS f32x4*)(cst + 5 * 64 + cl), bx = *(const LAS f32x4*)(cst + 6 * 64 + cl), ls = *(const LAS f32x4*)(cst + 7 * 64 + cl);
            f32x4 A, B;
#pragma unroll
            for (int i = 0; i < 4; ++i) {
                const float r = sigmoidf_(ra[i] + ba[i]), ig = sigmoidf_(ia[i] + bx[i]);
                const float la = 8.0f * r * ls[i];
                A[i] = __expf(la); B[i] = sqrtf(fmaxf(-expm1f(2.0f * la), 0.f)) * ig * xc[dt][i];
            }
#pragma unroll
            for (int off = 1; off < 16; off <<= 1) {
                if (off == 8 && smp) break;
                const bool cnd = (fr & segm) >= off;
#pragma unroll
                for (int i = 0; i < 4; ++i) {
                    const float ap = __shfl_up(A[i], off, 16), bp = __shfl_up(B[i], off, 16);
                    if (cnd) { B[i] = A[i] * bp + B[i]; A[i] = A[i] * ap; }
                }
            }
            const f32x4 h = B + A * Hc[dt], p = A * Pc[dt];
            *(f32x4*)(HL + (size_t)R * 384 + ch) = h; *(f32x4*)(PC + (size_t)R * 384 + ch) = p;
            if (!smp) {
#pragma unroll
                for (int i = 0; i < 4; ++i) { Hc[dt][i] = __shfl(h[i], (lane & 48) | 15); Pc[dt][i] = __shfl(p[i], (lane & 48) | 15); }
            }
        }
    }
    if (!smp && fr == 0) {
#pragma unroll
        for (int dt = 0; dt < 4; ++dt) {
            const int ch = 64 * n + 16 * dt + 4 * fq;
            *(f32x4*)((float*)(P->ws + WS_CA) + (size_t)c64 * 384 + ch) = Pc[dt]; *(f32x4*)((float*)(P->ws + WS_CH) + (size_t)c64 * 384 + ch) = Hc[dt];
        }
    }
}

__device__ __forceinline__ void phase2(KP P, int l, LAS unsigned char* lds) {
    const int tid = opaque_tid(), lane = tid & 63, wave = tid >> 6;
    const int gw = blockIdx.x * 8 + wave, NGW = gridDim.x * 8;
    const int gt = blockIdx.x * 512 + tid, NGT = gridDim.x * 512;
    constexpr int NT_R = NCH * 6, NT_P = NCH * 4;
    for (int t = gw; t < NT_R + NT_P; t += NGW) { LAS unsigned char* wl = lds + wave * 16384; if (t < NT_R) rglru_local_task(P, l, t, lane, wl); else pool_task(P, l, t - NT_R, lane, wl); }
    {
        const bf16_t* PJ = (const bf16_t*)(P->ws + WS_PJ); float* out = P->out;
        for (int i = gt; i < 2048 * 192; i += NGT) {
            const int r = i / 192, c4 = (i - r * 192) * 4, kv = c4 >= 384, c = c4 - 384 * kv;
            *(f32x4*)(out + (kv ? OFF_PWV : OFF_PWK) + ((size_t)l * 2048 + r) * 384 + c) = bf4_to_f4(*(const u32x2*)(PJ + (size_t)(SEQ - 2048 + r) * PJP + C_K + c4));
        }
        for (int i = gt; i < 256 * 192; i += NGT) {
            const int si = i / 192, c4 = (i - si * 192) * 4, kv = c4 >= 384, c = c4 - 384 * kv;
            *(f32x4*)(out + (kv ? OFF_SWV : OFF_SWK) + (((size_t)l * 32 + (si >> 3)) * 2048 + 2040 + (si & 7)) * 384 + c) = bf4_to_f4(*(const u32x2*)(PJ + (size_t)(SEQ + si) * PJP + C_K + c4));
        }
        for (int i = gt; i < 15 * 64; i += NGT) {
            const int r = i >> 6, c = (i & 63) * 4;
            *(f32x4*)(out + OFF_PPOOL + ((size_t)l * 15 + r) * 256 + c) = bf4_to_f4(*(const u32x2*)(PJ + (size_t)(SEQ - 15 + r) * PJP + C_U + c));
        }
        for (int i = gt; i < 256 * 64; i += NGT) {
            const int si = i >> 6, c = (i & 63) * 4;
            *(f32x4*)(out + OFF_SPOOL + (((size_t)l * 32 + (si >> 3)) * 15 + 7 + (si & 7)) * 256 + c) = bf4_to_f4(*(const u32x2*)(PJ + (size_t)(SEQ + si) * PJP + C_U + c));
        }
        for (int i = gt; i < 3 * 96; i += NGT) {
            const int r = i / 96, c = (i - r * 96) * 4;
            *(f32x4*)(out + OFF_PCONV + ((size_t)l * 3 + r) * 384 + c) = bf4_to_f4(*(const u32x2*)(PJ + (size_t)(SEQ - 3 + r) * PJP + C_XR + c));
        }
        for (int i = gt; i < 32 * 3 * 96; i += NGT) {
            const int br = i / 96, c = (i - br * 96) * 4, b = br / 3, r = br - 3 * b;
            *(f32x4*)(out + OFF_SCONV + (((size_t)l * 32 + b) * 3 + r) * 384 + c) = bf4_to_f4(*(const u32x2*)(PJ + (size_t)(SEQ + 8 * b + 5 + r) * PJP + C_XR + c));
        }
    }
    for (int i = gt; i < 32 * 7 * 256; i += NGT) {
        const int b = i / 1792, rem = i - b * 1792;
        P->out[OFF_SPOOL + ((size_t)l * 32 + b) * 15 * 256 + rem] = P->in[I_SPOOL][((size_t)l * 32 + b) * 15 * 256 + 8 * 256 + rem];
    }
}

__device__ __forceinline__ void rglru_fix_task(KP P, int l, int task, LAS unsigned char* lds) {
    const int tid = opaque_tid(), c = task / 3, cg_ = task - 3 * c, chl = tid & 127, seg = tid >> 7, ch = 128 * cg_ + chl;
    const float* CA = (const float*)(P->ws + WS_CA); const float* CH = (const float*)(P->ws + WS_CH);
    const float* HL = (const float*)(P->ws + WS_HL); const float* PC = (const float*)(P->ws + WS_PC);
    const bf16_t* PJ = (const bf16_t*)(P->ws + WS_PJ); bf16_t* MIX = (bf16_t*)(P->ws + WS_MIX);
    LAS float* sA = (LAS float*)lds; LAS float* sH = sA + 512;
    float carry = 0.f;
    const bool smp = c >= 256;
    if (!smp) {
        const int q = (c + 3) >> 2, k0 = seg * q, k1 = (k0 + q) < c ? (k0 + q) : c;
        float a = 1.f, h = 0.f;
        for (int kb_ = k0; kb_ < k1; kb_ += 16) {
            float ak[16], hk[16];
#pragma unroll
            for (int u_ = 0; u_ < 16; ++u_) { const int k = (kb_ + u_) < k1 ? (kb_ + u_) : (k1 - 1); ak[u_] = CA[(size_t)k * 384 + ch]; hk[u_] = CH[(size_t)k * 384 + ch]; }
#pragma unroll
            for (int u_ = 0; u_ < 16; ++u_) if (kb_ + u_ < k1) { h = ak[u_] * h + hk[u_]; a *= ak[u_]; }
        }
        sA[seg * 128 + chl] = a; sH[seg * 128 + chl] = h;
        __syncthreads();
#pragma unroll
        for (int s = 0; s < 4; ++s) carry = sA[s * 128 + chl] * carry + sH[s * 128 + chl];
    }
    const int T0 = c * 64 + seg * 16;
    float hl[16], pc[16]; unsigned short gg[16];
#pragma unroll
    for (int i = 0; i < 16; ++i) { const int R = T0 + i; hl[i] = HL[(size_t)R * 384 + ch]; pc[i] = PC[(size_t)R * 384 + ch]; gg[i] = PJ[(size_t)R * PJP + C_GT + ch]; }
    float h0v = 0.f, h1v = 0.f;
    if (smp) { h0v = P->in[I_SRG][((size_t)l * 32 + ((T0 - SEQ) >> 3)) * 384 + ch]; h1v = P->in[I_SRG][((size_t)l * 32 + ((T0 - SEQ) >> 3) + 1) * 384 + ch]; }
#pragma unroll
    for (int i = 0; i < 16; ++i) {
        const int R = T0 + i;
        const float cin = smp ? (i < 8 ? h0v : h1v) : carry;
        const float h = hl[i] + pc[i] * cin;
        const float g = __uint_as_float((unsigned)gg[i] << 16);
        const float y = h * gelu_tanh(g);
        MIX[(size_t)R * DM + 640 + ch] = (bf16_t)(pk2(y, 0.f) & 0xffffu);
        if (R == SEQ - 1) P->out[OFF_PRG + l * 384 + ch] = h;
        if (smp && (i & 7) == 7) P->out[OFF_SRG + ((size_t)l * 32 + ((R - SEQ) >> 3)) * 384 + ch] = h;
    }
    __syncthreads();
}

__device__ __forceinline__ s16x4 vtr(const LAS unsigned char* p) { return __builtin_bit_cast(s16x4, __builtin_amdgcn_ds_read_tr16_b64_v4i16((LAS s16x4*)p)); }

constexpr int VRP = 144;
constexpr int ATT_STEPS = 23;
__device__ __forceinline__ void att_step_info(int st, int& sh, int& s) { if (st < 12) { sh = 0; s = st; } else if (st < 18) { sh = 2; s = st - 12; } else { sh = 4; s = st - 18; } }

struct AttKV { bf16x8 k[2][2]; u32x4 v[4]; };
__device__ __forceinline__ void att_load(AttKV& b, int st, int p0, int fr, int lane, const bf16_t* Kb, const bf16_t* Vb) {
    int sh, s; att_step_info(st, sh, s);
    const int kbase = p0 - (128 << sh);
#pragma unroll
    for (int kt = 0; kt < 2; ++kt) { int pk = kbase + ((32 * s + 16 * kt + fr) << sh); pk = pk < 0 ? 0 : (pk > MT - 1 ? MT - 1 : pk);
        b.k[kt][0] = *(const bf16x8*)(Kb + (size_t)pk * PJP); b.k[kt][1] = *(const bf16x8*)(Kb + (size_t)pk * PJP + 32); }
    int pv = kbase + ((32 * s + (lane >> 1)) << sh); pv = pv < 0 ? 0 : (pv > MT - 1 ? MT - 1 : pv);
#pragma unroll
    for (int i = 0; i < 4; ++i) b.v[i] = *(const u32x4*)(Vb + (size_t)pv * PJP + 8 * i);
}
__device__ __forceinline__ void att_compute(const AttKV& b, int st, int p0, int fr, int fq, const bf16x8 qf0, const bf16x8 qf1, float& m, float& lsum, f32x4 (&o)[4],
                                            LAS unsigned char* vw, const LAS unsigned char* vr) {
    int sh, s; att_step_info(st, sh, s);
    const int kbase = p0 - (128 << sh);
    f32x4 sc[2];
#pragma unroll
    for (int kt = 0; kt < 2; ++kt) {
        sc[kt] = __builtin_amdgcn_mfma_f32_16x16x32_bf16(b.k[kt][0], qf0, (f32x4){0.f, 0.f, 0.f, 0.f}, 0, 0, 0);
        sc[kt] = __builtin_amdgcn_mfma_f32_16x16x32_bf16(b.k[kt][1], qf1, sc[kt], 0, 0, 0);
    }
    const int qe = ((16 >> sh) * fr) + 128;
    float mx = -INFINITY;
#pragma unroll
    for (int kt = 0; kt < 2; ++kt)
#pragma unroll
        for (int i = 0; i < 4; ++i) {
            const int j = 32 * s + 16 * kt + 4 * fq + i, e = qe - j, pk = kbase + (j << sh);
            const bool ok = (e >= 0) && (e <= 128) && (pk >= 0);
            sc[kt][i] = ok ? sc[kt][i] : -INFINITY;
            mx = fmaxf(mx, sc[kt][i]);
        }
    mx = fmaxf(mx, __shfl_xor(mx, 16)); mx = fmaxf(mx, __shfl_xor(mx, 32));
    const float mn = fmaxf(m, mx), al = fexp2(m - mn);
    m = mn;
    float ps = 0.f;
#pragma unroll
    for (int kt = 0; kt < 2; ++kt)
#pragma unroll
        for (int i = 0; i < 4; ++i) { sc[kt][i] = fexp2(sc[kt][i] - mn); ps += sc[kt][i]; }
    lsum = lsum * al + ps;
    u32x4 pw; pw.x = pk2(sc[0][0], sc[0][1]); pw.y = pk2(sc[0][2], sc[0][3]); pw.z = pk2(sc[1][0], sc[1][1]); pw.w = pk2(sc[1][2], sc[1][3]);
    const bf16x8 pb8 = __builtin_bit_cast(bf16x8, pw);
#pragma unroll
    for (int i = 0; i < 4; ++i) *(LAS u32x4*)(vw + 16 * i) = b.v[i];
#pragma unroll
    for (int dt = 0; dt < 4; ++dt) {
        const s16x4 lo = vtr(vr + dt * 32), hi = vtr(vr + 16 * VRP + dt * 32);
        const bf16x8 vf = __builtin_shufflevector(lo, hi, 0, 1, 2, 3, 4, 5, 6, 7);
        o[dt] = o[dt] * al;
        o[dt] = __builtin_amdgcn_mfma_f32_16x16x32_bf16(vf, pb8, o[dt], 0, 0, 0);
    }
}

__device__ __forceinline__ void attn_tile(KP P, int wt, int lane, LAS unsigned char* vl) {
    const int r = wt & 15, hh = (wt >> 4) % 6, pb = wt / 96, p0 = pb * 256 + r, fr = lane & 15, fq = lane >> 4;
    const bf16_t* PJ = (const bf16_t*)(P->ws + WS_PJ); bf16_t* MIX = (bf16_t*)(P->ws + WS_MIX);
    const bf16_t* qp = PJ + (size_t)(p0 + 16 * fr) * PJP + C_Q + 64 * hh + 8 * fq;
    const bf16x8 qf0 = *(const bf16x8*)qp, qf1 = *(const bf16x8*)(qp + 32);
    const bf16_t* Kb = PJ + C_K + 64 * hh + 8 * fq;
    const bf16_t* Vb = PJ + C_V + 64 * hh + 32 * (lane & 1);
    float m = -1e30f, lsum = 0.f;
    f32x4 o[4];
#pragma unroll
    for (int dt = 0; dt < 4; ++dt) o[dt] = (f32x4){0.f, 0.f, 0.f, 0.f};
    LAS unsigned char* vw = vl + (lane >> 1) * VRP + (lane & 1) * 64;
    const LAS unsigned char* vr = vl + (4 * fq + (fr >> 2)) * VRP + (fr & 3) * 8;
    AttKV b0, b1, b2, b3;
    att_load(b0, 0, p0, fr, lane, Kb, Vb); att_load(b1, 1, p0, fr, lane, Kb, Vb); att_load(b2, 2, p0, fr, lane, Kb, Vb);
#pragma unroll 1
    for (int st = 0; st < ATT_STEPS; st += 4) {
        if (st + 3 < ATT_STEPS) att_load(b3, st + 3, p0, fr, lane, Kb, Vb);
        att_compute(b0, st, p0, fr, fq, qf0, qf1, m, lsum, o, vw, vr);
        if (st + 4 < ATT_STEPS) att_load(b0, st + 4, p0, fr, lane, Kb, Vb);
        if (st + 1 < ATT_STEPS) att_compute(b1, st + 1, p0, fr, fq, qf0, qf1, m, lsum, o, vw, vr);
        if (st + 5 < ATT_STEPS) att_load(b1, st + 5, p0, fr, lane, Kb, Vb);
        if (st + 2 < ATT_STEPS) att_compute(b2, st + 2, p0, fr, fq, qf0, qf1, m, lsum, o, vw, vr);
        if (st + 6 < ATT_STEPS) att_load(b2, st + 6, p0, fr, lane, Kb, Vb);
        if (st + 3 < ATT_STEPS) att_compute(b3, st + 3, p0, fr, fq, qf0, qf1, m, lsum, o, vw, vr);
    }
    lsum += __shfl_xor(lsum, 16); lsum += __shfl_xor(lsum, 32);
    const float inv = 1.0f / lsum;
    bf16_t* op = MIX + (size_t)(p0 + 16 * fr) * DM + 64 * hh + 4 * fq;
#pragma unroll
    for (int dt = 0; dt < 4; ++dt) *(u32x2*)(op + 16 * dt) = f4_to_bf4(o[dt] * inv);
}

__device__ __forceinline__ void sattn_task(KP P, int l, int task, int lane) {
    const int t = task & 7, bh = task >> 3, hh = bh % 6, b = bh / 6, li = lane & 15, g = lane >> 4;
    const bf16_t* PJ = (const bf16_t*)(P->ws + WS_PJ); bf16_t* MIX = (bf16_t*)(P->ws + WS_MIX);
    const int row = SEQ + 8 * b + t;
    const f32x4 q = bf4_to_f4(*(const u32x2*)(PJ + (size_t)row * PJP + C_Q + 64 * hh + 4 * li));
    const float* ck = P->in[I_CK] + ((size_t)l * 32 + b) * 2048 * 384 + 64 * hh + 4 * li;
    const float* cv = P->in[I_CV] + ((size_t)l * 32 + b) * 2048 * 384 + 64 * hh + 4 * li;
    const float* sk = P->out + OFF_SWK + ((size_t)l * 32 + b) * 2048 * 384 + 64 * hh + 4 * li;
    const float* sv = P->out + OFF_SWV + ((size_t)l * 32 + b) * 2048 * 384 + 64 * hh + 4 * li;
    float m = -1e30f, lsum = 0.f; f32x4 o = (f32x4){0.f, 0.f, 0.f, 0.f};
    f32x4 ka[8], va[8], kb[8], vb[8];
#define SAT_LOAD(KV, VV, IT0) _Pragma("unroll") for (int u_ = 0; u_ < 8; ++u_) { const int jj = ((IT0) + u_) * 4 + g; const int jc = jj < 387 ? jj : 386; \
        const int pat = jc >= 258 ? 2 : (jc >= 129 ? 1 : 0), j = jc - 129 * pat; const int idx = 2048 + t - (j << (2 * pat)); \
        KV[u_] = *(const f32x4*)(idx < 2048 ? ck + (size_t)idx * 384 : sk + (size_t)(idx - 8) * 384); VV[u_] = *(const f32x4*)(idx < 2048 ? cv + (size_t)idx * 384 : sv + (size_t)(idx - 8) * 384); }
#define SAT_PROC(KV, VV, IT0) _Pragma("unroll") for (int u_ = 0; u_ < 8; ++u_) { const int jj = ((IT0) + u_) * 4 + g; \
        float s = (q[0] * KV[u_][0] + q[1] * KV[u_][1]) + (q[2] * KV[u_][2] + q[3] * KV[u_][3]); \
        s += __shfl_xor(s, 1); s += __shfl_xor(s, 2); s += __shfl_xor(s, 4); s += __shfl_xor(s, 8); \
        if (jj >= 387) s = -INFINITY; \
        const float mn = fmaxf(m, s), al = fexp2(m - mn), p = fexp2(s - mn); lsum = lsum * al + p; o = o * al + VV[u_] * p; m = mn; }
    SAT_LOAD(ka, va, 0)
#pragma unroll 1
    for (int it0 = 0; it0 < 112; it0 += 16) {
        SAT_LOAD(kb, vb, it0 + 8)
        SAT_PROC(ka, va, it0)
        if (it0 + 16 < 112) { SAT_LOAD(ka, va, it0 + 16) }
        SAT_PROC(kb, vb, it0 + 8)
    }
#undef SAT_LOAD
#undef SAT_PROC
    float M = fmaxf(m, __shfl_xor(m, 16)); M = fmaxf(M, __shfl_xor(M, 32));
    const float scl = fexp2(m - M);
    lsum *= scl; o = o * scl;
    lsum += __shfl_xor(lsum, 16); lsum += __shfl_xor(lsum, 32);
#pragma unroll
    for (int i = 0; i < 4; ++i) { o[i] += __shfl_xor(o[i], 16); o[i] += __shfl_xor(o[i], 32); }
    if (g == 0) *(u32x2*)(MIX + (size_t)row * DM + 64 * hh + 4 * li) = f4_to_bf4(o * (1.0f / lsum));
}

__device__ __forceinline__ void phase3(KP P, int l, LAS unsigned char* lds) {
    const int tid = opaque_tid(), lane = tid & 63, wave = tid >> 6;
    const int gw = blockIdx.x * 8 + wave, NGW = gridDim.x * 8;
    for (int t = blockIdx.x; t < NCH * 3; t += gridDim.x) rglru_fix_task(P, l, t, lds);
    LAS unsigned char* vl = lds + 4096 + wave * (32 * VRP);
    for (int t = gw; t < 1536; t += NGW) sattn_task(P, l, t, lane);
    for (int t = gw; t < 6144; t += NGW) attn_tile(P, t, lane, vl);
}

__device__ __forceinline__ void copy_cache(KP P, int l, int kv) {
    if (blockIdx.x < 4) return;
    const int tid = opaque_tid();
    const int gt = (blockIdx.x - 4) * 512 + tid, NGT = (gridDim.x - 4) * 512;
    constexpr int SEGV = 2040 * 384 / 4;
    const float* cin = P->in[kv ? I_CV : I_CK]; float* o = P->out + (kv ? OFF_SWV : OFF_SWK);
    for (int i = gt; i < 32 * SEGV; i += NGT) {
        const int b = i / SEGV, off = i - b * SEGV;
        const f32x4* src = (const f32x4*)(cin + (((size_t)l * 32 + b) * 2048 + 8) * 384) + off;
        f32x4* dst = (f32x4*)(o + ((size_t)l * 32 + b) * 2048 * 384) + off;
        __builtin_nontemporal_store(__builtin_nontemporal_load(src), dst);
    }
}

__device__ __forceinline__ void final_norm(KP P) {
    const int tid = opaque_tid(), lane = tid & 63, wave = tid >> 6;
    const int gw = blockIdx.x * 8 + wave, NGW = gridDim.x * 8;
    const float* X = (const float*)(P->ws + WS_X); const float* rss = (const float*)(P->ws + WS_RSS) + 4 * MT;
    for (int row = gw; row < MT; row += NGW) {
        const float rs = rsqrtf(rss[row] * (1.0f / DM) + EPS);
#pragma unroll
        for (int j = 0; j < 4; ++j) {
            const int c = 4 * lane + 256 * j;
            const f32x4 v = *(const f32x4*)(X + (size_t)row * DM + c) * rs * *(const f32x4*)(P->in[I_FING] + c);
            *(f32x4*)(P->out + (size_t)row * DM + c) = v;
        }
    }
}

#define XB_TMO      128
#define XB_XCNT(j)  (256  + 64 * (j))
#define XB_XSUB(j)  (1280 + 64 * (j))
#define XB_XGEN(j)  (2304 + 64 * (j))
#define XB_TOP      3328
#define XB_TOPGEN   3392
#define XCD_BAR_WORDS 3456
#define XB_SPIN_CAP (1u << 18)

__device__ __forceinline__ unsigned xb_ld(unsigned* p)              { return __hip_atomic_load(p, __ATOMIC_RELAXED, __HIP_MEMORY_SCOPE_AGENT); }
__device__ __forceinline__ unsigned xb_add(unsigned* p, unsigned v) { return __hip_atomic_fetch_add(p, v, __ATOMIC_RELAXED, __HIP_MEMORY_SCOPE_AGENT); }
__device__ __forceinline__ unsigned xb_xcc_id() { return (unsigned)__builtin_amdgcn_s_getreg((3 << 11) | 20) & 0xFu; }
#define XB_SPIN(cond, bar) do { unsigned _sp = 0; while (cond) { __builtin_amdgcn_s_sleep(1); \
    if ((++_sp & 255u) == 0u) { if (xb_ld(&(bar)[XB_TMO])) break; if (_sp > XB_SPIN_CAP) { atomicAdd(&(bar)[XB_TMO], 1u); break; } } } } while (0)

struct XcdBarrier {
    unsigned* bar; unsigned x;
    volatile LAS unsigned* st;
};

__device__ __forceinline__ XcdBarrier xcd_barrier_post(unsigned* bar, volatile LAS unsigned* st) {
    XcdBarrier b; b.bar = bar; b.x = (unsigned)__builtin_amdgcn_readfirstlane((int)xb_xcc_id()); b.st = st;
    if (threadIdx.x == 0) (void)xb_add(&bar[XB_XCNT(b.x)], 1u);
    return b;
}
__device__ __forceinline__ void xcd_barrier_complete(unsigned* bar, unsigned x, unsigned& nloc, unsigned& nx) {
    const unsigned G = gridDim.x * gridDim.y * gridDim.z;
    unsigned sum, cnt, mine, sp = 0u;
    for (;;) {
        sum = 0u; cnt = 0u; mine = 0u;
#pragma unroll
        for (unsigned j = 0; j < 16; ++j) { const unsigned c = xb_ld(&bar[XB_XCNT(j)]); sum += c; cnt += (c > 0u) ? 1u : 0u; mine = (j == x) ? c : mine; }
        if (sum == G) break;
        __builtin_amdgcn_s_sleep(1);
        if ((++sp & 255u) == 0u) { if (xb_ld(&bar[XB_TMO])) break; if (sp > XB_SPIN_CAP) { atomicAdd(&bar[XB_TMO], 1u); break; } }
    }
    nloc = mine > 0u ? mine : 1u; nx = cnt > 0u ? cnt : 1u;
}

__device__ __forceinline__ void xcd_barrier(const XcdBarrier& b) {
    unsigned bx_ = b.x; asm volatile("" : "+s"(bx_));
    asm volatile("s_waitcnt vmcnt(0)" ::: "memory");
    __syncthreads();
    if (threadIdx.x == 0) {
        unsigned* bar = b.bar; asm volatile("" : "+s"(bar));
        __builtin_amdgcn_s_waitcnt(0);
        unsigned nloc = b.st[0], nx = b.st[1];
        if (nloc == 0u) { xcd_barrier_complete(bar, bx_, nloc, nx); b.st[0] = nloc; b.st[1] = nx; }
        const unsigned old = xb_add(&bar[XB_XSUB(bx_)], 1u);
        const unsigned gen = old / nloc;
        if (old + 1u == (gen + 1u) * nloc) {
            __builtin_amdgcn_fence(__ATOMIC_RELEASE, "agent");
            asm volatile("s_waitcnt vmcnt(0)" ::: "memory");
            const unsigned og = xb_add(&bar[XB_TOP], 1u);
            const unsigned tg = og / nx;
            if (og + 1u == (tg + 1u) * nx) xb_add(&bar[XB_TOPGEN], 1u);
            else XB_SPIN(xb_ld(&bar[XB_TOPGEN]) == tg, bar);
            __builtin_amdgcn_fence(__ATOMIC_ACQUIRE, "agent");
            xb_add(&bar[XB_XGEN(bx_)], 1u);
            asm volatile("s_waitcnt vmcnt(0)" ::: "memory");
        } else {
            XB_SPIN(xb_ld(&bar[XB_XGEN(bx_)]) == gen, bar);
            __builtin_amdgcn_fence(__ATOMIC_ACQUIRE, "agent");
            asm volatile("s_waitcnt vmcnt(0)" ::: "memory");
        }
    }
    __syncthreads();
}

__global__ void __launch_bounds__(512) mega_fwd(Params Pval) {
    extern __shared__ __attribute__((aligned(16))) unsigned char lds_raw[];
    LAS unsigned char* lds = (LAS unsigned char*)lds_raw;
    cg::grid_group grid = cg::this_grid();
    if (Pval.ws == nullptr) grid.sync();
    volatile LAS unsigned* bst = (volatile LAS unsigned*)(lds + pg8::STAGE_BYTES);
    if (threadIdx.x < 2) bst[threadIdx.x] = 0u;
    __syncthreads();
    XcdBarrier bar = xcd_barrier_post((unsigned*)(Pval.ws + WS_BAR), bst);
    prologue(kargs(), lds);
    xcd_barrier(bar);
#pragma unroll 1
    for (int l = 0; l < 2; ++l) {
        {
            KP P = kargs(); unsigned char* ws = P->ws; float* rss = (float*)(ws + WS_RSS);
            pg8::Gemm g{(const bf16_t*)(ws + WS_XB), (const bf16_t*)(ws + WS_WIN) + (size_t)l * DINP * DM, MT, DINP, DM}; pg8::StaticOrder S; S.init(MT, DINP, gridDim.x, blockIdx.x);
            EpiInProj E{(bf16_t*)(ws + WS_PJ), rss + (size_t)(2 * l) * MT, (const float*)(ws + WS_ROPE)};
            pg8::gemm_phase<EpiInProj, pg8::StaticOrder, true, true>(lds, g, S, E);
        }
        xcd_barrier(bar);
        phase2(kargs(), l, lds);
        xcd_barrier(bar);
        phase3(kargs(), l, lds);
        xcd_barrier(bar);
        {
            KP P = kargs(); unsigned char* ws = P->ws; float* rss = (float*)(ws + WS_RSS); float* X = (float*)(ws + WS_X);
            pg8::Gemm g{(const bf16_t*)(ws + WS_MIX), (const bf16_t*)(ws + WS_WOUT) + (size_t)l * DM * DM, MT, DM, DM}; pg8::StaticOrder S; S.init(MT, DM, gridDim.x, blockIdx.x);
            EpiResid E{l == 0 ? P->in[I_XP] : X, l == 0 ? P->in[I_XS] : X + (size_t)SEQ * DM, X, (bf16_t*)(ws + WS_XB), rss + (size_t)(2 * l + 1) * MT};
            pg8::gemm_phase<EpiResid, pg8::StaticOrder, true, true>(lds, g, S, E);
            copy_cache(kargs(), l, 0);
        }
        xcd_barrier(bar);
        {
            KP P = kargs(); unsigned char* ws = P->ws; float* rss = (float*)(ws + WS_RSS);
            pg8::Gemm g{(const bf16_t*)(ws + WS_XB), (const bf16_t*)(ws + WS_WGU) + (size_t)l * NGU * DM, MT, NGU, DM}; pg8::StaticOrder S; S.init(MT, NGU, gridDim.x, blockIdx.x);
            EpiGateUp E{(bf16_t*)(ws + WS_HB), rss + (size_t)(2 * l + 1) * MT};
            pg8::gemm_phase<EpiGateUp, pg8::StaticOrder, true, true>(lds, g, S, E);
        }
        xcd_barrier(bar);
        {
            KP P = kargs(); unsigned char* ws = P->ws; float* rss = (float*)(ws + WS_RSS); float* X = (float*)(ws + WS_X);
            pg8::Gemm g{(const bf16_t*)(ws + WS_HB), (const bf16_t*)(ws + WS_WDN) + (size_t)l * DM * DFF, MT, DM, DFF}; pg8::StaticOrder S; S.init(MT, DM, gridDim.x, blockIdx.x);
            EpiResid E{X, X + (size_t)SEQ * DM, X, (bf16_t*)(ws + WS_XB), rss + (size_t)(2 * l + 2) * MT};
            pg8::gemm_phase<EpiResid, pg8::StaticOrder, true, true>(lds, g, S, E);
            copy_cache(kargs(), l, 1);
        }
        xcd_barrier(bar);
    }
    final_norm(kargs());
}

constexpr int LDS_BYTES = pg8::STAGE_BYTES + 256;

extern "C" void kernel_launch(void* const* d_in, const int* in_sizes, int n_in, void* d_out, int out_size, void* d_ws, size_t ws_size, hipStream_t stream) {
    static int grid = 0;
    if (grid == 0) {
        if (n_in != 23 || (size_t)out_size != OUT_TOTAL || ws_size < WS_END) { fprintf(stderr, "kernel_launch: unexpected shapes (n_in %d out %d ws %zu need %zu)\n", n_in, out_size, ws_size, (size_t)WS_END); grid = -1; return; }
        int dev = 0, cus = 0, per_cu = 0;
        hipGetDevice(&dev); hipDeviceGetAttribute(&cus, hipDeviceAttributeMultiprocessorCount, dev);
        hipFuncSetAttribute((const void*)mega_fwd, hipFuncAttributeMaxDynamicSharedMemorySize, LDS_BYTES);
        hipOccupancyMaxActiveBlocksPerMultiprocessor(&per_cu, (const void*)mega_fwd, 512, LDS_BYTES);
        if (per_cu < 1) { fprintf(stderr, "kernel_launch: occupancy query says %d blocks/CU\n", per_cu); per_cu = 1; }
        grid = cus * 1;
        (void)hipGetLastError();
    }
    if (grid < 0) return;
    if (hipMemsetAsync((unsigned char*)d_ws + WS_BAR, 0, 16384, stream) != hipSuccess) { fprintf(stderr, "kernel_launch: memset of the barrier words failed\n"); return; }
    Params p{};
    for (int i = 0; i < 23; ++i) p.in[i] = (const float*)d_in[i];
    p.out = (float*)d_out; p.ws = (unsigned char*)d_ws;
    void* args[] = {&p};
    hipError_t e = hipLaunchCooperativeKernel((const void*)mega_fwd, dim3(grid), dim3(512), args, LDS_BYTES, stream);
    if (e != hipSuccess) fprintf(stderr, "cooperative launch failed: %s (grid %d)\n", hipGetErrorString(e), grid);
}
```

```cpp
#include <hip/hip_runtime.h>
#include <hip/hip_cooperative_groups.h>
#include <cstdio>
#include <cstdint>
namespace cg = cooperative_groups;
namespace pg8 {
#define PG8_LAS __attribute__((address_space(3)))
typedef unsigned short bf16_t;
typedef short bf16x8 __attribute__((ext_vector_type(8)));
typedef float f32x4 __attribute__((ext_vector_type(4)));
typedef unsigned u32x4 __attribute__((ext_vector_type(4)));
constexpr int BM = 256, BK = 64, HALF = 128, HTB = HALF * BK * 2  , STAGE_BYTES = 8 * HTB, NXCD = 8, WGM = 8;

__host__ __device__ __forceinline__ int lds_byte(int r, int c) { const int st = (r >> 4) * 2 + (c >> 5), rr = r & 15, cc = c & 31, ob = rr * 64 + cc * 2; return st * 1024 + (ob ^ (((ob >> 9) & 1) << 5)); }
__host__ __device__ __forceinline__ void stage_rc(int b, int& R, int& C) { const int st = b / 1024, sb = b % 1024, swz = sb ^ (((sb >> 9) & 1) << 5); R = (st >> 1) * 16 + swz / 64; C = (st & 1) * 32 + (swz % 64) / 2; }
__host__ __device__ __forceinline__ int perm32(int rho) { const int n = rho >> 4, i = rho & 15; return 8 * (i >> 2) + 4 * n + (i & 3); }

struct Unit { int pm, pn; };
struct Gemm { const bf16_t* A; const bf16_t* Bt; int M, N, K; };

struct StaticOrder {
    int nM, nN, nwg, G, c;
    __host__ __device__ void init(int M, int N, int G_, int c_) { nM = M / BM; nN = N / BM; nwg = nM * nN; G = G_; c = c_; }
    __host__ __device__ bool next(int i, Unit& u) const {
        const long L = (long)i * G + c; if (L >= nwg) return false;
        int wgid = (int)L; { const int q = nwg / NXCD, r = nwg % NXCD, xcd = wgid % NXCD, off = wgid / NXCD; wgid = (xcd < r ? xcd * (q + 1) : r * (q + 1) + (xcd - r) * q) + off; }
        const int nig = WGM * nN, gid = wgid / nig, fm = gid * WGM, gsz = (nM - fm) < WGM ? (nM - fm) : WGM;
        u.pm = fm + ((wgid % nig) % gsz); u.pn = (wgid % nig) / gsz; return true;
    }
    __device__ __forceinline__ void a_ready(const Unit&) const {}
    __device__ __forceinline__ void done(const Unit&) const {}
};

__device__ __forceinline__ unsigned cvt_pk_bf16(float lo, float hi) { unsigned r; asm volatile("v_cvt_pk_bf16_f32 %0, %1, %2" : "=v"(r) : "v"(lo), "v"(hi)); return r; }
template <class Epi, class Sched, bool ALIGN_EPI = false, bool SP2 = false>
__device__ __forceinline__ void gemm_phase(PG8_LAS unsigned char* lds, const Gemm g, const Sched& S, const Epi& E) {
    int tid_ = threadIdx.x; asm volatile("" : "+v"(tid_));
    const int tid = tid_, wid = __builtin_amdgcn_readfirstlane(tid >> 6), lane = tid & 63, wr = wid >> 2, wc = wid & 3, fr = lane & 15, fq = lane >> 4;
    const int K = g.K, nt = K / BK;
    unsigned voffA[2], voffB[2];
#pragma unroll
    for (int i = 0; i < 2; ++i) { int R, C; stage_rc(tid * 16 + i * 8192, R, C); const int Rb = Epi::PERM ? ((R & ~31) + perm32(R & 31)) : R;
        voffA[i] = (unsigned)(R * K + C) * 2u; voffB[i] = (unsigned)(Rb * K + C) * 2u; }
    const size_t kstep = (size_t)(BK * 2);
    const size_t hstep = (size_t)HALF * K * 2;
    const size_t tstep = 2 * hstep;
    const unsigned ldsw = (unsigned)wid * 1024u;
    const int aoff = lds_byte(wr * 64 + fr, fq * 8), boff = lds_byte(wc * 32 + fr, fq * 8);
#define PG8_SA(b, h) (((b) * 2 + (h)) * HTB)
#define PG8_SB(b, h) ((4 + (b) * 2 + (h)) * HTB)
#define PG8_STAGE(bufoff, gbase, voff) do { _Pragma("unroll") for (int _i = 0; _i < 2; ++_i) \
        __builtin_amdgcn_global_load_lds((const unsigned*)((const char*)(gbase) + (voff)[_i]), (PG8_LAS unsigned*)(lds + (bufoff) + ldsw + _i * 8192), 16, 0, 0); } while (0)
#define PG8_LDA(dst, b, h) do { _Pragma("unroll") for (int m = 0; m < 4; ++m) _Pragma("unroll") for (int k = 0; k < 2; ++k) dst[m][k] = *(const PG8_LAS bf16x8*)(lds + PG8_SA(b, h) + aoff + m * 2048 + k * 1024); } while (0)
#define PG8_LDB(dst, b, h) do { _Pragma("unroll") for (int n = 0; n < 2; ++n) _Pragma("unroll") for (int k = 0; k < 2; ++k) dst[n][k] = *(const PG8_LAS bf16x8*)(lds + PG8_SB(b, h) + boff + n * 2048 + k * 1024); } while (0)
#define PG8_MMA(ai, bj, At, Bt) do { __builtin_amdgcn_s_setprio(1); _Pragma("unroll") for (int m = 0; m < 4; ++m) _Pragma("unroll") for (int n = 0; n < 2; ++n) _Pragma("unroll") for (int k = 0; k < 2; ++k) \
        acc[ai][bj][m][n] = __builtin_amdgcn_mfma_f32_16x16x32_bf16(Bt[n][k], At[m][k], acc[ai][bj][m][n], 0, 0, 0); __builtin_amdgcn_s_setprio(0); } while (0)
#define PG8_WAIT_V(n) asm volatile("s_waitcnt vmcnt(" #n ")" ::: "memory")
#define PG8_WAIT_L(n) asm volatile("s_waitcnt lgkmcnt(" #n ")" ::: "memory")
#define PG8_BAR __builtin_amdgcn_s_barrier()
#define PG8_SCHED __builtin_amdgcn_sched_barrier(0)
    Unit cur, nxt; int ui = 0;
    if (!S.next(0, cur)) return;
    f32x4 acc[2][2][4][2];
#pragma unroll
    for (int a = 0; a < 2; ++a)
#pragma unroll
        for (int b = 0; b < 2; ++b)
#pragma unroll
            for (int m = 0; m < 4; ++m)
#pragma unroll
                for (int n = 0; n < 2; ++n) acc[a][b][m][n] = (f32x4){0.f, 0.f, 0.f, 0.f};
    bf16x8 At[4][2], B0[2][2], B1[2][2];
    const char* cA = (const char*)g.A + (size_t)cur.pm * tstep; const char* cB = (const char*)g.Bt + (size_t)cur.pn * tstep;
    S.a_ready(cur);
    if constexpr (SP2) {
        PG8_STAGE(PG8_SB(0, 0), cB, voffB); PG8_STAGE(PG8_SB(0, 1), cB + hstep, voffB); PG8_STAGE(PG8_SA(0, 0), cA, voffA); PG8_STAGE(PG8_SA(0, 1), cA + hstep, voffA);
        if (wr == 1) PG8_BAR;
        PG8_WAIT_V(2); PG8_BAR;
        PG8_STAGE(PG8_SB(1, 0), cB + kstep, voffB); PG8_STAGE(PG8_SA(1, 0), cA + kstep, voffA); PG8_STAGE(PG8_SB(1, 1), cB + hstep + kstep, voffB);
        PG8_WAIT_V(6); PG8_BAR;
    } else {
        PG8_STAGE(PG8_SB(0, 0), cB, voffB); PG8_STAGE(PG8_SA(0, 0), cA, voffA); PG8_STAGE(PG8_SB(0, 1), cB + hstep, voffB); PG8_STAGE(PG8_SA(0, 1), cA + hstep, voffA);
        if (wr == 1) PG8_BAR;
        PG8_WAIT_V(4); PG8_BAR;
        PG8_STAGE(PG8_SB(1, 0), cB + kstep, voffB); PG8_STAGE(PG8_SA(1, 0), cA + kstep, voffA); PG8_STAGE(PG8_SB(1, 1), cB + hstep + kstep, voffB);
        PG8_WAIT_V(6); PG8_BAR;
    }
    for (;;) {
        const bool has_next = S.next(ui + 1, nxt);
        const char* nA = has_next ? (const char*)g.A + (size_t)nxt.pm * tstep : cA; const char* nB = has_next ? (const char*)g.Bt + (size_t)nxt.pn * tstep : cB;
        for (int t = 0; t < nt; t += 2) {
            const bool last = (t == nt - 2);
            const char* a1 = cA + (size_t)(t + 1) * kstep;
            const char* a2 = last ? nA : cA + (size_t)(t + 2) * kstep; const char* b2 = last ? nB : cB + (size_t)(t + 2) * kstep;
            const char* a3 = a2 + kstep; const char* b3 = b2 + kstep;
            if (last && has_next) S.a_ready(nxt);
            if constexpr (SP2) {
            PG8_LDB(B0, 0, 0); PG8_LDB(B1, 0, 1); PG8_SCHED; PG8_LDA(At, 0, 0); PG8_STAGE(PG8_SA(1, 1), a1 + hstep, voffA);
            PG8_WAIT_V(8); PG8_WAIT_L(0); PG8_BAR; PG8_MMA(0, 0, At, B0); PG8_MMA(0, 1, At, B1); PG8_BAR; PG8_SCHED;
            PG8_LDA(At, 0, 1); PG8_STAGE(PG8_SB(0, 0), b2, voffB); PG8_STAGE(PG8_SB(0, 1), b2 + hstep, voffB); PG8_STAGE(PG8_SA(0, 0), a2, voffA);
            PG8_WAIT_V(8); PG8_WAIT_L(0); PG8_BAR; PG8_MMA(1, 0, At, B0); PG8_MMA(1, 1, At, B1); PG8_BAR; PG8_SCHED;
            PG8_LDB(B0, 1, 0); PG8_LDB(B1, 1, 1); PG8_SCHED; PG8_LDA(At, 1, 0); PG8_STAGE(PG8_SA(0, 1), a2 + hstep, voffA);
            PG8_WAIT_V(8); PG8_WAIT_L(0); PG8_BAR; PG8_MMA(0, 0, At, B0); PG8_MMA(0, 1, At, B1); PG8_BAR; PG8_SCHED;
            PG8_LDA(At, 1, 1); PG8_STAGE(PG8_SB(1, 0), b3, voffB); PG8_STAGE(PG8_SB(1, 1), b3 + hstep, voffB); PG8_STAGE(PG8_SA(1, 0), a3, voffA);
            PG8_WAIT_V(8); PG8_WAIT_L(0); PG8_BAR; PG8_MMA(1, 0, At, B0); PG8_MMA(1, 1, At, B1); PG8_BAR; PG8_SCHED;
            } else {
            PG8_LDB(B0, 0, 0); PG8_SCHED; PG8_LDA(At, 0, 0); PG8_STAGE(PG8_SA(1, 1), a1 + hstep, voffA);
            PG8_WAIT_L(8); PG8_BAR; PG8_WAIT_L(0); PG8_MMA(0, 0, At, B0); PG8_BAR; PG8_SCHED;
            PG8_LDB(B1, 0, 1); PG8_STAGE(PG8_SB(0, 0), b2, voffB);
            PG8_BAR; PG8_WAIT_L(0); PG8_MMA(0, 1, At, B1); PG8_BAR;
            PG8_LDA(At, 0, 1); PG8_STAGE(PG8_SA(0, 0), a2, voffA);
            PG8_BAR; PG8_WAIT_L(0); PG8_MMA(1, 0, At, B0); PG8_BAR; PG8_SCHED;
            PG8_STAGE(PG8_SB(0, 1), b2 + hstep, voffB);
            PG8_WAIT_V(6); PG8_BAR; PG8_MMA(1, 1, At, B1); PG8_BAR;
            PG8_LDB(B0, 1, 0); PG8_SCHED; PG8_LDA(At, 1, 0); PG8_STAGE(PG8_SA(0, 1), a2 + hstep, voffA);
            PG8_WAIT_L(8); PG8_BAR; PG8_WAIT_L(0); PG8_MMA(0, 0, At, B0); PG8_BAR; PG8_SCHED;
            PG8_LDB(B1, 1, 1); PG8_STAGE(PG8_SB(1, 0), b3, voffB);
            PG8_BAR; PG8_WAIT_L(0); PG8_MMA(0, 1, At, B1); PG8_BAR;
            PG8_LDA(At, 1, 1); PG8_STAGE(PG8_SA(1, 0), a3, voffA);
            PG8_BAR; PG8_WAIT_L(0); PG8_MMA(1, 0, At, B0); PG8_BAR; PG8_SCHED;
            PG8_STAGE(PG8_SB(1, 1), b3 + hstep, voffB);
            PG8_WAIT_V(6); PG8_BAR; PG8_MMA(1, 1, At, B1); PG8_BAR;
            }
        }
        if constexpr (ALIGN_EPI) { if (wr == 0) PG8_BAR; }
        if constexpr (!Epi::AFTER_DRAIN) { E(acc, cur, wr, wc, fr, fq); S.done(cur); }
        if (!has_next) break;
#pragma unroll
        for (int a = 0; a < 2; ++a)
#pragma unroll
            for (int b = 0; b < 2; ++b)
#pragma unroll
                for (int m = 0; m < 4; ++m)
#pragma unroll
                    for (int n = 0; n < 2; ++n) acc[a][b][m][n] = (f32x4){0.f, 0.f, 0.f, 0.f};
        cur = nxt; cA = nA; cB = nB; ++ui;
        if constexpr (ALIGN_EPI) { if (wr == 1) PG8_BAR; }
    }
    PG8_WAIT_V(0);
    if constexpr (!ALIGN_EPI) { if (wr == 0) PG8_BAR; }
    PG8_BAR;
    if constexpr (Epi::AFTER_DRAIN) { E.fused(acc, cur, wr, wc, fr, fq, lds, wid, lane); S.done(cur); }
#undef PG8_SA
#undef PG8_SB
#undef PG8_STAGE
#undef PG8_LDA
#undef PG8_LDB
#undef PG8_MMA
#undef PG8_WAIT_V
#undef PG8_WAIT_L
#undef PG8_BAR
#undef PG8_SCHED
}
}

using pg8::bf16_t; using pg8::bf16x8; using pg8::f32x4; using pg8::u32x4;
#define LAS __attribute__((address_space(3)))
typedef short s16x4 __attribute__((ext_vector_type(4)));
typedef unsigned u32x2 __attribute__((ext_vector_type(2)));
typedef float f32x2 __attribute__((ext_vector_type(2)));

constexpr int DM = 1024, SEQ = 16384, NSMP = 256, MT = SEQ + NSMP;
constexpr int DIN = 2176, DINP = 2304, DFF = 2816, NGU = 2 * DFF;
constexpr int C_Q = 0, C_K = 384, C_V = 768, C_U = 1152, C_XR = 1408, C_GT = 1792, PJP = 2176;
constexpr int NCH = MT / 64;
constexpr float EPS = 1e-6f;
constexpr float QSCALE = 0.125f * 1.4426950408889634f;

constexpr size_t OFF_YP = 0, OFF_YS = OFF_YP + (size_t)SEQ * DM, OFF_PWK = OFF_YS + (size_t)NSMP * DM, OFF_PWV = OFF_PWK + 2ull * 2048 * 384,
                 OFF_PPOOL = OFF_PWV + 2ull * 2048 * 384, OFF_PCONV = OFF_PPOOL + 2 * 15 * 256, OFF_PRG = OFF_PCONV + 2 * 3 * 384, OFF_SWK = OFF_PRG + 2 * 384,
                 OFF_SWV = OFF_SWK + 2ull * 32 * 2048 * 384, OFF_SPOOL = OFF_SWV + 2ull * 32 * 2048 * 384, OFF_SCONV = OFF_SPOOL + 2 * 32 * 15 * 256,
                 OFF_SRG = OFF_SCONV + 2 * 32 * 3 * 384, OUT_TOTAL = OFF_SRG + 2 * 32 * 384;

constexpr size_t al256(size_t x) { return (x + 255) & ~(size_t)255; }
constexpr size_t WS_WIN = 0;
constexpr size_t WS_WOUT = WS_WIN + al256(2ull * DINP * DM * 2);
constexpr size_t WS_WGU = WS_WOUT + al256(2ull * DM * DM * 2);
constexpr size_t WS_WDN = WS_WGU + al256(2ull * NGU * DM * 2);
constexpr size_t WS_WA = WS_WDN + al256(2ull * DM * DFF * 2);
constexpr size_t WS_WX = WS_WA + al256(2ull * 6 * 64 * 64 * 2);
constexpr size_t WS_WP = WS_WX + al256(2ull * 6 * 64 * 64 * 2);
constexpr size_t WS_ROPE = WS_WP + al256(2ull * 4 * 64 * 64 * 2);
constexpr size_t WS_RSS = WS_ROPE + al256(16392ull * 32 * 8);
constexpr size_t WS_XB = WS_RSS + al256(5ull * MT * 4);
constexpr size_t WS_PJ = WS_XB + al256((size_t)MT * DM * 2);
constexpr size_t WS_HL = WS_PJ + al256((size_t)MT * PJP * 2);
constexpr size_t WS_PC = WS_HL + al256((size_t)MT * 384 * 4);
constexpr size_t WS_CA = WS_PC + al256((size_t)MT * 384 * 4);
constexpr size_t WS_CH = WS_CA + al256((size_t)NCH * 384 * 4);
constexpr size_t WS_MIX = WS_CH + al256((size_t)NCH * 384 * 4);
constexpr size_t WS_X = WS_MIX + al256((size_t)MT * DM * 2);
constexpr size_t WS_HB = WS_X + al256((size_t)MT * DM * 4);
constexpr size_t WS_BAR = WS_HB + al256((size_t)MT * DFF * 2);
constexpr size_t WS_END = WS_BAR + 16384;

struct Params { const float* in[23]; float* out; unsigned char* ws; };
typedef const __attribute__((address_space(4))) Params* KP;
__device__ __forceinline__ KP kargs() { auto p = __builtin_amdgcn_kernarg_segment_ptr(); asm volatile("" : "+s"(p)); return (KP)p; }
enum { I_XP = 0, I_XS, I_CK, I_CV, I_SPOOL, I_SCONV, I_SRG, I_N1G, I_WIN, I_POOLW, I_POOLS, I_CONVW, I_CONVB, I_GAW, I_GAB, I_GXW, I_GXB, I_LAM, I_WOUT, I_N2G, I_WGU, I_WDN, I_FING };

__device__ __forceinline__ int opaque_tid() { int t = threadIdx.x; asm volatile("" : "+v"(t)); return t; }
__device__ __forceinline__ unsigned pk2(float lo, float hi) { return pg8::cvt_pk_bf16(lo, hi); }
__device__ __forceinline__ float bf_lo(unsigned w) { return __uint_as_float(w << 16); }
__device__ __forceinline__ float bf_hi(unsigned w) { return __uint_as_float(w & 0xffff0000u); }
__device__ __forceinline__ f32x4 bf4_to_f4(u32x2 w) { return (f32x4){bf_lo(w.x), bf_hi(w.x), bf_lo(w.y), bf_hi(w.y)}; }
__device__ __forceinline__ u32x2 f4_to_bf4(f32x4 v) { u32x2 w; w.x = pk2(v[0], v[1]); w.y = pk2(v[2], v[3]); return w; }
__device__ __forceinline__ float wave_sum(float v) {
#pragma unroll
    for (int o = 1; o < 64; o <<= 1) v += __shfl_xor(v, o);
    return v;
}
__device__ __forceinline__ float fexp2(float x) { return __builtin_amdgcn_exp2f(x); }
__device__ __forceinline__ float fsigmoid(float x) { return __builtin_amdgcn_rcpf(1.0f + fexp2(-1.4426950408889634f * x)); }
template <int N> __device__ __forceinline__ float dpp_row_shr_c(float v) { return __int_as_float(__builtin_amdgcn_update_dpp(0, __float_as_int(v), 0x110 + N, 0xf, 0xf, false)); }
__device__ __forceinline__ float dpp_row_shr(float v, int n) { return n == 1 ? dpp_row_shr_c<1>(v) : n == 2 ? dpp_row_shr_c<2>(v) : n == 4 ? dpp_row_shr_c<4>(v) : dpp_row_shr_c<8>(v); }
__device__ __forceinline__ float sigmoidf_(float x) { return 1.0f / (1.0f + __expf(-x)); }
__device__ __forceinline__ float gelu_tanh(float x) { const float z = 0.7978845608028654f * (x + 0.044715f * x * x * x); const float e = __expf(2.0f * z); return 0.5f * x * (2.0f - 2.0f / (e + 1.0f)); }

struct EpiInProj {
    static constexpr bool PERM = true, AFTER_DRAIN = false;
    bf16_t* PJ; const float* rss; const float* rope;
    __device__ __forceinline__ void operator()(const f32x4 (&acc)[2][2][4][2], const pg8::Unit& u, int wr, int wc, int fr_, int fq_) const {
        int fr = fr_, fq = fq_; asm volatile("" : "+v"(fr), "+v"(fq));
#pragma unroll
        for (int bj = 0; bj < 2; ++bj) {
            const int cb = u.pn * 256 + bj * 128;
            if (cb >= DIN) continue;
            const int c0 = cb + wc * 32 + fq * 8;
            if (cb < C_V) {
                const bool isk = cb >= C_K; const int sb = isk ? C_K : 0; const int o = c0 - sb; const int hb = o & ~63; const int j0 = (o & 63) >> 1;
                const float qs = isk ? 1.0f : QSCALE;
#pragma unroll
                for (int ai = 0; ai < 2; ++ai)
#pragma unroll
                    for (int m = 0; m < 4; ++m) {
                        const int row = u.pm * 256 + ai * 128 + wr * 64 + m * 16 + fr;
                        const int pos = row < SEQ ? row : SEQ + ((row - SEQ) & 7);
                        const f32x4 t0 = *(const f32x4*)(rope + ((size_t)pos * 32 + j0) * 2), t1 = *(const f32x4*)(rope + ((size_t)pos * 32 + j0) * 2 + 4);
                        const float rsv = rsqrtf(rss[row] * (1.0f / DM) + EPS) * qs;
                        const f32x4 v0 = acc[ai][bj][m][0] * rsv, v1 = acc[ai][bj][m][1] * rsv;
                        f32x4 o1, o2;
                        o1[0] = v0[0] * t0[0] - v0[1] * t0[1]; o2[0] = v0[1] * t0[0] + v0[0] * t0[1];
                        o1[1] = v0[2] * t0[2] - v0[3] * t0[3]; o2[1] = v0[3] * t0[2] + v0[2] * t0[3];
                        o1[2] = v1[0] * t1[0] - v1[1] * t1[1]; o2[2] = v1[1] * t1[0] + v1[0] * t1[1];
                        o1[3] = v1[2] * t1[2] - v1[3] * t1[3]; o2[3] = v1[3] * t1[2] + v1[2] * t1[3];
                        bf16_t* pj = PJ + (size_t)row * PJP + sb + hb + j0;
                        *(u32x2*)pj = f4_to_bf4(o1); *(u32x2*)(pj + 32) = f4_to_bf4(o2);
                    }
            } else {
#pragma unroll
                for (int ai = 0; ai < 2; ++ai)
#pragma unroll
                    for (int m = 0; m < 4; ++m) {
                        const int row = u.pm * 256 + ai * 128 + wr * 64 + m * 16 + fr;
                        const float rsv = rsqrtf(rss[row] * (1.0f / DM) + EPS);
                        const f32x4 v0 = acc[ai][bj][m][0] * rsv, v1 = acc[ai][bj][m][1] * rsv;
                        u32x4 w; w.x = pk2(v0[0], v0[1]); w.y = pk2(v0[2], v0[3]); w.z = pk2(v1[0], v1[1]); w.w = pk2(v1[2], v1[3]);
                        *(u32x4*)(PJ + (size_t)row * PJP + c0) = w;
                    }
            }
        }
    }
};

struct EpiResid {
    static constexpr bool PERM = false, AFTER_DRAIN = false;
    const float* base_p; const float* base_s; float* X; bf16_t* XB; float* rss_out;
    __device__ __forceinline__ void operator()(const f32x4 (&acc)[2][2][4][2], const pg8::Unit& u, int wr, int wc, int fr, int fq) const {
#pragma unroll
        for (int ai = 0; ai < 2; ++ai)
#pragma unroll
            for (int m = 0; m < 4; ++m) {
                const int row = u.pm * 256 + ai * 128 + wr * 64 + m * 16 + fr;
                const float* b = row < SEQ ? base_p + (size_t)row * DM : base_s + (size_t)(row - SEQ) * DM;
                float ss = 0.f;
#pragma unroll
                for (int bj = 0; bj < 2; ++bj)
#pragma unroll
                    for (int n = 0; n < 2; ++n) {
                        const int col = u.pn * 256 + bj * 128 + wc * 32 + n * 16 + fq * 4;
                        const f32x4 x = *(const f32x4*)(b + col) + acc[ai][bj][m][n];
                        *(f32x4*)(X + (size_t)row * DM + col) = x;
                        *(u32x2*)(XB + (size_t)row * DM + col) = f4_to_bf4(x);
                        ss += (x[0] * x[0] + x[1] * x[1]) + (x[2] * x[2] + x[3] * x[3]);
                    }
                ss += __shfl_xor(ss, 16); ss += __shfl_xor(ss, 32);
                if (fq == 0) unsafeAtomicAdd(rss_out + row, ss);
            }
    }
};

struct EpiGateUp {
    static constexpr bool PERM = true, AFTER_DRAIN = false;
    bf16_t* HB; const float* rss;
    __device__ __forceinline__ void operator()(const f32x4 (&acc)[2][2][4][2], const pg8::Unit& u, int wr, int wc, int fr, int fq) const {
#pragma unroll
        for (int ai = 0; ai < 2; ++ai)
#pragma unroll
            for (int m = 0; m < 4; ++m) {
                const int row = u.pm * 256 + ai * 128 + wr * 64 + m * 16 + fr;
                const float rs = rsqrtf(rss[row] * (1.0f / DM) + EPS);
#pragma unroll
                for (int bj = 0; bj < 2; ++bj) {
                    const int hc = u.pn * 128 + bj * 64 + wc * 16 + fq * 4;
                    const f32x4 g = acc[ai][bj][m][0] * rs, up = acc[ai][bj][m][1] * rs;
                    f32x4 h;
#pragma unroll
                    for (int i = 0; i < 4; ++i) h[i] = g[i] * sigmoidf_(g[i]) * up[i];
                    *(u32x2*)(HB + (size_t)row * DFF + hc) = f4_to_bf4(h);
                }
            }
    }
};

__device__ __forceinline__ int colmap_in(int n) { if (n >= DIN) return -1; if (n >= C_V) return n; const int sb = n >= C_K ? C_K : 0; const int o = n - sb; return sb + (o & ~63) + ((o & 63) >> 1) + 32 * (o & 1); }
__device__ __forceinline__ int colmap_gu(int n) { return ((n >> 3) << 2) + (n & 3) + DFF * ((n >> 2) & 1); }

__device__ __forceinline__ void transpose_item(const float* __restrict__ W, int K, int Nsrc, const float* __restrict__ kscale, bf16_t* WT, int item, int nblk, int mode, LAS float* scr, int lane) {
    const int kb = item / nblk, nb = item - kb * nblk, k0 = 64 * kb, n0 = 32 * nb;
    const int ch = lane & 7, rsub = lane >> 3, c4 = ch & 3, hi = ch >> 2;
    int srccol, x0, xs;
    bool zero = false;
    if (mode == 1 && n0 < C_V) { const int sb = n0 >= C_K ? C_K : 0, o = n0 - sb; srccol = sb + (o & ~63) + ((o & 63) >> 1) + 32 * hi + 4 * c4; x0 = 8 * c4 + hi; xs = 2; }
    else if (mode == 2) { srccol = (n0 >> 1) + DFF * hi + 4 * c4; x0 = 8 * c4 + 4 * hi; xs = 1; }
    else { srccol = n0 + 4 * ch; x0 = 4 * ch; xs = 1; zero = (mode == 1 && n0 >= DIN); }
    f32x4 v[8];
#pragma unroll
    for (int i = 0; i < 8; ++i) v[i] = zero ? (f32x4){0.f, 0.f, 0.f, 0.f} : *(const f32x4*)(W + (size_t)(k0 + 8 * i + rsub) * Nsrc + srccol);
#pragma unroll
    for (int i = 0; i < 8; ++i) {
        const int kk = 8 * i + rsub; const float sc = kscale ? kscale[k0 + kk] : 1.0f;
#pragma unroll
        for (int e = 0; e < 4; ++e) scr[kk * 33 + x0 + xs * e] = v[i][e] * sc;
    }
    asm volatile("s_waitcnt lgkmcnt(0)" ::: "memory");
    const int c = lane & 7;
#pragma unroll
    for (int j = 0; j < 4; ++j) {
        const int n = (lane >> 3) + 8 * j; const LAS float* s = scr + (8 * c) * 33 + n;
        u32x4 o; o.x = pk2(s[0 * 33], s[1 * 33]); o.y = pk2(s[2 * 33], s[3 * 33]); o.z = pk2(s[4 * 33], s[5 * 33]); o.w = pk2(s[6 * 33], s[7 * 33]);
        *(u32x4*)(WT + (size_t)(n0 + n) * K + k0 + 8 * c) = o;
    }
    asm volatile("s_waitcnt lgkmcnt(0)" ::: "memory");
}

__device__ __forceinline__ void prologue(KP P, LAS unsigned char* lds) {
    const int tid = opaque_tid(), lane = tid & 63, wave = tid >> 6;
    const int gw = blockIdx.x * 8 + wave, NGW = gridDim.x * 8;
    const int gt = blockIdx.x * 512 + tid, NGT = gridDim.x * 512;
    unsigned char* ws = P->ws;
    LAS float* scr = (LAS float*)(lds + wave * 8704);
    constexpr int I_IN = 16 * (DINP / 32), I_OUT = 16 * (DM / 32), I_GU = 16 * (NGU / 32), I_DN = (DFF / 64) * (DM / 32), I_L = I_IN + I_OUT + I_GU + I_DN;
    for (int it = gw; it < 2 * I_L; it += NGW) {
        const int l = it / I_L; int r = it - l * I_L;
        if (r < I_IN) { transpose_item(P->in[I_WIN] + (size_t)l * DM * DIN, DM, DIN, P->in[I_N1G] + l * DM, (bf16_t*)(ws + WS_WIN) + (size_t)l * DINP * DM, r, DINP / 32, 1, scr, lane); continue; } r -= I_IN;
        if (r < I_OUT) { transpose_item(P->in[I_WOUT] + (size_t)l * DM * DM, DM, DM, nullptr, (bf16_t*)(ws + WS_WOUT) + (size_t)l * DM * DM, r, DM / 32, 0, scr, lane); continue; } r -= I_OUT;
        if (r < I_GU) { transpose_item(P->in[I_WGU] + (size_t)l * DM * NGU, DM, NGU, P->in[I_N2G] + l * DM, (bf16_t*)(ws + WS_WGU) + (size_t)l * NGU * DM, r, NGU / 32, 2, scr, lane); continue; } r -= I_GU;
        transpose_item(P->in[I_WDN] + (size_t)l * DFF * DM, DFF, DM, nullptr, (bf16_t*)(ws + WS_WDN) + (size_t)l * DM * DFF, r, DM / 32, 0, scr, lane);
    }
    float* rss = (float*)(ws + WS_RSS);
    bf16_t* XB = (bf16_t*)(ws + WS_XB);
    for (int row0 = gw; row0 < MT; row0 += 4 * NGW) {
        f32x4 v[4][4];
#pragma unroll
        for (int r = 0; r < 4; ++r) { const int row = row0 + r * NGW; if (row < MT) { const float* xr = row < SEQ ? P->in[I_XP] + (size_t)row * DM : P->in[I_XS] + (size_t)(row - SEQ) * DM;
#pragma unroll
            for (int j = 0; j < 4; ++j) v[r][j] = *(const f32x4*)(xr + 4 * lane + 256 * j); } }
#pragma unroll
        for (int r = 0; r < 4; ++r) { const int row = row0 + r * NGW; if (row < MT) { float sm = 0.f;
#pragma unroll
            for (int j = 0; j < 4; ++j) { const f32x4 x = v[r][j]; sm += (x[0] * x[0] + x[1] * x[1]) + (x[2] * x[2] + x[3] * x[3]); *(u32x2*)(XB + (size_t)row * DM + 4 * lane + 256 * j) = f4_to_bf4(x); }
            sm = wave_sum(sm);
            if (lane == 0) rss[row] = sm; } }
    }
    for (int i = gt; i < 4 * MT; i += NGT) rss[MT + i] = 0.f;
    bf16_t* WA = (bf16_t*)(ws + WS_WA); bf16_t* WX = (bf16_t*)(ws + WS_WX); bf16_t* WP = (bf16_t*)(ws + WS_WP);
    for (int i = gt; i < 2 * 6 * 64 * 64; i += NGT) {
        const int slot = i & 63, d = (i >> 6) & 63, ln = i >> 12;
        const int kk = slot >> 5, q = (slot >> 3) & 3, e = slot & 7, c = 16 * (2 * kk + (e >> 2)) + 4 * q + (e & 3);
        const size_t src = ((size_t)ln * 64 + c) * 64 + d;
        WA[i] = (bf16_t)(pk2(P->in[I_GAW][src], 0.f) & 0xffffu); WX[i] = (bf16_t)(pk2(P->in[I_GXW][src], 0.f) & 0xffffu);
    }
    for (int i = gt; i < 2 * 4 * 64 * 64; i += NGT) {
        const int c = i & 63, d = (i >> 6) & 63, lg = i >> 12;
        WP[i] = (bf16_t)(pk2(P->in[I_POOLW][((size_t)lg * 64 + c) * 64 + d], 0.f) & 0xffffu);
    }
    float* rope = (float*)(ws + WS_ROPE);
    {
        const int j = gt & 31;
        const float inv = (float)exp2(-(double)j * (13.287712379549449 / 32.0));
        for (int pos = gt >> 5; pos < 16392; pos += NGT >> 5) {
            const float ang = (float)pos * inv;
            double rev = (double)ang * 0.15915494309189535; rev -= floor(rev);
            const float rf = (float)rev;
            *(f32x2*)(rope + 2 * ((size_t)pos * 32 + j)) = (f32x2){__builtin_amdgcn_cosf(rf), __builtin_amdgcn_sinf(rf)};
        }
    }
}

__device__ __forceinline__ void pool_row8(KP P, const bf16_t* PJ, int l, int R, int k, int ch, float (&v)[8]) {
    if (R < SEQ) {
        const int rr = R - k;
        if (rr < 0) {
#pragma unroll
            for (int i = 0; i < 8; ++i) v[i] = 0.f;
            return; }
        const u32x4 w = *(const u32x4*)(PJ + (size_t)rr * PJP + C_U + ch);
        v[0] = bf_lo(w.x); v[1] = bf_hi(w.x); v[2] = bf_lo(w.y); v[3] = bf_hi(w.y); v[4] = bf_lo(w.z); v[5] = bf_hi(w.z); v[6] = bf_lo(w.w); v[7] = bf_hi(w.w);
    } else {
        const int si = R - SEQ, b = si >> 3, t = si & 7, tk = t - k;
        if (tk >= 0) {
            const u32x4 w = *(const u32x4*)(PJ + (size_t)(SEQ + 8 * b + tk) * PJP + C_U + ch);
            v[0] = bf_lo(w.x); v[1] = bf_hi(w.x); v[2] = bf_lo(w.y); v[3] = bf_hi(w.y); v[4] = bf_lo(w.z); v[5] = bf_hi(w.z); v[6] = bf_lo(w.w); v[7] = bf_hi(w.w);
        } else {
            const float* s = P->in[I_SPOOL] + (((size_t)l * 32 + b) * 15 + (15 + tk)) * 256 + ch;
            const f32x4 a = *(const f32x4*)s, c = *(const f32x4*)(s + 4);
            v[0] = a[0]; v[1] = a[1]; v[2] = a[2]; v[3] = a[3]; v[4] = c[0]; v[5] = c[1]; v[6] = c[2]; v[7] = c[3];
        }
    }
}

constexpr int TLP = 136;
__device__ __forceinline__ void pool_task(KP P, int l, int task, int lane, LAS unsigned char* wl) {
    const int g = task & 3, T0 = (task >> 2) * 64, w = 2 << g, fr = lane & 15, fq = lane >> 4;
    const bool smp = T0 >= SEQ;
    const bf16_t* PJ = (const bf16_t*)(P->ws + WS_PJ); bf16_t* MIX = (bf16_t*)(P->ws + WS_MIX);
    const bf16_t* WP = (const bf16_t*)(P->ws + WS_WP) + (size_t)(l * 4 + g) * 4096;
    if (!smp) {
#pragma unroll
        for (int i = 0; i < 10; ++i) {
            const int rr = 8 * i + (lane >> 3), gr = T0 - 15 + rr;
            u32x4 v = (u32x4){0u, 0u, 0u, 0u};
            if (rr < 79 && gr >= 0) v = *(const u32x4*)(PJ + (size_t)gr * PJP + C_U + 64 * g + 8 * (lane & 7));
            if (rr < 79) *(LAS u32x4*)(wl + rr * TLP + 16 * (lane & 7)) = v;
        }
    }
    bf16x8 af[4][2];
#pragma unroll
    for (int dt = 0; dt < 4; ++dt)
#pragma unroll
        for (int kk = 0; kk < 2; ++kk) af[dt][kk] = *(const bf16x8*)(WP + (16 * dt + fr) * 64 + 32 * kk + 8 * fq);
    f32x4 sc[4];
#pragma unroll
    for (int dt = 0; dt < 4; ++dt) sc[dt] = *(const f32x4*)(P->in[I_POOLS] + l * 256 + 64 * g + 16 * dt + 4 * fq);
#pragma unroll 1
    for (int tt = 0; tt < 4; ++tt) {
        const int R = T0 + 16 * tt + fr;
        const int pos1 = R < SEQ ? R + 1 : SEQ + 1;
        const float rc = 1.0f / (float)(pos1 < w ? pos1 : w);
        bf16x8 bfr[2];
#pragma unroll
        for (int kk = 0; kk < 2; ++kk) {
            float s[8], u0[8];
            if (!smp) {
                const LAS unsigned char* rp = wl + (15 + 16 * tt + fr) * TLP + 2 * (32 * kk + 8 * fq);
                { const u32x4 x = *(const LAS u32x4*)rp; u0[0] = bf_lo(x.x); u0[1] = bf_hi(x.x); u0[2] = bf_lo(x.y); u0[3] = bf_hi(x.y); u0[4] = bf_lo(x.z); u0[5] = bf_hi(x.z); u0[6] = bf_lo(x.w); u0[7] = bf_hi(x.w); }
#pragma unroll
                for (int i = 0; i < 8; ++i) s[i] = u0[i];
                for (int k = 1; k < w; ++k) {
                    const u32x4 x = *(const LAS u32x4*)(rp - k * TLP);
                    s[0] += bf_lo(x.x); s[1] += bf_hi(x.x); s[2] += bf_lo(x.y); s[3] += bf_hi(x.y); s[4] += bf_lo(x.z); s[5] += bf_hi(x.z); s[6] += bf_lo(x.w); s[7] += bf_hi(x.w);
                }
            } else {
                const int ch = 64 * g + 32 * kk + 8 * fq;
                pool_row8(P, PJ, l, R, 0, ch, u0);
#pragma unroll
                for (int i = 0; i < 8; ++i) s[i] = u0[i];
                for (int k = 1; k < w; ++k) {
                    float v[8]; pool_row8(P, PJ, l, R, k, ch, v);
#pragma unroll
                    for (int i = 0; i < 8; ++i) s[i] += v[i];
                }
            }
            u32x4 pw;
            pw.x = pk2(s[0] * rc - u0[0], s[1] * rc - u0[1]); pw.y = pk2(s[2] * rc - u0[2], s[3] * rc - u0[3]);
            pw.z = pk2(s[4] * rc - u0[4], s[5] * rc - u0[5]); pw.w = pk2(s[6] * rc - u0[6], s[7] * rc - u0[7]);
            bfr[kk] = __builtin_bit_cast(bf16x8, pw);
        }
#pragma unroll
        for (int dt = 0; dt < 4; ++dt) {
            f32x4 y = (f32x4){0.f, 0.f, 0.f, 0.f};
            y = __builtin_amdgcn_mfma_f32_16x16x32_bf16(af[dt][0], bfr[0], y, 0, 0, 0);
            y = __builtin_amdgcn_mfma_f32_16x16x32_bf16(af[dt][1], bfr[1], y, 0, 0, 0);
            y = y * sc[dt];
            *(u32x2*)(MIX + (size_t)R * DM + 384 + 64 * g + 16 * dt + 4 * fq) = f4_to_bf4(y);
        }
    }
}

__device__ __forceinline__ void rglru_local_task(KP P, int l, int task, int lane, LAS unsigned char* wl) {
    const int c64 = task / 6, n = task - 6 * c64, T0 = c64 * 64, fr = lane & 15, fq = lane >> 4;
    const bool smp = T0 >= SEQ;
    const bf16_t* PJ = (const bf16_t*)(P->ws + WS_PJ);
    float* HL = (float*)(P->ws + WS_HL); float* PC = (float*)(P->ws + WS_PC);
    const bf16_t* WA = (const bf16_t*)(P->ws + WS_WA) + (size_t)(l * 6 + n) * 4096; const bf16_t* WX = (const bf16_t*)(P->ws + WS_WX) + (size_t)(l * 6 + n) * 4096;
    LAS float* cst = (LAS float*)(wl + 12288);
    if (!smp) {
#pragma unroll
        for (int i = 0; i < 9; ++i) {
            const int rr = 8 * i + (lane >> 3), gr = T0 - 3 + rr;
            u32x4 v = (u32x4){0u, 0u, 0u, 0u};
            if (rr < 67 && gr >= 0) v = *(const u32x4*)(PJ + (size_t)gr * PJP + C_XR + 64 * n + 8 * (lane & 7));
            if (rr < 67) *(LAS u32x4*)(wl + rr * TLP + 16 * (lane & 7)) = v;
        }
    } else {
        for (int i = 0; i < 11; ++i) {
            const int rr = 8 * i + (lane >> 3), bb = rr / 11, k = rr - 11 * bb, b = ((T0 - SEQ) >> 3) + bb, c8 = 64 * n + 8 * (lane & 7);
            u32x4 v;
            if (k < 3) { const float* sp = P->in[I_SCONV] + (((size_t)l * 32 + b) * 3 + k) * 384 + c8; const f32x4 a = *(const f32x4*)sp, c = *(const f32x4*)(sp + 4);
                v.x = pk2(a[0], a[1]); v.y = pk2(a[2], a[3]); v.z = pk2(c[0], c[1]); v.w = pk2(c[2], c[3]); }
            else v = *(const u32x4*)(PJ + (size_t)(SEQ + 8 * b + (k - 3)) * PJP + C_XR + c8);
            *(LAS u32x4*)(wl + rr * TLP + 16 * (lane & 7)) = v;
        }
    }
    {
        const int ch = l * 384 + 64 * n + lane;
#pragma unroll
        for (int j = 0; j < 4; ++j) cst[j * 64 + lane] = P->in[I_CONVW][(size_t)l * 3 * 384 + j * 384 + ch];
        cst[4 * 64 + lane] = P->in[I_CONVB][ch]; cst[5 * 64 + lane] = P->in[I_GAB][ch]; cst[6 * 64 + lane] = P->in[I_GXB][ch];
        cst[7 * 64 + lane] = -log1pf(__expf(-P->in[I_LAM][ch]));
    }
    bf16x8 wa[4][2], wx[4][2];
#pragma unroll
    for (int dt = 0; dt < 4; ++dt)
#pragma unroll
        for (int kk = 0; kk < 2; ++kk) { wa[dt][kk] = *(const bf16x8*)(WA + (16 * dt + fr) * 64 + 32 * kk + 8 * fq); wx[dt][kk] = *(const bf16x8*)(WX + (16 * dt + fr) * 64 + 32 * kk + 8 * fq); }
    f32x4 Pc[4], Hc[4];
#pragma unroll
    for (int dt = 0; dt < 4; ++dt) { Pc[dt] = (f32x4){1.f, 1.f, 1.f, 1.f}; Hc[dt] = (f32x4){0.f, 0.f, 0.f, 0.f}; }
    const int segm = smp ? 7 : 15;
#pragma unroll 1
    for (int tt = 0; tt < 4; ++tt) {
        const int ti = 16 * tt + fr, R = T0 + ti;
        const int trow = smp ? (ti >> 3) * 11 + (ti & 7) : ti;
        f32x4 xc[4];
#pragma unroll
        for (int dt = 0; dt < 4; ++dt) {
            const int cl = 16 * dt + 4 * fq;
            f32x4 a = *(const LAS f32x4*)(cst + 4 * 64 + cl);
#pragma unroll
            for (int j = 0; j < 4; ++j) a += *(const LAS f32x4*)(cst + j * 64 + cl) * bf4_to_f4(*(const LAS u32x2*)(wl + (trow + j) * TLP + 2 * cl));
            xc[dt] = a;
        }
        bf16x8 bfr[2];
#pragma unroll
        for (int kk = 0; kk < 2; ++kk) { u32x4 pw; pw.x = pk2(xc[2 * kk][0], xc[2 * kk][1]); pw.y = pk2(xc[2 * kk][2], xc[2 * kk][3]); pw.z = pk2(xc[2 * kk + 1][0], xc[2 * kk + 1][1]); pw.w = pk2(xc[2 * kk + 1][2], xc[2 * kk + 1][3]); bfr[kk] = __builtin_bit_cast(bf16x8, pw); }
#pragma unroll
        for (int dt = 0; dt < 4; ++dt) {
            const int cl = 16 * dt + 4 * fq, ch = 64 * n + cl;
            f32x4 ra = (f32x4){0.f, 0.f, 0.f, 0.f}, ia = (f32x4){0.f, 0.f, 0.f, 0.f};
            ra = __builtin_amdgcn_mfma_f32_16x16x32_bf16(wa[dt][0], bfr[0], ra, 0, 0, 0); ra = __builtin_amdgcn_mfma_f32_16x16x32_bf16(wa[dt][1], bfr[1], ra, 0, 0, 0);
            ia = __builtin_amdgcn_mfma_f32_16x16x32_bf16(wx[dt][0], bfr[0], ia, 0, 0, 0); ia = __builtin_amdgcn_mfma_f32_16x16x32_bf16(wx[dt][1], bfr[1], ia, 0, 0, 0);
            const f32x4 ba = *(const LAS f32x4*)(cst + 5 * 64 + cl), bx = *(const LAS f32x4*)(cst + 6 * 64 + cl), ls = *(const LAS f32x4*)(cst + 7 * 64 + cl);
            f32x4 A, B;
#pragma unroll
            for (int i = 0; i < 4; ++i) {
                const float r = fsigmoid(ra[i] + ba[i]), ig = fsigmoid(ia[i] + bx[i]);
                const float a = fexp2(11.541560327111707f * r * ls[i]);
                A[i] = a; B[i] = __builtin_amdgcn_sqrtf(fmaxf(1.0f - a * a, 0.f)) * ig * xc[dt][i];
            }
#pragma unroll
            for (int off = 1; off < 16; off <<= 1) {
                if (off == 8 && smp) break;
                const bool cnd = (fr & segm) >= off;
#pragma unroll
                for (int i = 0; i < 4; ++i) {
                    const float ap = dpp_row_shr(A[i], off), bp = dpp_row_shr(B[i], off);
                    if (cnd) { B[i] = A[i] * bp + B[i]; A[i] = A[i] * ap; }
                }
            }
            const f32x4 h = B + A * Hc[dt], p = A * Pc[dt];
            *(f32x4*)(HL + (size_t)R * 384 + ch) = h; *(f32x4*)(PC + (size_t)R * 384 + ch) = p;
            if (!smp) {
#pragma unroll
                for (int i = 0; i < 4; ++i) { Hc[dt][i] = __shfl(h[i], (lane & 48) | 15); Pc[dt][i] = __shfl(p[i], (lane & 48) | 15); }
            }
        }
    }
    if (!smp && fr == 0) {
#pragma unroll
        for (int dt = 0; dt < 4; ++dt) {
            const int ch = 64 * n + 16 * dt + 4 * fq;
            *(f32x4*)((float*)(P->ws + WS_CA) + (size_t)c64 * 384 + ch) = Pc[dt]; *(f32x4*)((float*)(P->ws + WS_CH) + (size_t)c64 * 384 + ch) = Hc[dt];
        }
    }
}

__device__ __forceinline__ void phase2(KP P, int l, LAS unsigned char* lds) {
    const int tid = opaque_tid(), lane = tid & 63, wave = tid >> 6;
    const int gw = blockIdx.x * 8 + wave, NGW = gridDim.x * 8;
    const int gt = blockIdx.x * 512 + tid, NGT = gridDim.x * 512;
    constexpr int NT_R = NCH * 6, NT_P = NCH * 4;
    for (int t = gw; t < NT_R + NT_P; t += NGW) { LAS unsigned char* wl = lds + wave * 16384; if (t < NT_R) rglru_local_task(P, l, t, lane, wl); else pool_task(P, l, t - NT_R, lane, wl); }
    {
        const bf16_t* PJ = (const bf16_t*)(P->ws + WS_PJ); float* out = P->out;
        for (int i = gt; i < 2048 * 192; i += NGT) {
            const int r = i / 192, c4 = (i - r * 192) * 4, kv = c4 >= 384, c = c4 - 384 * kv;
            *(f32x4*)(out + (kv ? OFF_PWV : OFF_PWK) + ((size_t)l * 2048 + r) * 384 + c) = bf4_to_f4(*(const u32x2*)(PJ + (size_t)(SEQ - 2048 + r) * PJP + C_K + c4));
        }
        for (int i = gt; i < 256 * 192; i += NGT) {
            const int si = i / 192, c4 = (i - si * 192) * 4, kv = c4 >= 384, c = c4 - 384 * kv;
            *(f32x4*)(out + (kv ? OFF_SWV : OFF_SWK) + (((size_t)l * 32 + (si >> 3)) * 2048 + 2040 + (si & 7)) * 384 + c) = bf4_to_f4(*(const u32x2*)(PJ + (size_t)(SEQ + si) * PJP + C_K + c4));
        }
        for (int i = gt; i < 15 * 64; i += NGT) {
            const int r = i >> 6, c = (i & 63) * 4;
            *(f32x4*)(out + OFF_PPOOL + ((size_t)l * 15 + r) * 256 + c) = bf4_to_f4(*(const u32x2*)(PJ + (size_t)(SEQ - 15 + r) * PJP + C_U + c));
        }
        for (int i = gt; i < 256 * 64; i += NGT) {
            const int si = i >> 6, c = (i & 63) * 4;
            *(f32x4*)(out + OFF_SPOOL + (((size_t)l * 32 + (si >> 3)) * 15 + 7 + (si & 7)) * 256 + c) = bf4_to_f4(*(const u32x2*)(PJ + (size_t)(SEQ + si) * PJP + C_U + c));
        }
        for (int i = gt; i < 3 * 96; i += NGT) {
            const int r = i / 96, c = (i - r * 96) * 4;
            *(f32x4*)(out + OFF_PCONV + ((size_t)l * 3 + r) * 384 + c) = bf4_to_f4(*(const u32x2*)(PJ + (size_t)(SEQ - 3 + r) * PJP + C_XR + c));
        }
        for (int i = gt; i < 32 * 3 * 96; i += NGT) {
            const int br = i / 96, c = (i - br * 96) * 4, b = br / 3, r = br - 3 * b;
            *(f32x4*)(out + OFF_SCONV + (((size_t)l * 32 + b) * 3 + r) * 384 + c) = bf4_to_f4(*(const u32x2*)(PJ + (size_t)(SEQ + 8 * b + 5 + r) * PJP + C_XR + c));
        }
    }
    for (int i = gt; i < 32 * 7 * 256; i += NGT) {
        const int b = i / 1792, rem = i - b * 1792;
        P->out[OFF_SPOOL + ((size_t)l * 32 + b) * 15 * 256 + rem] = P->in[I_SPOOL][((size_t)l * 32 + b) * 15 * 256 + 8 * 256 + rem];
    }
}

__device__ __forceinline__ void rglru_fix_task(KP P, int l, int task, LAS unsigned char* lds) {
    const int tid = opaque_tid(), c = task / 3, cg_ = task - 3 * c, chl = tid & 127, seg = tid >> 7, ch = 128 * cg_ + chl;
    const float* CA = (const float*)(P->ws + WS_CA); const float* CH = (const float*)(P->ws + WS_CH);
    const float* HL = (const float*)(P->ws + WS_HL); const float* PC = (const float*)(P->ws + WS_PC);
    const bf16_t* PJ = (const bf16_t*)(P->ws + WS_PJ); bf16_t* MIX = (bf16_t*)(P->ws + WS_MIX);
    LAS float* sA = (LAS float*)lds; LAS float* sH = sA + 512;
    float carry = 0.f;
    const bool smp = c >= 256;
    if (!smp) {
        const int q = (c + 3) >> 2, k0 = seg * q, k1 = (k0 + q) < c ? (k0 + q) : c;
        float a = 1.f, h = 0.f;
        for (int kb_ = k0; kb_ < k1; kb_ += 16) {
            float ak[16], hk[16];
#pragma unroll
            for (int u_ = 0; u_ < 16; ++u_) { const int k = (kb_ + u_) < k1 ? (kb_ + u_) : (k1 - 1); ak[u_] = CA[(size_t)k * 384 + ch]; hk[u_] = CH[(size_t)k * 384 + ch]; }
#pragma unroll
            for (int u_ = 0; u_ < 16; ++u_) if (kb_ + u_ < k1) { h = ak[u_] * h + hk[u_]; a *= ak[u_]; }
        }
        sA[seg * 128 + chl] = a; sH[seg * 128 + chl] = h;
        __syncthreads();
#pragma unroll
        for (int s = 0; s < 4; ++s) carry = sA[s * 128 + chl] * carry + sH[s * 128 + chl];
    }
    const int T0 = c * 64 + seg * 16;
    float hl[16], pc[16]; unsigned short gg[16];
#pragma unroll
    for (int i = 0; i < 16; ++i) { const int R = T0 + i; hl[i] = HL[(size_t)R * 384 + ch]; pc[i] = PC[(size_t)R * 384 + ch]; gg[i] = PJ[(size_t)R * PJP + C_GT + ch]; }
    float h0v = 0.f, h1v = 0.f;
    if (smp) { h0v = P->in[I_SRG][((size_t)l * 32 + ((T0 - SEQ) >> 3)) * 384 + ch]; h1v = P->in[I_SRG][((size_t)l * 32 + ((T0 - SEQ) >> 3) + 1) * 384 + ch]; }
#pragma unroll
    for (int i = 0; i < 16; ++i) {
        const int R = T0 + i;
        const float cin = smp ? (i < 8 ? h0v : h1v) : carry;
        const float h = hl[i] + pc[i] * cin;
        const float g = __uint_as_float((unsigned)gg[i] << 16);
        const float y = h * gelu_tanh(g);
        MIX[(size_t)R * DM + 640 + ch] = (bf16_t)(pk2(y, 0.f) & 0xffffu);
        if (R == SEQ - 1) P->out[OFF_PRG + l * 384 + ch] = h;
        if (smp && (i & 7) == 7) P->out[OFF_SRG + ((size_t)l * 32 + ((R - SEQ) >> 3)) * 384 + ch] = h;
    }
    __syncthreads();
}

__device__ __forceinline__ s16x4 vtr(const LAS unsigned char* p) { return __builtin_bit_cast(s16x4, __builtin_amdgcn_ds_read_tr16_b64_v4i16((LAS s16x4*)p)); }

constexpr int VRP = 144;
constexpr int ATT_STEPS = 23;
__device__ __forceinline__ void att_step_info(int st, int& sh, int& s) { if (st < 12) { sh = 0; s = st; } else if (st < 18) { sh = 2; s = st - 12; } else { sh = 4; s = st - 18; } }

struct AttKV { bf16x8 k[2][2]; u32x4 v[4]; };
__device__ __forceinline__ void att_load(AttKV& b, int st, int p0, int fr, int lane, const bf16_t* Kb, const bf16_t* Vb) {
    int sh, s; att_step_info(st, sh, s);
    const int kbase = p0 - (128 << sh);
#pragma unroll
    for (int kt = 0; kt < 2; ++kt) { int pk = kbase + ((32 * s + 16 * kt + fr) << sh); pk = pk < 0 ? 0 : (pk > MT - 1 ? MT - 1 : pk);
        b.k[kt][0] = *(const bf16x8*)(Kb + (size_t)pk * PJP); b.k[kt][1] = *(const bf16x8*)(Kb + (size_t)pk * PJP + 32); }
    int pv = kbase + ((32 * s + (lane >> 1)) << sh); pv = pv < 0 ? 0 : (pv > MT - 1 ? MT - 1 : pv);
#pragma unroll
    for (int i = 0; i < 4; ++i) b.v[i] = *(const u32x4*)(Vb + (size_t)pv * PJP + 8 * i);
}
__device__ __forceinline__ void att_compute(const AttKV& b, int st, int p0, int fr, int fq, const bf16x8 qf0, const bf16x8 qf1, float& m, float& lsum, f32x4 (&o)[4],
                                            LAS unsigned char* vw, const LAS unsigned char* vr) {
    int sh, s; att_step_info(st, sh, s);
    const int kbase = p0 - (128 << sh);
    f32x4 sc[2];
#pragma unroll
    for (int kt = 0; kt < 2; ++kt) {
        sc[kt] = __builtin_amdgcn_mfma_f32_16x16x32_bf16(b.k[kt][0], qf0, (f32x4){0.f, 0.f, 0.f, 0.f}, 0, 0, 0);
        sc[kt] = __builtin_amdgcn_mfma_f32_16x16x32_bf16(b.k[kt][1], qf1, sc[kt], 0, 0, 0);
    }
    const int qe = ((16 >> sh) * fr) + 128;
    float mx = -INFINITY;
#pragma unroll
    for (int kt = 0; kt < 2; ++kt)
#pragma unroll
        for (int i = 0; i < 4; ++i) {
            const int j = 32 * s + 16 * kt + 4 * fq + i, e = qe - j, pk = kbase + (j << sh);
            const bool ok = (e >= 0) && (e <= 128) && (pk >= 0);
            sc[kt][i] = ok ? sc[kt][i] : -INFINITY;
            mx = fmaxf(mx, sc[kt][i]);
        }
    mx = fmaxf(mx, __shfl_xor(mx, 16)); mx = fmaxf(mx, __shfl_xor(mx, 32));
    const float mn = fmaxf(m, mx), al = fexp2(m - mn);
    m = mn;
    float ps = 0.f;
#pragma unroll
    for (int kt = 0; kt < 2; ++kt)
#pragma unroll
        for (int i = 0; i < 4; ++i) { sc[kt][i] = fexp2(sc[kt][i] - mn); ps += sc[kt][i]; }
    lsum = lsum * al + ps;
    u32x4 pw; pw.x = pk2(sc[0][0], sc[0][1]); pw.y = pk2(sc[0][2], sc[0][3]); pw.z = pk2(sc[1][0], sc[1][1]); pw.w = pk2(sc[1][2], sc[1][3]);
    const bf16x8 pb8 = __builtin_bit_cast(bf16x8, pw);
#pragma unroll
    for (int i = 0; i < 4; ++i) *(LAS u32x4*)(vw + 16 * i) = b.v[i];
#pragma unroll
    for (int dt = 0; dt < 4; ++dt) {
        const s16x4 lo = vtr(vr + dt * 32), hi = vtr(vr + 16 * VRP + dt * 32);
        const bf16x8 vf = __builtin_shufflevector(lo, hi, 0, 1, 2, 3, 4, 5, 6, 7);
        o[dt] = o[dt] * al;
        o[dt] = __builtin_amdgcn_mfma_f32_16x16x32_bf16(vf, pb8, o[dt], 0, 0, 0);
    }
}

constexpr int CPY_SEG = 2040 * 384 / 4, CPY_KV = 32 * CPY_SEG, CPY_TOT = 2 * CPY_KV;
__device__ __forceinline__ void cpy_addr(KP P, int l, int i, const f32x4*& src, f32x4*& dst) {
    const int kv = i >= CPY_KV, r = i - kv * CPY_KV, b = r / CPY_SEG, off = r - b * CPY_SEG;
    src = (const f32x4*)(P->in[kv ? I_CV : I_CK] + (((size_t)l * 32 + b) * 2048 + 8) * 384) + off;
    dst = (f32x4*)(P->out + (kv ? OFF_SWV : OFF_SWK) + ((size_t)l * 32 + b) * 2048 * 384) + off;
}
__device__ __forceinline__ void attn_tile(KP P, int l, int wt, int gw, int NGW, int tk, int lane, LAS unsigned char* vl) {
    const int r = wt & 15, hh = (wt >> 4) % 6, pb = wt / 96, p0 = pb * 256 + r, fr = lane & 15, fq = lane >> 4;
    const bf16_t* PJ = (const bf16_t*)(P->ws + WS_PJ); bf16_t* MIX = (bf16_t*)(P->ws + WS_MIX);
    const bf16_t* qp = PJ + (size_t)(p0 + 16 * fr) * PJP + C_Q + 64 * hh + 8 * fq;
    const bf16x8 qf0 = *(const bf16x8*)qp, qf1 = *(const bf16x8*)(qp + 32);
    const bf16_t* Kb = PJ + C_K + 64 * hh + 8 * fq;
    const bf16_t* Vb = PJ + C_V + 64 * hh + 32 * (lane & 1);
    float m = -1e30f, lsum = 0.f;
    f32x4 o[4];
#pragma unroll
    for (int dt = 0; dt < 4; ++dt) o[dt] = (f32x4){0.f, 0.f, 0.f, 0.f};
    LAS unsigned char* vw = vl + (lane >> 1) * VRP + (lane & 1) * 64;
    const LAS unsigned char* vr = vl + (4 * fq + (fr >> 2)) * VRP + (fr & 3) * 8;
    AttKV b0, b1, b2;
    att_load(b0, 0, p0, fr, lane, Kb, Vb); att_load(b1, 1, p0, fr, lane, Kb, Vb);
#pragma unroll 1
    for (int st = 0; st < ATT_STEPS; st += 3) {
        f32x4 cv_[4];
        const int cbase = ((tk * 8 + st / 3) * 4) * NGW + gw;
#pragma unroll
        for (int u = 0; u < 4; ++u) { const int i = (cbase + u * NGW) * 64 + lane; if (i < CPY_TOT) { const f32x4* sp; f32x4* dp; cpy_addr(P, l, i, sp, dp); cv_[u] = __builtin_nontemporal_load(sp); } }
        if (st + 2 < ATT_STEPS) att_load(b2, st + 2, p0, fr, lane, Kb, Vb);
        att_compute(b0, st, p0, fr, fq, qf0, qf1, m, lsum, o, vw, vr);
        if (st + 3 < ATT_STEPS) att_load(b0, st + 3, p0, fr, lane, Kb, Vb);
        if (st + 1 < ATT_STEPS) att_compute(b1, st + 1, p0, fr, fq, qf0, qf1, m, lsum, o, vw, vr);
        if (st + 4 < ATT_STEPS) att_load(b1, st + 4, p0, fr, lane, Kb, Vb);
        if (st + 2 < ATT_STEPS) att_compute(b2, st + 2, p0, fr, fq, qf0, qf1, m, lsum, o, vw, vr);
#pragma unroll
        for (int u = 0; u < 4; ++u) { const int i = (cbase + u * NGW) * 64 + lane; if (i < CPY_TOT) { const f32x4* sp; f32x4* dp; cpy_addr(P, l, i, sp, dp); __builtin_nontemporal_store(cv_[u], dp); } }
    }
    lsum += __shfl_xor(lsum, 16); lsum += __shfl_xor(lsum, 32);
    const float inv = 1.0f / lsum;
    bf16_t* op = MIX + (size_t)(p0 + 16 * fr) * DM + 64 * hh + 4 * fq;
#pragma unroll
    for (int dt = 0; dt < 4; ++dt) *(u32x2*)(op + 16 * dt) = f4_to_bf4(o[dt] * inv);
}

__device__ __forceinline__ void sattn_block_task(KP P, int l, int task, LAS unsigned char* lds) {
    const int tid = opaque_tid(), lane = tid & 63, wave = tid >> 6, l32 = lane & 31, half = lane >> 5;
    const int b = task >> 3, t = task & 7, row = SEQ + task;
    const bf16_t* PJ = (const bf16_t*)(P->ws + WS_PJ); bf16_t* MIX = (bf16_t*)(P->ws + WS_MIX);
    f32x4 q[3];
#pragma unroll
    for (int i = 0; i < 3; ++i) q[i] = bf4_to_f4(*(const u32x2*)(PJ + (size_t)row * PJP + C_Q + 4 * (l32 + 32 * i)));
    const float* ck = P->in[I_CK] + ((size_t)l * 32 + b) * 2048 * 384 + 4 * l32;
    const float* cv = P->in[I_CV] + ((size_t)l * 32 + b) * 2048 * 384 + 4 * l32;
    const float* sk = P->out + OFF_SWK + ((size_t)l * 32 + b) * 2048 * 384 + 4 * l32;
    const float* sv = P->out + OFF_SWV + ((size_t)l * 32 + b) * 2048 * 384 + 4 * l32;
    float m[3], ls[3]; f32x4 o[3];
#pragma unroll
    for (int i = 0; i < 3; ++i) { m[i] = -1e30f; ls[i] = 0.f; o[i] = (f32x4){0.f, 0.f, 0.f, 0.f}; }
    const int slot = 2 * wave + half;
#pragma unroll 1
    for (int it0 = 0; it0 < 28; it0 += 4) {
        f32x4 kr[4][3], vr[4][3];
#pragma unroll
        for (int u = 0; u < 4; ++u) {
            const int kk = (it0 + u) * 16 + slot, kc = kk < 387 ? kk : 386;
            const int pat = kc >= 258 ? 2 : (kc >= 129 ? 1 : 0), j = kc - 129 * pat, idx = 2048 + t - (j << (2 * pat));
            const float* kp = idx < 2048 ? ck + (size_t)idx * 384 : sk + (size_t)(idx - 8) * 384;
            const float* vp = idx < 2048 ? cv + (size_t)idx * 384 : sv + (size_t)(idx - 8) * 384;
#pragma unroll
            for (int i = 0; i < 3; ++i) { kr[u][i] = *(const f32x4*)(kp + 128 * i); vr[u][i] = *(const f32x4*)(vp + 128 * i); }
        }
#pragma unroll
        for (int u = 0; u < 4; ++u) {
            const bool valid = (it0 + u) * 16 + slot < 387;
#pragma unroll
            for (int i = 0; i < 3; ++i) {
                float sc = (q[i][0] * kr[u][i][0] + q[i][1] * kr[u][i][1]) + (q[i][2] * kr[u][i][2] + q[i][3] * kr[u][i][3]);
                sc += __shfl_xor(sc, 1); sc += __shfl_xor(sc, 2); sc += __shfl_xor(sc, 4); sc += __shfl_xor(sc, 8);
                if (!valid) sc = -INFINITY;
                const float mn = fmaxf(m[i], sc), al = fexp2(m[i] - mn), p = fexp2(sc - mn);
                ls[i] = ls[i] * al + p; o[i] = o[i] * al + vr[u][i] * p; m[i] = mn;
            }
        }
    }
    LAS float* part = (LAS float*)lds;
#pragma unroll
    for (int i = 0; i < 3; ++i) {
        const float mo = __shfl_xor(m[i], 32), lo = __shfl_xor(ls[i], 32);
        f32x4 oo;
#pragma unroll
        for (int e = 0; e < 4; ++e) oo[e] = __shfl_xor(o[i][e], 32);
        const float M = fmaxf(m[i], mo), a0 = fexp2(m[i] - M), a1 = fexp2(mo - M);
        const float L = ls[i] * a0 + lo * a1; const f32x4 O = o[i] * a0 + oo * a1;
        if (half == 0) { LAS float* d = part + ((wave * 96) + l32 + 32 * i) * 6; d[0] = M; d[1] = L; d[2] = O[0]; d[3] = O[1]; d[4] = O[2]; d[5] = O[3]; }
    }
    __syncthreads();
    if (tid < 96) {
        float M = -1e30f;
#pragma unroll
        for (int w = 0; w < 8; ++w) M = fmaxf(M, part[(w * 96 + tid) * 6]);
        float L = 0.f; f32x4 O = (f32x4){0.f, 0.f, 0.f, 0.f};
#pragma unroll
        for (int w = 0; w < 8; ++w) { const LAS float* d = part + (w * 96 + tid) * 6; const float a = fexp2(d[0] - M); L += d[1] * a; O += (f32x4){d[2], d[3], d[4], d[5]} * a; }
        *(u32x2*)(MIX + (size_t)row * DM + 4 * tid) = f4_to_bf4(O * (1.0f / L));
    }
    __syncthreads();
}

__device__ __forceinline__ void phase3(KP P, int l, LAS unsigned char* lds) {
    const int tid = opaque_tid(), lane = tid & 63, wave = tid >> 6;
    const int gw = blockIdx.x * 8 + wave, NGW = gridDim.x * 8;
    for (int t = blockIdx.x; t < NCH * 3; t += gridDim.x) rglru_fix_task(P, l, t, lds);
    for (int t = blockIdx.x; t < NSMP; t += gridDim.x) sattn_block_task(P, l, t, lds);
    LAS unsigned char* vl = lds + 20480 + wave * (32 * VRP);
    { int tk = 0; for (int t = gw; t < 6144; t += NGW, ++tk) attn_tile(P, l, t, gw, NGW, tk, lane, vl); }
}

template <int K>
__device__ __forceinline__ void sample_proj(const bf16_t* A, const bf16_t* Bt, const float* base_s, float* X, bf16_t* XB, float* rss_out, LAS unsigned char* lds) {
    const int tid = opaque_tid(), lane = tid & 63, wave = tid >> 6, fr = lane & 15, fq = lane >> 4;
    const int rg = blockIdx.x >> 4, cg_ = blockIdx.x & 15;
    if (blockIdx.x >= 256) return;
    constexpr int KS = K / 8, NK = KS / 32;
    const bf16_t* ap = A + (size_t)(SEQ + 16 * rg + fr) * K + wave * KS + 8 * fq;
    const bf16_t* bp = Bt + (size_t)(64 * cg_ + fr) * K + wave * KS + 8 * fq;
    f32x4 acc[4];
#pragma unroll
    for (int ct = 0; ct < 4; ++ct) acc[ct] = (f32x4){0.f, 0.f, 0.f, 0.f};
#pragma unroll 1
    for (int k0 = 0; k0 < NK; k0 += 4) {
        bf16x8 af[4], bf[4][4];
#pragma unroll
        for (int u = 0; u < 4; ++u) { const int ks = (k0 + u) < NK ? (k0 + u) : (NK - 1); af[u] = *(const bf16x8*)(ap + 32 * ks);
#pragma unroll
            for (int ct = 0; ct < 4; ++ct) bf[u][ct] = *(const bf16x8*)(bp + (size_t)(16 * ct) * K + 32 * ks); }
#pragma unroll
        for (int u = 0; u < 4; ++u) if (k0 + u < NK) {
#pragma unroll
            for (int ct = 0; ct < 4; ++ct) acc[ct] = __builtin_amdgcn_mfma_f32_16x16x32_bf16(bf[u][ct], af[u], acc[ct], 0, 0, 0);
        }
    }
    LAS f32x4* red = (LAS f32x4*)lds;
#pragma unroll
    for (int ct = 0; ct < 4; ++ct) red[(wave * 4 + ct) * 64 + lane] = acc[ct];
    __syncthreads();
    if (wave < 4) {
        f32x4 sacc = (f32x4){0.f, 0.f, 0.f, 0.f};
#pragma unroll
        for (int w = 0; w < 8; ++w) sacc += red[(w * 4 + wave) * 64 + lane];
        const int row = 16 * rg + fr, col = 64 * cg_ + 16 * wave + 4 * fq;
        const f32x4 x = *(const f32x4*)(base_s + (size_t)row * DM + col) + sacc;
        *(f32x4*)(X + (size_t)(SEQ + row) * DM + col) = x;
        *(u32x2*)(XB + (size_t)(SEQ + row) * DM + col) = f4_to_bf4(x);
        float ss = (x[0] * x[0] + x[1] * x[1]) + (x[2] * x[2] + x[3] * x[3]);
        ss += __shfl_xor(ss, 16); ss += __shfl_xor(ss, 32);
        if (fq == 0) unsafeAtomicAdd(rss_out + SEQ + row, ss);
    }
    __syncthreads();
}

__device__ __forceinline__ void copy_cache(KP P, int l, int kv) {
    if (blockIdx.x < 4) return;
    const int tid = opaque_tid();
    const int gt = (blockIdx.x - 4) * 512 + tid, NGT = (gridDim.x - 4) * 512;
    constexpr int SEGV = 2040 * 384 / 4;
    const float* cin = P->in[kv ? I_CV : I_CK]; float* o = P->out + (kv ? OFF_SWV : OFF_SWK);
    for (int i0 = gt; i0 < 32 * SEGV; i0 += 8 * NGT) {
        f32x4 v[8];
#pragma unroll
        for (int u = 0; u < 8; ++u) {
            const int i = i0 + u * NGT;
            if (i < 32 * SEGV) { const int b = i / SEGV, off = i - b * SEGV; v[u] = __builtin_nontemporal_load((const f32x4*)(cin + (((size_t)l * 32 + b) * 2048 + 8) * 384) + off); }
        }
#pragma unroll
        for (int u = 0; u < 8; ++u) {
            const int i = i0 + u * NGT;
            if (i < 32 * SEGV) { const int b = i / SEGV, off = i - b * SEGV; __builtin_nontemporal_store(v[u], (f32x4*)(o + ((size_t)l * 32 + b) * 2048 * 384) + off); }
        }
    }
}

__device__ __forceinline__ void final_norm(KP P) {
    const int tid = opaque_tid(), lane = tid & 63, wave = tid >> 6;
    const int gw = blockIdx.x * 8 + wave, NGW = gridDim.x * 8;
    const float* X = (const float*)(P->ws + WS_X); const float* rss = (const float*)(P->ws + WS_RSS) + 4 * MT;
    for (int row = gw; row < MT; row += NGW) {
        const float rs = rsqrtf(rss[row] * (1.0f / DM) + EPS);
#pragma unroll
        for (int j = 0; j < 4; ++j) {
            const int c = 4 * lane + 256 * j;
            const f32x4 v = *(const f32x4*)(X + (size_t)row * DM + c) * rs * *(const f32x4*)(P->in[I_FING] + c);
            *(f32x4*)(P->out + (size_t)row * DM + c) = v;
        }
    }
}

#define XB_TMO      128
#define XB_XCNT(j)  (256  + 64 * (j))
#define XB_XSUB(j)  (1280 + 64 * (j))
#define XB_XGEN(j)  (2304 + 64 * (j))
#define XB_TOP      3328
#define XB_TOPGEN   3392
#define XCD_BAR_WORDS 3456
#define XB_SPIN_CAP (1u << 18)

__device__ __forceinline__ unsigned xb_ld(unsigned* p)              { return __hip_atomic_load(p, __ATOMIC_RELAXED, __HIP_MEMORY_SCOPE_AGENT); }
__device__ __forceinline__ unsigned xb_add(unsigned* p, unsigned v) { return __hip_atomic_fetch_add(p, v, __ATOMIC_RELAXED, __HIP_MEMORY_SCOPE_AGENT); }
__device__ __forceinline__ unsigned xb_xcc_id() { return (unsigned)__builtin_amdgcn_s_getreg((3 << 11) | 20) & 0xFu; }
#define XB_SPIN(cond, bar) do { unsigned _sp = 0; while (cond) { __builtin_amdgcn_s_sleep(1); \
    if ((++_sp & 255u) == 0u) { if (xb_ld(&(bar)[XB_TMO])) break; if (_sp > XB_SPIN_CAP) { atomicAdd(&(bar)[XB_TMO], 1u); break; } } } } while (0)

struct XcdBarrier {
    unsigned* bar; unsigned x;
    volatile LAS unsigned* st;
};

__device__ __forceinline__ XcdBarrier xcd_barrier_post(unsigned* bar, volatile LAS unsigned* st) {
    XcdBarrier b; b.bar = bar; b.x = (unsigned)__builtin_amdgcn_readfirstlane((int)xb_xcc_id()); b.st = st;
    if (threadIdx.x == 0) (void)xb_add(&bar[XB_XCNT(b.x)], 1u);
    return b;
}
__device__ __forceinline__ void xcd_barrier_complete(unsigned* bar, unsigned x, unsigned& nloc, unsigned& nx) {
    const unsigned G = gridDim.x * gridDim.y * gridDim.z;
    unsigned sum, cnt, mine, sp = 0u;
    for (;;) {
        sum = 0u; cnt = 0u; mine = 0u;
#pragma unroll
        for (unsigned j = 0; j < 16; ++j) { const unsigned c = xb_ld(&bar[XB_XCNT(j)]); sum += c; cnt += (c > 0u) ? 1u : 0u; mine = (j == x) ? c : mine; }
        if (sum == G) break;
        __builtin_amdgcn_s_sleep(1);
        if ((++sp & 255u) == 0u) { if (xb_ld(&bar[XB_TMO])) break; if (sp > XB_SPIN_CAP) { atomicAdd(&bar[XB_TMO], 1u); break; } }
    }
    nloc = mine > 0u ? mine : 1u; nx = cnt > 0u ? cnt : 1u;
}

__device__ __forceinline__ void xcd_barrier(const XcdBarrier& b) {
    unsigned bx_ = b.x; asm volatile("" : "+s"(bx_));
    asm volatile("s_waitcnt vmcnt(0)" ::: "memory");
    __syncthreads();
    if (threadIdx.x == 0) {
        unsigned* bar = b.bar; asm volatile("" : "+s"(bar));
        __builtin_amdgcn_s_waitcnt(0);
        unsigned nloc = b.st[0], nx = b.st[1];
        if (nloc == 0u) { xcd_barrier_complete(bar, bx_, nloc, nx); b.st[0] = nloc; b.st[1] = nx; }
        const unsigned old = xb_add(&bar[XB_XSUB(bx_)], 1u);
        const unsigned gen = old / nloc;
        if (old + 1u == (gen + 1u) * nloc) {
            __builtin_amdgcn_fence(__ATOMIC_RELEASE, "agent");
            asm volatile("s_waitcnt vmcnt(0)" ::: "memory");
            const unsigned og = xb_add(&bar[XB_TOP], 1u);
            const unsigned tg = og / nx;
            if (og + 1u == (tg + 1u) * nx) xb_add(&bar[XB_TOPGEN], 1u);
            else XB_SPIN(xb_ld(&bar[XB_TOPGEN]) == tg, bar);
            __builtin_amdgcn_fence(__ATOMIC_ACQUIRE, "agent");
            xb_add(&bar[XB_XGEN(bx_)], 1u);
            asm volatile("s_waitcnt vmcnt(0)" ::: "memory");
        } else {
            XB_SPIN(xb_ld(&bar[XB_XGEN(bx_)]) == gen, bar);
            __builtin_amdgcn_fence(__ATOMIC_ACQUIRE, "agent");
            asm volatile("s_waitcnt vmcnt(0)" ::: "memory");
        }
    }
    __syncthreads();
}

__global__ void __launch_bounds__(512) mega_fwd(Params Pval) {
    extern __shared__ __attribute__((aligned(16))) unsigned char lds_raw[];
    LAS unsigned char* lds = (LAS unsigned char*)lds_raw;
    cg::grid_group grid = cg::this_grid();
    if (Pval.ws == nullptr) grid.sync();
    volatile LAS unsigned* bst = (volatile LAS unsigned*)(lds + pg8::STAGE_BYTES);
    if (threadIdx.x < 2) bst[threadIdx.x] = 0u;
    __syncthreads();
    XcdBarrier bar = xcd_barrier_post((unsigned*)(Pval.ws + WS_BAR), bst);
    prologue(kargs(), lds);
    xcd_barrier(bar);
#pragma unroll 1
    for (int l = 0; l < 2; ++l) {
        {
            KP P = kargs(); unsigned char* ws = P->ws; float* rss = (float*)(ws + WS_RSS);
            pg8::Gemm g{(const bf16_t*)(ws + WS_XB), (const bf16_t*)(ws + WS_WIN) + (size_t)l * DINP * DM, MT, DINP, DM}; pg8::StaticOrder S; S.init(MT, DINP, gridDim.x, blockIdx.x);
            EpiInProj E{(bf16_t*)(ws + WS_PJ), rss + (size_t)(2 * l) * MT, (const float*)(ws + WS_ROPE)};
            pg8::gemm_phase<EpiInProj, pg8::StaticOrder, true, true>(lds, g, S, E);
        }
        xcd_barrier(bar);
        phase2(kargs(), l, lds);
        xcd_barrier(bar);
        phase3(kargs(), l, lds);
        xcd_barrier(bar);
        {
            KP P = kargs(); unsigned char* ws = P->ws; float* rss = (float*)(ws + WS_RSS); float* X = (float*)(ws + WS_X);
            pg8::Gemm g{(const bf16_t*)(ws + WS_MIX), (const bf16_t*)(ws + WS_WOUT) + (size_t)l * DM * DM, SEQ, DM, DM}; pg8::StaticOrder S; S.init(SEQ, DM, gridDim.x, blockIdx.x);
            EpiResid E{l == 0 ? P->in[I_XP] : X, l == 0 ? P->in[I_XS] : X + (size_t)SEQ * DM, X, (bf16_t*)(ws + WS_XB), rss + (size_t)(2 * l + 1) * MT};
            pg8::gemm_phase<EpiResid, pg8::StaticOrder, true, true>(lds, g, S, E);
            sample_proj<DM>((const bf16_t*)(ws + WS_MIX), (const bf16_t*)(ws + WS_WOUT) + (size_t)l * DM * DM, l == 0 ? P->in[I_XS] : X + (size_t)SEQ * DM, X, (bf16_t*)(ws + WS_XB), rss + (size_t)(2 * l + 1) * MT, lds);
        }
        xcd_barrier(bar);
        {
            KP P = kargs(); unsigned char* ws = P->ws; float* rss = (float*)(ws + WS_RSS);
            pg8::Gemm g{(const bf16_t*)(ws + WS_XB), (const bf16_t*)(ws + WS_WGU) + (size_t)l * NGU * DM, MT, NGU, DM}; pg8::StaticOrder S; S.init(MT, NGU, gridDim.x, blockIdx.x);
            EpiGateUp E{(bf16_t*)(ws + WS_HB), rss + (size_t)(2 * l + 1) * MT};
            pg8::gemm_phase<EpiGateUp, pg8::StaticOrder, true, true>(lds, g, S, E);
        }
        xcd_barrier(bar);
        {
            KP P = kargs(); unsigned char* ws = P->ws; float* rss = (float*)(ws + WS_RSS); float* X = (float*)(ws + WS_X);
            pg8::Gemm g{(const bf16_t*)(ws + WS_HB), (const bf16_t*)(ws + WS_WDN) + (size_t)l * DM * DFF, SEQ, DM, DFF}; pg8::StaticOrder S; S.init(SEQ, DM, gridDim.x, blockIdx.x);
            EpiResid E{X, X + (size_t)SEQ * DM, X, (bf16_t*)(ws + WS_XB), rss + (size_t)(2 * l + 2) * MT};
            pg8::gemm_phase<EpiResid, pg8::StaticOrder, true, true>(lds, g, S, E);
            sample_proj<DFF>((const bf16_t*)(ws + WS_HB), (const bf16_t*)(ws + WS_WDN) + (size_t)l * DM * DFF, X + (size_t)SEQ * DM, X, (bf16_t*)(ws + WS_XB), rss + (size_t)(2 * l + 2) * MT, lds);
        }
        xcd_barrier(bar);
    }
    final_norm(kargs());
}

constexpr int LDS_BYTES = pg8::STAGE_BYTES + 256;

extern "C" void kernel_launch(void* const* d_in, const int* in_sizes, int n_in, void* d_out, int out_size, void* d_ws, size_t ws_size, hipStream_t stream) {
    static int grid = 0;
    if (grid == 0) {
        if (n_in != 23 || (size_t)out_size != OUT_TOTAL || ws_size < WS_END) { fprintf(stderr, "kernel_launch: unexpected shapes (n_in %d out %d ws %zu need %zu)\n", n_in, out_size, ws_size, (size_t)WS_END); grid = -1; return; }
        int dev = 0, cus = 0, per_cu = 0;
        hipGetDevice(&dev); hipDeviceGetAttribute(&cus, hipDeviceAttributeMultiprocessorCount, dev);
        hipFuncSetAttribute((const void*)mega_fwd, hipFuncAttributeMaxDynamicSharedMemorySize, LDS_BYTES);
        hipOccupancyMaxActiveBlocksPerMultiprocessor(&per_cu, (const void*)mega_fwd, 512, LDS_BYTES);
        if (per_cu < 1) { fprintf(stderr, "kernel_launch: occupancy query says %d blocks/CU\n", per_cu); per_cu = 1; }
        grid = 256;
        (void)hipGetLastError();
    }
    if (grid < 0) return;
    if (hipMemsetAsync((unsigned char*)d_ws + WS_BAR, 0, 16384, stream) != hipSuccess) { fprintf(stderr, "kernel_launch: memset of the barrier words failed\n"); return; }
    Params p{};
    for (int i = 0; i < 23; ++i) p.in[i] = (const float*)d_in[i];
    p.out = (float*)d_out; p.ws = (unsigned char*)d_ws;
    void* args[] = {&p};
    hipError_t e = hipLaunchCooperativeKernel((const void*)mega_fwd, dim3(grid), dim3(512), args, LDS_BYTES, stream);
    if (e != hipSuccess) fprintf(stderr, "cooperative launch failed: %s (grid %d)\n", hipGetErrorString(e), grid);
}
```

```cpp
#include <hip/hip_runtime.h>
#include <hip/hip_cooperative_groups.h>
#include <cstdio>
#include <cstdint>
namespace cg = cooperative_groups;
namespace pg8 {
#define PG8_LAS __attribute__((address_space(3)))
typedef unsigned short bf16_t;
typedef short bf16x8 __attribute__((ext_vector_type(8)));
typedef float f32x4 __attribute__((ext_vector_type(4)));
typedef unsigned u32x4 __attribute__((ext_vector_type(4)));
constexpr int BM = 256, BK = 64, HALF = 128, HTB = HALF * BK * 2  , STAGE_BYTES = 8 * HTB, NXCD = 8, WGM = 8;

__host__ __device__ __forceinline__ int lds_byte(int r, int c) { const int st = (r >> 4) * 2 + (c >> 5), rr = r & 15, cc = c & 31, ob = rr * 64 + cc * 2; return st * 1024 + (ob ^ (((ob >> 9) & 1) << 5)); }
__host__ __device__ __forceinline__ void stage_rc(int b, int& R, int& C) { const int st = b / 1024, sb = b % 1024, swz = sb ^ (((sb >> 9) & 1) << 5); R = (st >> 1) * 16 + swz / 64; C = (st & 1) * 32 + (swz % 64) / 2; }
__host__ __device__ __forceinline__ int perm32(int rho) { const int n = rho >> 4, i = rho & 15; return 8 * (i >> 2) + 4 * n + (i & 3); }

struct Unit { int pm, pn; };
struct Gemm { const bf16_t* A; const bf16_t* Bt; int M, N, K; };

struct StaticOrder {
    int nM, nN, nwg, G, c;
    __host__ __device__ void init(int M, int N, int G_, int c_) { nM = M / BM; nN = N / BM; nwg = nM * nN; G = G_; c = c_; }
    __host__ __device__ bool next(int i, Unit& u) const {
        const long L = (long)i * G + c; if (L >= nwg) return false;
        int wgid = (int)L; { const int q = nwg / NXCD, r = nwg % NXCD, xcd = wgid % NXCD, off = wgid / NXCD; wgid = (xcd < r ? xcd * (q + 1) : r * (q + 1) + (xcd - r) * q) + off; }
        const int nig = WGM * nN, gid = wgid / nig, fm = gid * WGM, gsz = (nM - fm) < WGM ? (nM - fm) : WGM;
        u.pm = fm + ((wgid % nig) % gsz); u.pn = (wgid % nig) / gsz; return true;
    }
    __device__ __forceinline__ void a_ready(const Unit&) const {}
    __device__ __forceinline__ void done(const Unit&) const {}
};

__device__ __forceinline__ unsigned cvt_pk_bf16(float lo, float hi) { unsigned r; asm volatile("v_cvt_pk_bf16_f32 %0, %1, %2" : "=v"(r) : "v"(lo), "v"(hi)); return r; }
template <class Epi, class Sched, bool ALIGN_EPI = false, bool SP2 = false>
__device__ __forceinline__ void gemm_phase(PG8_LAS unsigned char* lds, const Gemm g, const Sched& S, const Epi& E) {
    int tid_ = threadIdx.x; asm volatile("" : "+v"(tid_));
    const int tid = tid_, wid = __builtin_amdgcn_readfirstlane(tid >> 6), lane = tid & 63, wr = wid >> 2, wc = wid & 3, fr = lane & 15, fq = lane >> 4;
    const int K = g.K, nt = K / BK;
    unsigned voffA[2], voffB[2];
#pragma unroll
    for (int i = 0; i < 2; ++i) { int R, C; stage_rc(tid * 16 + i * 8192, R, C); const int Rb = Epi::PERM ? ((R & ~31) + perm32(R & 31)) : R;
        voffA[i] = (unsigned)(R * K + C) * 2u; voffB[i] = (unsigned)(Rb * K + C) * 2u; }
    const size_t kstep = (size_t)(BK * 2);
    const size_t hstep = (size_t)HALF * K * 2;
    const size_t tstep = 2 * hstep;
    const unsigned ldsw = (unsigned)wid * 1024u;
    const int aoff = lds_byte(wr * 64 + fr, fq * 8), boff = lds_byte(wc * 32 + fr, fq * 8);
#define PG8_SA(b, h) (((b) * 2 + (h)) * HTB)
#define PG8_SB(b, h) ((4 + (b) * 2 + (h)) * HTB)
#define PG8_STAGE(bufoff, gbase, voff) do { _Pragma("unroll") for (int _i = 0; _i < 2; ++_i) \
        __builtin_amdgcn_global_load_lds((const unsigned*)((const char*)(gbase) + (voff)[_i]), (PG8_LAS unsigned*)(lds + (bufoff) + ldsw + _i * 8192), 16, 0, 0); } while (0)
#define PG8_LDA(dst, b, h) do { _Pragma("unroll") for (int m = 0; m < 4; ++m) _Pragma("unroll") for (int k = 0; k < 2; ++k) dst[m][k] = *(const PG8_LAS bf16x8*)(lds + PG8_SA(b, h) + aoff + m * 2048 + k * 1024); } while (0)
#define PG8_LDB(dst, b, h) do { _Pragma("unroll") for (int n = 0; n < 2; ++n) _Pragma("unroll") for (int k = 0; k < 2; ++k) dst[n][k] = *(const PG8_LAS bf16x8*)(lds + PG8_SB(b, h) + boff + n * 2048 + k * 1024); } while (0)
#define PG8_MMA(ai, bj, At, Bt) do { __builtin_amdgcn_s_setprio(1); _Pragma("unroll") for (int m = 0; m < 4; ++m) _Pragma("unroll") for (int n = 0; n < 2; ++n) _Pragma("unroll") for (int k = 0; k < 2; ++k) \
        acc[ai][bj][m][n] = __builtin_amdgcn_mfma_f32_16x16x32_bf16(Bt[n][k], At[m][k], acc[ai][bj][m][n], 0, 0, 0); __builtin_amdgcn_s_setprio(0); } while (0)
#define PG8_WAIT_V(n) asm volatile("s_waitcnt vmcnt(" #n ")" ::: "memory")
#define PG8_WAIT_L(n) asm volatile("s_waitcnt lgkmcnt(" #n ")" ::: "memory")
#define PG8_BAR __builtin_amdgcn_s_barrier()
#define PG8_SCHED __builtin_amdgcn_sched_barrier(0)
    Unit cur, nxt; int ui = 0;
    if (!S.next(0, cur)) return;
    f32x4 acc[2][2][4][2];
#pragma unroll
    for (int a = 0; a < 2; ++a)
#pragma unroll
        for (int b = 0; b < 2; ++b)
#pragma unroll
            for (int m = 0; m < 4; ++m)
#pragma unroll
                for (int n = 0; n < 2; ++n) acc[a][b][m][n] = (f32x4){0.f, 0.f, 0.f, 0.f};
    bf16x8 At[4][2], B0[2][2], B1[2][2];
    const char* cA = (const char*)g.A + (size_t)cur.pm * tstep; const char* cB = (const char*)g.Bt + (size_t)cur.pn * tstep;
    S.a_ready(cur);
    if constexpr (SP2) {
        PG8_STAGE(PG8_SB(0, 0), cB, voffB); PG8_STAGE(PG8_SB(0, 1), cB + hstep, voffB); PG8_STAGE(PG8_SA(0, 0), cA, voffA); PG8_STAGE(PG8_SA(0, 1), cA + hstep, voffA);
        if (wr == 1) PG8_BAR;
        PG8_WAIT_V(2); PG8_BAR;
        PG8_STAGE(PG8_SB(1, 0), cB + kstep, voffB); PG8_STAGE(PG8_SA(1, 0), cA + kstep, voffA); PG8_STAGE(PG8_SB(1, 1), cB + hstep + kstep, voffB);
        PG8_WAIT_V(6); PG8_BAR;
    } else {
        PG8_STAGE(PG8_SB(0, 0), cB, voffB); PG8_STAGE(PG8_SA(0, 0), cA, voffA); PG8_STAGE(PG8_SB(0, 1), cB + hstep, voffB); PG8_STAGE(PG8_SA(0, 1), cA + hstep, voffA);
        if (wr == 1) PG8_BAR;
        PG8_WAIT_V(4); PG8_BAR;
        PG8_STAGE(PG8_SB(1, 0), cB + kstep, voffB); PG8_STAGE(PG8_SA(1, 0), cA + kstep, voffA); PG8_STAGE(PG8_SB(1, 1), cB + hstep + kstep, voffB);
        PG8_WAIT_V(6); PG8_BAR;
    }
    for (;;) {
        const bool has_next = S.next(ui + 1, nxt);
        const char* nA = has_next ? (const char*)g.A + (size_t)nxt.pm * tstep : cA; const char* nB = has_next ? (const char*)g.Bt + (size_t)nxt.pn * tstep : cB;
        for (int t = 0; t < nt; t += 2) {
            const bool last = (t == nt - 2);
            const char* a1 = cA + (size_t)(t + 1) * kstep;
            const char* a2 = last ? nA : cA + (size_t)(t + 2) * kstep; const char* b2 = last ? nB : cB + (size_t)(t + 2) * kstep;
            const char* a3 = a2 + kstep; const char* b3 = b2 + kstep;
            if (last && has_next) S.a_ready(nxt);
            if constexpr (SP2) {
            PG8_LDB(B0, 0, 0); PG8_LDB(B1, 0, 1); PG8_SCHED; PG8_LDA(At, 0, 0); PG8_STAGE(PG8_SA(1, 1), a1 + hstep, voffA);
            PG8_WAIT_V(8); PG8_WAIT_L(0); PG8_BAR; PG8_MMA(0, 0, At, B0); PG8_MMA(0, 1, At, B1); PG8_BAR; PG8_SCHED;
            PG8_LDA(At, 0, 1); PG8_STAGE(PG8_SB(0, 0), b2, voffB); PG8_STAGE(PG8_SB(0, 1), b2 + hstep, voffB); PG8_STAGE(PG8_SA(0, 0), a2, voffA);
            PG8_WAIT_V(8); PG8_WAIT_L(0); PG8_BAR; PG8_MMA(1, 0, At, B0); PG8_MMA(1, 1, At, B1); PG8_BAR; PG8_SCHED;
            PG8_LDB(B0, 1, 0); PG8_LDB(B1, 1, 1); PG8_SCHED; PG8_LDA(At, 1, 0); PG8_STAGE(PG8_SA(0, 1), a2 + hstep, voffA);
            PG8_WAIT_V(8); PG8_WAIT_L(0); PG8_BAR; PG8_MMA(0, 0, At, B0); PG8_MMA(0, 1, At, B1); PG8_BAR; PG8_SCHED;
            PG8_LDA(At, 1, 1); PG8_STAGE(PG8_SB(1, 0), b3, voffB); PG8_STAGE(PG8_SB(1, 1), b3 + hstep, voffB); PG8_STAGE(PG8_SA(1, 0), a3, voffA);
            PG8_WAIT_V(8); PG8_WAIT_L(0); PG8_BAR; PG8_MMA(1, 0, At, B0); PG8_MMA(1, 1, At, B1); PG8_BAR; PG8_SCHED;
            } else {
            PG8_LDB(B0, 0, 0); PG8_SCHED; PG8_LDA(At, 0, 0); PG8_STAGE(PG8_SA(1, 1), a1 + hstep, voffA);
            PG8_WAIT_L(8); PG8_BAR; PG8_WAIT_L(0); PG8_MMA(0, 0, At, B0); PG8_BAR; PG8_SCHED;
            PG8_LDB(B1, 0, 1); PG8_STAGE(PG8_SB(0, 0), b2, voffB);
            PG8_BAR; PG8_WAIT_L(0); PG8_MMA(0, 1, At, B1); PG8_BAR;
            PG8_LDA(At, 0, 1); PG8_STAGE(PG8_SA(0, 0), a2, voffA);
            PG8_BAR; PG8_WAIT_L(0); PG8_MMA(1, 0, At, B0); PG8_BAR; PG8_SCHED;
            PG8_STAGE(PG8_SB(0, 1), b2 + hstep, voffB);
            PG8_WAIT_V(6); PG8_BAR; PG8_MMA(1, 1, At, B1); PG8_BAR;
            PG8_LDB(B0, 1, 0); PG8_SCHED; PG8_LDA(At, 1, 0); PG8_STAGE(PG8_SA(0, 1), a2 + hstep, voffA);
            PG8_WAIT_L(8); PG8_BAR; PG8_WAIT_L(0); PG8_MMA(0, 0, At, B0); PG8_BAR; PG8_SCHED;
            PG8_LDB(B1, 1, 1); PG8_STAGE(PG8_SB(1, 0), b3, voffB);
            PG8_BAR; PG8_WAIT_L(0); PG8_MMA(0, 1, At, B1); PG8_BAR;
            PG8_LDA(At, 1, 1); PG8_STAGE(PG8_SA(1, 0), a3, voffA);
            PG8_BAR; PG8_WAIT_L(0); PG8_MMA(1, 0, At, B0); PG8_BAR; PG8_SCHED;
            PG8_STAGE(PG8_SB(1, 1), b3 + hstep, voffB);
            PG8_WAIT_V(6); PG8_BAR; PG8_MMA(1, 1, At, B1); PG8_BAR;
            }
        }
        if constexpr (ALIGN_EPI) { if (wr == 0) PG8_BAR; }
        if constexpr (!Epi::AFTER_DRAIN) { E(acc, cur, wr, wc, fr, fq); S.done(cur); }
        if (!has_next) break;
#pragma unroll
        for (int a = 0; a < 2; ++a)
#pragma unroll
            for (int b = 0; b < 2; ++b)
#pragma unroll
                for (int m = 0; m < 4; ++m)
#pragma unroll
                    for (int n = 0; n < 2; ++n) acc[a][b][m][n] = (f32x4){0.f, 0.f, 0.f, 0.f};
        cur = nxt; cA = nA; cB = nB; ++ui;
        if constexpr (ALIGN_EPI) { if (wr == 1) PG8_BAR; }
    }
    PG8_WAIT_V(0);
    if constexpr (!ALIGN_EPI) { if (wr == 0) PG8_BAR; }
    PG8_BAR;
    if constexpr (Epi::AFTER_DRAIN) { E.fused(acc, cur, wr, wc, fr, fq, lds, wid, lane); S.done(cur); }
#undef PG8_SA
#undef PG8_SB
#undef PG8_STAGE
#undef PG8_LDA
#undef PG8_LDB
#undef PG8_MMA
#undef PG8_WAIT_V
#undef PG8_WAIT_L
#undef PG8_BAR
#undef PG8_SCHED
}
}

using pg8::bf16_t; using pg8::bf16x8; using pg8::f32x4; using pg8::u32x4;
#define LAS __attribute__((address_space(3)))
typedef short s16x4 __attribute__((ext_vector_type(4)));
typedef unsigned u32x2 __attribute__((ext_vector_type(2)));
typedef float f32x2 __attribute__((ext_vector_type(2)));

constexpr int DM = 1024, SEQ = 16384, NSMP = 256, MT = SEQ + NSMP;
constexpr int DIN = 2176, DINP = 2304, DFF = 2816, NGU = 2 * DFF;
constexpr int C_Q = 0, C_K = 384, C_V = 768, C_U = 1152, C_XR = 1408, C_GT = 1792, PJP = 2176;
constexpr int NCH = MT / 64;
constexpr float EPS = 1e-6f;
constexpr float QSCALE = 0.125f * 1.4426950408889634f;

constexpr size_t OFF_YP = 0, OFF_YS = OFF_YP + (size_t)SEQ * DM, OFF_PWK = OFF_YS + (size_t)NSMP * DM, OFF_PWV = OFF_PWK + 2ull * 2048 * 384,
                 OFF_PPOOL = OFF_PWV + 2ull * 2048 * 384, OFF_PCONV = OFF_PPOOL + 2 * 15 * 256, OFF_PRG = OFF_PCONV + 2 * 3 * 384, OFF_SWK = OFF_PRG + 2 * 384,
                 OFF_SWV = OFF_SWK + 2ull * 32 * 2048 * 384, OFF_SPOOL = OFF_SWV + 2ull * 32 * 2048 * 384, OFF_SCONV = OFF_SPOOL + 2 * 32 * 15 * 256,
                 OFF_SRG = OFF_SCONV + 2 * 32 * 3 * 384, OUT_TOTAL = OFF_SRG + 2 * 32 * 384;

constexpr size_t al256(size_t x) { return (x + 255) & ~(size_t)255; }
constexpr size_t WS_WIN = 0;
constexpr size_t WS_WOUT = WS_WIN + al256(2ull * DINP * DM * 2);
constexpr size_t WS_WGU = WS_WOUT + al256(2ull * DM * DM * 2);
constexpr size_t WS_WDN = WS_WGU + al256(2ull * NGU * DM * 2);
constexpr size_t WS_WA = WS_WDN + al256(2ull * DM * DFF * 2);
constexpr size_t WS_WX = WS_WA + al256(2ull * 6 * 64 * 64 * 2);
constexpr size_t WS_WP = WS_WX + al256(2ull * 6 * 64 * 64 * 2);
constexpr size_t WS_ROPE = WS_WP + al256(2ull * 4 * 64 * 64 * 2);
constexpr size_t WS_RSS = WS_ROPE + al256(16392ull * 32 * 8);
constexpr size_t WS_XB = WS_RSS + al256(5ull * MT * 4);
constexpr size_t WS_PJ = WS_XB + al256((size_t)MT * DM * 2);
constexpr size_t WS_HL = WS_PJ + al256((size_t)MT * PJP * 2);
constexpr size_t WS_PC = WS_HL + al256((size_t)MT * 384 * 4);
constexpr size_t WS_CA = WS_PC + al256((size_t)MT * 384 * 4);
constexpr size_t WS_CH = WS_CA + al256((size_t)NCH * 384 * 4);
constexpr size_t WS_MIX = WS_CH + al256((size_t)NCH * 384 * 4);
constexpr size_t WS_X = WS_MIX + al256((size_t)MT * DM * 2);
constexpr size_t WS_HB = WS_X + al256((size_t)MT * DM * 4);
constexpr size_t WS_BAR = WS_HB + al256((size_t)MT * DFF * 2);
constexpr size_t WS_END = WS_BAR + 16384;

struct Params { const float* in[23]; float* out; unsigned char* ws; };
typedef const __attribute__((address_space(4))) Params* KP;
__device__ __forceinline__ KP kargs() { auto p = __builtin_amdgcn_kernarg_segment_ptr(); asm volatile("" : "+s"(p)); return (KP)p; }
enum { I_XP = 0, I_XS, I_CK, I_CV, I_SPOOL, I_SCONV, I_SRG, I_N1G, I_WIN, I_POOLW, I_POOLS, I_CONVW, I_CONVB, I_GAW, I_GAB, I_GXW, I_GXB, I_LAM, I_WOUT, I_N2G, I_WGU, I_WDN, I_FING };

__device__ __forceinline__ int opaque_tid() { int t = threadIdx.x; asm volatile("" : "+v"(t)); return t; }
__device__ __forceinline__ unsigned pk2(float lo, float hi) { return pg8::cvt_pk_bf16(lo, hi); }
__device__ __forceinline__ float bf_lo(unsigned w) { return __uint_as_float(w << 16); }
__device__ __forceinline__ float bf_hi(unsigned w) { return __uint_as_float(w & 0xffff0000u); }
__device__ __forceinline__ f32x4 bf4_to_f4(u32x2 w) { return (f32x4){bf_lo(w.x), bf_hi(w.x), bf_lo(w.y), bf_hi(w.y)}; }
__device__ __forceinline__ u32x2 f4_to_bf4(f32x4 v) { u32x2 w; w.x = pk2(v[0], v[1]); w.y = pk2(v[2], v[3]); return w; }
__device__ __forceinline__ float wave_sum(float v) {
#pragma unroll
    for (int o = 1; o < 64; o <<= 1) v += __shfl_xor(v, o);
    return v;
}
__device__ __forceinline__ float fexp2(float x) { return __builtin_amdgcn_exp2f(x); }
__device__ __forceinline__ float fsigmoid(float x) { return __builtin_amdgcn_rcpf(1.0f + fexp2(-1.4426950408889634f * x)); }
template <int N> __device__ __forceinline__ float dpp_row_shr_c(float v) { return __int_as_float(__builtin_amdgcn_update_dpp(0, __float_as_int(v), 0x110 + N, 0xf, 0xf, false)); }
__device__ __forceinline__ float dpp_row_shr(float v, int n) { return n == 1 ? dpp_row_shr_c<1>(v) : n == 2 ? dpp_row_shr_c<2>(v) : n == 4 ? dpp_row_shr_c<4>(v) : dpp_row_shr_c<8>(v); }
__device__ __forceinline__ float sigmoidf_(float x) { return 1.0f / (1.0f + __expf(-x)); }
__device__ __forceinline__ float gelu_tanh(float x) { const float z = 0.7978845608028654f * (x + 0.044715f * x * x * x); const float e = __expf(2.0f * z); return 0.5f * x * (2.0f - 2.0f / (e + 1.0f)); }

struct EpiInProj {
    static constexpr bool PERM = true, AFTER_DRAIN = false;
    bf16_t* PJ; const float* rss; const float* rope;
    __device__ __forceinline__ void operator()(const f32x4 (&acc)[2][2][4][2], const pg8::Unit& u, int wr, int wc, int fr_, int fq_) const {
        int fr = fr_, fq = fq_; asm volatile("" : "+v"(fr), "+v"(fq));
#pragma unroll
        for (int bj = 0; bj < 2; ++bj) {
            const int cb = u.pn * 256 + bj * 128;
            if (cb >= DIN) continue;
            const int c0 = cb + wc * 32 + fq * 8;
            if (cb < C_V) {
                const bool isk = cb >= C_K; const int sb = isk ? C_K : 0; const int o = c0 - sb; const int hb = o & ~63; const int j0 = (o & 63) >> 1;
                const float qs = isk ? 1.0f : QSCALE;
#pragma unroll
                for (int ai = 0; ai < 2; ++ai)
#pragma unroll
                    for (int m = 0; m < 4; ++m) {
                        const int row = u.pm * 256 + ai * 128 + wr * 64 + m * 16 + fr;
                        const int pos = row < SEQ ? row : SEQ + ((row - SEQ) & 7);
                        const f32x4 t0 = *(const f32x4*)(rope + ((size_t)pos * 32 + j0) * 2), t1 = *(const f32x4*)(rope + ((size_t)pos * 32 + j0) * 2 + 4);
                        const float rsv = rsqrtf(rss[row] * (1.0f / DM) + EPS) * qs;
                        const f32x4 v0 = acc[ai][bj][m][0] * rsv, v1 = acc[ai][bj][m][1] * rsv;
                        f32x4 o1, o2;
                        o1[0] = v0[0] * t0[0] - v0[1] * t0[1]; o2[0] = v0[1] * t0[0] + v0[0] * t0[1];
                        o1[1] = v0[2] * t0[2] - v0[3] * t0[3]; o2[1] = v0[3] * t0[2] + v0[2] * t0[3];
                        o1[2] = v1[0] * t1[0] - v1[1] * t1[1]; o2[2] = v1[1] * t1[0] + v1[0] * t1[1];
                        o1[3] = v1[2] * t1[2] - v1[3] * t1[3]; o2[3] = v1[3] * t1[2] + v1[2] * t1[3];
                        bf16_t* pj = PJ + (size_t)row * PJP + sb + hb + j0;
                        *(u32x2*)pj = f4_to_bf4(o1); *(u32x2*)(pj + 32) = f4_to_bf4(o2);
                    }
            } else {
#pragma unroll
                for (int ai = 0; ai < 2; ++ai)
#pragma unroll
                    for (int m = 0; m < 4; ++m) {
                        const int row = u.pm * 256 + ai * 128 + wr * 64 + m * 16 + fr;
                        const float rsv = rsqrtf(rss[row] * (1.0f / DM) + EPS);
                        const f32x4 v0 = acc[ai][bj][m][0] * rsv, v1 = acc[ai][bj][m][1] * rsv;
                        u32x4 w; w.x = pk2(v0[0], v0[1]); w.y = pk2(v0[2], v0[3]); w.z = pk2(v1[0], v1[1]); w.w = pk2(v1[2], v1[3]);
                        *(u32x4*)(PJ + (size_t)row * PJP + c0) = w;
                    }
            }
        }
    }
};

struct EpiResid {
    static constexpr bool PERM = false, AFTER_DRAIN = false;
    const float* base_p; const float* base_s; float* X; bf16_t* XB; float* rss_out;
    __device__ __forceinline__ void operator()(const f32x4 (&acc)[2][2][4][2], const pg8::Unit& u, int wr, int wc, int fr, int fq) const {
#pragma unroll
        for (int ai = 0; ai < 2; ++ai)
#pragma unroll
            for (int m = 0; m < 4; ++m) {
                const int row = u.pm * 256 + ai * 128 + wr * 64 + m * 16 + fr;
                const float* b = row < SEQ ? base_p + (size_t)row * DM : base_s + (size_t)(row - SEQ) * DM;
                float ss = 0.f;
#pragma unroll
                for (int bj = 0; bj < 2; ++bj)
#pragma unroll
                    for (int n = 0; n < 2; ++n) {
                        const int col = u.pn * 256 + bj * 128 + wc * 32 + n * 16 + fq * 4;
                        const f32x4 x = *(const f32x4*)(b + col) + acc[ai][bj][m][n];
                        *(f32x4*)(X + (size_t)row * DM + col) = x;
                        *(u32x2*)(XB + (size_t)row * DM + col) = f4_to_bf4(x);
                        ss += (x[0] * x[0] + x[1] * x[1]) + (x[2] * x[2] + x[3] * x[3]);
                    }
                ss += __shfl_xor(ss, 16); ss += __shfl_xor(ss, 32);
                if (fq == 0) unsafeAtomicAdd(rss_out + row, ss);
            }
    }
};

struct EpiGateUp {
    static constexpr bool PERM = true, AFTER_DRAIN = false;
    bf16_t* HB; const float* rss;
    __device__ __forceinline__ void operator()(const f32x4 (&acc)[2][2][4][2], const pg8::Unit& u, int wr, int wc, int fr, int fq) const {
#pragma unroll
        for (int ai = 0; ai < 2; ++ai)
#pragma unroll
            for (int m = 0; m < 4; ++m) {
                const int row = u.pm * 256 + ai * 128 + wr * 64 + m * 16 + fr;
                const float rs = rsqrtf(rss[row] * (1.0f / DM) + EPS);
#pragma unroll
                for (int bj = 0; bj < 2; ++bj) {
                    const int hc = u.pn * 128 + bj * 64 + wc * 16 + fq * 4;
                    const f32x4 g = acc[ai][bj][m][0] * rs, up = acc[ai][bj][m][1] * rs;
                    f32x4 h;
#pragma unroll
                    for (int i = 0; i < 4; ++i) h[i] = g[i] * sigmoidf_(g[i]) * up[i];
                    *(u32x2*)(HB + (size_t)row * DFF + hc) = f4_to_bf4(h);
                }
            }
    }
};

__device__ __forceinline__ int colmap_in(int n) { if (n >= DIN) return -1; if (n >= C_V) return n; const int sb = n >= C_K ? C_K : 0; const int o = n - sb; return sb + (o & ~63) + ((o & 63) >> 1) + 32 * (o & 1); }
__device__ __forceinline__ int colmap_gu(int n) { return ((n >> 3) << 2) + (n & 3) + DFF * ((n >> 2) & 1); }

__device__ __forceinline__ void transpose_item(const float* __restrict__ W, int K, int Nsrc, const float* __restrict__ kscale, bf16_t* WT, int item, int nblk, int mode, LAS float* scr, int lane) {
    const int kb = item / nblk, nb = item - kb * nblk, k0 = 64 * kb, n0 = 32 * nb;
    const int ch = lane & 7, rsub = lane >> 3, c4 = ch & 3, hi = ch >> 2;
    int srccol, x0, xs;
    bool zero = false;
    if (mode == 1 && n0 < C_V) { const int sb = n0 >= C_K ? C_K : 0, o = n0 - sb; srccol = sb + (o & ~63) + ((o & 63) >> 1) + 32 * hi + 4 * c4; x0 = 8 * c4 + hi; xs = 2; }
    else if (mode == 2) { srccol = (n0 >> 1) + DFF * hi + 4 * c4; x0 = 8 * c4 + 4 * hi; xs = 1; }
    else { srccol = n0 + 4 * ch; x0 = 4 * ch; xs = 1; zero = (mode == 1 && n0 >= DIN); }
    f32x4 v[8];
#pragma unroll
    for (int i = 0; i < 8; ++i) v[i] = zero ? (f32x4){0.f, 0.f, 0.f, 0.f} : *(const f32x4*)(W + (size_t)(k0 + 8 * i + rsub) * Nsrc + srccol);
#pragma unroll
    for (int i = 0; i < 8; ++i) {
        const int kk = 8 * i + rsub; const float sc = kscale ? kscale[k0 + kk] : 1.0f;
#pragma unroll
        for (int e = 0; e < 4; ++e) scr[kk * 33 + x0 + xs * e] = v[i][e] * sc;
    }
    asm volatile("s_waitcnt lgkmcnt(0)" ::: "memory");
    const int c = lane & 7;
#pragma unroll
    for (int j = 0; j < 4; ++j) {
        const int n = (lane >> 3) + 8 * j; const LAS float* s = scr + (8 * c) * 33 + n;
        u32x4 o; o.x = pk2(s[0 * 33], s[1 * 33]); o.y = pk2(s[2 * 33], s[3 * 33]); o.z = pk2(s[4 * 33], s[5 * 33]); o.w = pk2(s[6 * 33], s[7 * 33]);
        *(u32x4*)(WT + (size_t)(n0 + n) * K + k0 + 8 * c) = o;
    }
    asm volatile("s_waitcnt lgkmcnt(0)" ::: "memory");
}

__device__ __forceinline__ void prologue(KP P, LAS unsigned char* lds) {
    const int tid = opaque_tid(), lane = tid & 63, wave = tid >> 6;
    const int gw = blockIdx.x * 8 + wave, NGW = gridDim.x * 8;
    const int gt = blockIdx.x * 512 + tid, NGT = gridDim.x * 512;
    unsigned char* ws = P->ws;
    LAS float* scr = (LAS float*)(lds + wave * 8704);
    constexpr int I_IN = 16 * (DINP / 32), I_OUT = 16 * (DM / 32), I_GU = 16 * (NGU / 32), I_DN = (DFF / 64) * (DM / 32), I_L = I_IN + I_OUT + I_GU + I_DN;
    for (int it = gw; it < 2 * I_L; it += NGW) {
        const int l = it / I_L; int r = it - l * I_L;
        if (r < I_IN) { transpose_item(P->in[I_WIN] + (size_t)l * DM * DIN, DM, DIN, P->in[I_N1G] + l * DM, (bf16_t*)(ws + WS_WIN) + (size_t)l * DINP * DM, r, DINP / 32, 1, scr, lane); continue; } r -= I_IN;
        if (r < I_OUT) { transpose_item(P->in[I_WOUT] + (size_t)l * DM * DM, DM, DM, nullptr, (bf16_t*)(ws + WS_WOUT) + (size_t)l * DM * DM, r, DM / 32, 0, scr, lane); continue; } r -= I_OUT;
        if (r < I_GU) { transpose_item(P->in[I_WGU] + (size_t)l * DM * NGU, DM, NGU, P->in[I_N2G] + l * DM, (bf16_t*)(ws + WS_WGU) + (size_t)l * NGU * DM, r, NGU / 32, 2, scr, lane); continue; } r -= I_GU;
        transpose_item(P->in[I_WDN] + (size_t)l * DFF * DM, DFF, DM, nullptr, (bf16_t*)(ws + WS_WDN) + (size_t)l * DM * DFF, r, DM / 32, 0, scr, lane);
    }
    float* rss = (float*)(ws + WS_RSS);
    bf16_t* XB = (bf16_t*)(ws + WS_XB);
    for (int row0 = gw; row0 < MT; row0 += 4 * NGW) {
        f32x4 v[4][4];
#pragma unroll
        for (int r = 0; r < 4; ++r) { const int row = row0 + r * NGW; if (row < MT) { const float* xr = row < SEQ ? P->in[I_XP] + (size_t)row * DM : P->in[I_XS] + (size_t)(row - SEQ) * DM;
#pragma unroll
            for (int j = 0; j < 4; ++j) v[r][j] = *(const f32x4*)(xr + 4 * lane + 256 * j); } }
#pragma unroll
        for (int r = 0; r < 4; ++r) { const int row = row0 + r * NGW; if (row < MT) { float sm = 0.f;
#pragma unroll
            for (int j = 0; j < 4; ++j) { const f32x4 x = v[r][j]; sm += (x[0] * x[0] + x[1] * x[1]) + (x[2] * x[2] + x[3] * x[3]); *(u32x2*)(XB + (size_t)row * DM + 4 * lane + 256 * j) = f4_to_bf4(x); }
            sm = wave_sum(sm);
            if (lane == 0) rss[row] = sm; } }
    }
    for (int i = gt; i < 4 * MT; i += NGT) rss[MT + i] = 0.f;
    bf16_t* WA = (bf16_t*)(ws + WS_WA); bf16_t* WX = (bf16_t*)(ws + WS_WX); bf16_t* WP = (bf16_t*)(ws + WS_WP);
    for (int i = gt; i < 2 * 6 * 64 * 64; i += NGT) {
        const int slot = i & 63, d = (i >> 6) & 63, ln = i >> 12;
        const int kk = slot >> 5, q = (slot >> 3) & 3, e = slot & 7, c = 16 * (2 * kk + (e >> 2)) + 4 * q + (e & 3);
        const size_t src = ((size_t)ln * 64 + c) * 64 + d;
        WA[i] = (bf16_t)(pk2(P->in[I_GAW][src], 0.f) & 0xffffu); WX[i] = (bf16_t)(pk2(P->in[I_GXW][src], 0.f) & 0xffffu);
    }
    for (int i = gt; i < 2 * 4 * 64 * 64; i += NGT) {
        const int c = i & 63, d = (i >> 6) & 63, lg = i >> 12;
        WP[i] = (bf16_t)(pk2(P->in[I_POOLW][((size_t)lg * 64 + c) * 64 + d], 0.f) & 0xffffu);
    }
    float* rope = (float*)(ws + WS_ROPE);
    {
        const int j = gt & 31;
        const float inv = (float)exp2(-(double)j * (13.287712379549449 / 32.0));
        for (int pos = gt >> 5; pos < 16392; pos += NGT >> 5) {
            const float ang = (float)pos * inv;
            double rev = (double)ang * 0.15915494309189535; rev -= floor(rev);
            const float rf = (float)rev;
            *(f32x2*)(rope + 2 * ((size_t)pos * 32 + j)) = (f32x2){__builtin_amdgcn_cosf(rf), __builtin_amdgcn_sinf(rf)};
        }
    }
}

__device__ __forceinline__ void pool_row8(KP P, const bf16_t* PJ, int l, int R, int k, int ch, float (&v)[8]) {
    if (R < SEQ) {
        const int rr = R - k;
        if (rr < 0) {
#pragma unroll
            for (int i = 0; i < 8; ++i) v[i] = 0.f;
            return; }
        const u32x4 w = *(const u32x4*)(PJ + (size_t)rr * PJP + C_U + ch);
        v[0] = bf_lo(w.x); v[1] = bf_hi(w.x); v[2] = bf_lo(w.y); v[3] = bf_hi(w.y); v[4] = bf_lo(w.z); v[5] = bf_hi(w.z); v[6] = bf_lo(w.w); v[7] = bf_hi(w.w);
    } else {
        const int si = R - SEQ, b = si >> 3, t = si & 7, tk = t - k;
        if (tk >= 0) {
            const u32x4 w = *(const u32x4*)(PJ + (size_t)(SEQ + 8 * b + tk) * PJP + C_U + ch);
            v[0] = bf_lo(w.x); v[1] = bf_hi(w.x); v[2] = bf_lo(w.y); v[3] = bf_hi(w.y); v[4] = bf_lo(w.z); v[5] = bf_hi(w.z); v[6] = bf_lo(w.w); v[7] = bf_hi(w.w);
        } else {
            const float* s = P->in[I_SPOOL] + (((size_t)l * 32 + b) * 15 + (15 + tk)) * 256 + ch;
            const f32x4 a = *(const f32x4*)s, c = *(const f32x4*)(s + 4);
            v[0] = a[0]; v[1] = a[1]; v[2] = a[2]; v[3] = a[3]; v[4] = c[0]; v[5] = c[1]; v[6] = c[2]; v[7] = c[3];
        }
    }
}

constexpr int TLP = 136;
__device__ __forceinline__ void pool_task(KP P, int l, int task, int lane, LAS unsigned char* wl) {
    const int g = task & 3, T0 = (task >> 2) * 64, w = 2 << g, fr = lane & 15, fq = lane >> 4;
    const bool smp = T0 >= SEQ;
    const bf16_t* PJ = (const bf16_t*)(P->ws + WS_PJ); bf16_t* MIX = (bf16_t*)(P->ws + WS_MIX);
    const bf16_t* WP = (const bf16_t*)(P->ws + WS_WP) + (size_t)(l * 4 + g) * 4096;
    if (!smp) {
#pragma unroll
        for (int i = 0; i < 10; ++i) {
            const int rr = 8 * i + (lane >> 3), gr = T0 - 15 + rr;
            u32x4 v = (u32x4){0u, 0u, 0u, 0u};
            if (rr < 79 && gr >= 0) v = *(const u32x4*)(PJ + (size_t)gr * PJP + C_U + 64 * g + 8 * (lane & 7));
            if (rr < 79) *(LAS u32x4*)(wl + rr * TLP + 16 * (lane & 7)) = v;
        }
    }
    bf16x8 af[4][2];
#pragma unroll
    for (int dt = 0; dt < 4; ++dt)
#pragma unroll
        for (int kk = 0; kk < 2; ++kk) af[dt][kk] = *(const bf16x8*)(WP + (16 * dt + fr) * 64 + 32 * kk + 8 * fq);
    f32x4 sc[4];
#pragma unroll
    for (int dt = 0; dt < 4; ++dt) sc[dt] = *(const f32x4*)(P->in[I_POOLS] + l * 256 + 64 * g + 16 * dt + 4 * fq);
#pragma unroll 1
    for (int tt = 0; tt < 4; ++tt) {
        const int R = T0 + 16 * tt + fr;
        const int pos1 = R < SEQ ? R + 1 : SEQ + 1;
        const float rc = 1.0f / (float)(pos1 < w ? pos1 : w);
        bf16x8 bfr[2];
#pragma unroll
        for (int kk = 0; kk < 2; ++kk) {
            float s[8], u0[8];
            if (!smp) {
                const LAS unsigned char* rp = wl + (15 + 16 * tt + fr) * TLP + 2 * (32 * kk + 8 * fq);
                { const u32x4 x = *(const LAS u32x4*)rp; u0[0] = bf_lo(x.x); u0[1] = bf_hi(x.x); u0[2] = bf_lo(x.y); u0[3] = bf_hi(x.y); u0[4] = bf_lo(x.z); u0[5] = bf_hi(x.z); u0[6] = bf_lo(x.w); u0[7] = bf_hi(x.w); }
#pragma unroll
                for (int i = 0; i < 8; ++i) s[i] = u0[i];
                for (int k = 1; k < w; ++k) {
                    const u32x4 x = *(const LAS u32x4*)(rp - k * TLP);
                    s[0] += bf_lo(x.x); s[1] += bf_hi(x.x); s[2] += bf_lo(x.y); s[3] += bf_hi(x.y); s[4] += bf_lo(x.z); s[5] += bf_hi(x.z); s[6] += bf_lo(x.w); s[7] += bf_hi(x.w);
                }
            } else {
                const int ch = 64 * g + 32 * kk + 8 * fq;
                pool_row8(P, PJ, l, R, 0, ch, u0);
#pragma unroll
                for (int i = 0; i < 8; ++i) s[i] = u0[i];
                for (int k = 1; k < w; ++k) {
                    float v[8]; pool_row8(P, PJ, l, R, k, ch, v);
#pragma unroll
                    for (int i = 0; i < 8; ++i) s[i] += v[i];
                }
            }
            u32x4 pw;
            pw.x = pk2(s[0] * rc - u0[0], s[1] * rc - u0[1]); pw.y = pk2(s[2] * rc - u0[2], s[3] * rc - u0[3]);
            pw.z = pk2(s[4] * rc - u0[4], s[5] * rc - u0[5]); pw.w = pk2(s[6] * rc - u0[6], s[7] * rc - u0[7]);
            bfr[kk] = __builtin_bit_cast(bf16x8, pw);
        }
#pragma unroll
        for (int dt = 0; dt < 4; ++dt) {
            f32x4 y = (f32x4){0.f, 0.f, 0.f, 0.f};
            y = __builtin_amdgcn_mfma_f32_16x16x32_bf16(af[dt][0], bfr[0], y, 0, 0, 0);
            y = __builtin_amdgcn_mfma_f32_16x16x32_bf16(af[dt][1], bfr[1], y, 0, 0, 0);
            y = y * sc[dt];
            *(u32x2*)(MIX + (size_t)R * DM + 384 + 64 * g + 16 * dt + 4 * fq) = f4_to_bf4(y);
        }
    }
}

__device__ __forceinline__ void rglru_local_task(KP P, int l, int task, int lane, LAS unsigned char* wl) {
    const int c64 = task / 6, n = task - 6 * c64, T0 = c64 * 64, fr = lane & 15, fq = lane >> 4;
    const bool smp = T0 >= SEQ;
    const bf16_t* PJ = (const bf16_t*)(P->ws + WS_PJ);
    float* HL = (float*)(P->ws + WS_HL); float* PC = (float*)(P->ws + WS_PC);
    const bf16_t* WA = (const bf16_t*)(P->ws + WS_WA) + (size_t)(l * 6 + n) * 4096; const bf16_t* WX = (const bf16_t*)(P->ws + WS_WX) + (size_t)(l * 6 + n) * 4096;
    LAS float* cst = (LAS float*)(wl + 12288);
    if (!smp) {
#pragma unroll
        for (int i = 0; i < 9; ++i) {
            const int rr = 8 * i + (lane >> 3), gr = T0 - 3 + rr;
            u32x4 v = (u32x4){0u, 0u, 0u, 0u};
            if (rr < 67 && gr >= 0) v = *(const u32x4*)(PJ + (size_t)gr * PJP + C_XR + 64 * n + 8 * (lane & 7));
            if (rr < 67) *(LAS u32x4*)(wl + rr * TLP + 16 * (lane & 7)) = v;
        }
    } else {
#pragma unroll 1
        for (int i = 0; i < 11; ++i) {
            const int rr = 8 * i + (lane >> 3), bb = rr / 11, k = rr - 11 * bb, b = ((T0 - SEQ) >> 3) + bb, c8 = 64 * n + 8 * (lane & 7);
            u32x4 v;
            if (k < 3) { const float* sp = P->in[I_SCONV] + (((size_t)l * 32 + b) * 3 + k) * 384 + c8; const f32x4 a = *(const f32x4*)sp, c = *(const f32x4*)(sp + 4);
                v.x = pk2(a[0], a[1]); v.y = pk2(a[2], a[3]); v.z = pk2(c[0], c[1]); v.w = pk2(c[2], c[3]); }
            else v = *(const u32x4*)(PJ + (size_t)(SEQ + 8 * b + (k - 3)) * PJP + C_XR + c8);
            *(LAS u32x4*)(wl + rr * TLP + 16 * (lane & 7)) = v;
        }
    }
    {
        const int ch = l * 384 + 64 * n + lane;
#pragma unroll
        for (int j = 0; j < 4; ++j) cst[j * 64 + lane] = P->in[I_CONVW][(size_t)l * 3 * 384 + j * 384 + ch];
        cst[4 * 64 + lane] = P->in[I_CONVB][ch]; cst[5 * 64 + lane] = P->in[I_GAB][ch]; cst[6 * 64 + lane] = P->in[I_GXB][ch];
        cst[7 * 64 + lane] = -log1pf(__expf(-P->in[I_LAM][ch]));
    }
    __builtin_amdgcn_sched_barrier(0);
    bf16x8 wa[4][2], wx[4][2];
#pragma unroll
    for (int dt = 0; dt < 4; ++dt)
#pragma unroll
        for (int kk = 0; kk < 2; ++kk) { wa[dt][kk] = *(const bf16x8*)(WA + (16 * dt + fr) * 64 + 32 * kk + 8 * fq); wx[dt][kk] = *(const bf16x8*)(WX + (16 * dt + fr) * 64 + 32 * kk + 8 * fq); }
    f32x4 Pc[4], Hc[4];
#pragma unroll
    for (int dt = 0; dt < 4; ++dt) { Pc[dt] = (f32x4){1.f, 1.f, 1.f, 1.f}; Hc[dt] = (f32x4){0.f, 0.f, 0.f, 0.f}; }
    const int segm = smp ? 7 : 15;
#pragma unroll 1
    for (int tt = 0; tt < 4; ++tt) {
        const int ti = 16 * tt + fr, R = T0 + ti;
        const int trow = smp ? (ti >> 3) * 11 + (ti & 7) : ti;
        f32x4 xc[4];
#pragma unroll
        for (int dt = 0; dt < 4; ++dt) {
            const int cl = 16 * dt + 4 * fq;
            f32x4 a = *(const LAS f32x4*)(cst + 4 * 64 + cl);
#pragma unroll
            for (int j = 0; j < 4; ++j) a += *(const LAS f32x4*)(cst + j * 64 + cl) * bf4_to_f4(*(const LAS u32x2*)(wl + (trow + j) * TLP + 2 * cl));
            xc[dt] = a;
        }
        bf16x8 bfr[2];
#pragma unroll
        for (int kk = 0; kk < 2; ++kk) { u32x4 pw; pw.x = pk2(xc[2 * kk][0], xc[2 * kk][1]); pw.y = pk2(xc[2 * kk][2], xc[2 * kk][3]); pw.z = pk2(xc[2 * kk + 1][0], xc[2 * kk + 1][1]); pw.w = pk2(xc[2 * kk + 1][2], xc[2 * kk + 1][3]); bfr[kk] = __builtin_bit_cast(bf16x8, pw); }
#pragma unroll
        for (int dt = 0; dt < 4; ++dt) {
            const int cl = 16 * dt + 4 * fq, ch = 64 * n + cl;
            f32x4 ra = (f32x4){0.f, 0.f, 0.f, 0.f}, ia = (f32x4){0.f, 0.f, 0.f, 0.f};
            ra = __builtin_amdgcn_mfma_f32_16x16x32_bf16(wa[dt][0], bfr[0], ra, 0, 0, 0); ra = __builtin_amdgcn_mfma_f32_16x16x32_bf16(wa[dt][1], bfr[1], ra, 0, 0, 0);
            ia = __builtin_amdgcn_mfma_f32_16x16x32_bf16(wx[dt][0], bfr[0], ia, 0, 0, 0); ia = __builtin_amdgcn_mfma_f32_16x16x32_bf16(wx[dt][1], bfr[1], ia, 0, 0, 0);
            const f32x4 ba = *(const LAS f32x4*)(cst + 5 * 64 + cl), bx = *(const LAS f32x4*)(cst + 6 * 64 + cl), ls = *(const LAS f32x4*)(cst + 7 * 64 + cl);
            f32x4 A, B;
#pragma unroll
            for (int i = 0; i < 4; ++i) {
                const float r = fsigmoid(ra[i] + ba[i]), ig = fsigmoid(ia[i] + bx[i]);
                const float a = fexp2(11.541560327111707f * r * ls[i]);
                A[i] = a; B[i] = __builtin_amdgcn_sqrtf(fmaxf(1.0f - a * a, 0.f)) * ig * xc[dt][i];
            }
#pragma unroll
            for (int off = 1; off < 16; off <<= 1) {
                if (off == 8 && smp) break;
                const bool cnd = (fr & segm) >= off;
#pragma unroll
                for (int i = 0; i < 4; ++i) {
                    const float ap = dpp_row_shr(A[i], off), bp = dpp_row_shr(B[i], off);
                    if (cnd) { B[i] = A[i] * bp + B[i]; A[i] = A[i] * ap; }
                }
            }
            const f32x4 h = B + A * Hc[dt], p = A * Pc[dt];
            *(f32x4*)(HL + (size_t)R * 384 + ch) = h; *(f32x4*)(PC + (size_t)R * 384 + ch) = p;
            if (!smp) {
#pragma unroll
                for (int i = 0; i < 4; ++i) { Hc[dt][i] = __shfl(h[i], (lane & 48) | 15); Pc[dt][i] = __shfl(p[i], (lane & 48) | 15); }
            }
        }
    }
    if (!smp && fr == 0) {
#pragma unroll
        for (int dt = 0; dt < 4; ++dt) {
            const int ch = 64 * n + 16 * dt + 4 * fq;
            *(f32x4*)((float*)(P->ws + WS_CA) + (size_t)c64 * 384 + ch) = Pc[dt]; *(f32x4*)((float*)(P->ws + WS_CH) + (size_t)c64 * 384 + ch) = Hc[dt];
        }
    }
}

__device__ __forceinline__ void rglru_fix_task(KP P, int l, int task, LAS unsigned char* lds) {
    const int tid = opaque_tid(), c = task / 3, cg_ = task - 3 * c, chl = tid & 127, seg = tid >> 7, ch = 128 * cg_ + chl;
    const float* CA = (const float*)(P->ws + WS_CA); const float* CH = (const float*)(P->ws + WS_CH);
    const float* HL = (const float*)(P->ws + WS_HL); const float* PC = (const float*)(P->ws + WS_PC);
    const bf16_t* PJ = (const bf16_t*)(P->ws + WS_PJ); bf16_t* MIX = (bf16_t*)(P->ws + WS_MIX);
    LAS float* sA = (LAS float*)lds; LAS float* sH = sA + 512;
    const int T0 = c * 64 + seg * 16;
    float hl[16], pc[16]; unsigned short gg[16];
#pragma unroll
    for (int i = 0; i < 16; ++i) { const int R = T0 + i; hl[i] = HL[(size_t)R * 384 + ch]; pc[i] = PC[(size_t)R * 384 + ch]; gg[i] = PJ[(size_t)R * PJP + C_GT + ch]; }
    float carry = 0.f;
    {
        const int q = (c + 3) >> 2, k0 = seg * q, k1 = (k0 + q) < c ? (k0 + q) : c;
        float a = 1.f, h = 0.f;
        for (int kb_ = k0; kb_ < k1; kb_ += 32) {
            float ak[32], hk[32];
#pragma unroll
            for (int u_ = 0; u_ < 32; ++u_) { const int k = (kb_ + u_) < k1 ? (kb_ + u_) : (k1 - 1); ak[u_] = CA[(size_t)k * 384 + ch]; hk[u_] = CH[(size_t)k * 384 + ch]; }
#pragma unroll
            for (int u_ = 0; u_ < 32; ++u_) if (kb_ + u_ < k1) { h = ak[u_] * h + hk[u_]; a *= ak[u_]; }
        }
        sA[seg * 128 + chl] = a; sH[seg * 128 + chl] = h;
        __syncthreads();
#pragma unroll
        for (int s = 0; s < 4; ++s) carry = sA[s * 128 + chl] * carry + sH[s * 128 + chl];
    }
#pragma unroll
    for (int i = 0; i < 16; ++i) {
        const int R = T0 + i;
        const float h = hl[i] + pc[i] * carry;
        const float g = __uint_as_float((unsigned)gg[i] << 16);
        const float y = h * gelu_tanh(g);
        MIX[(size_t)R * DM + 640 + ch] = (bf16_t)(pk2(y, 0.f) & 0xffffu);
        if (R == SEQ - 1) P->out[OFF_PRG + l * 384 + ch] = h;
    }
    __syncthreads();
}
__device__ __forceinline__ void rglru_fix_sample(KP P, int l) {
    const int gt = blockIdx.x * 512 + opaque_tid();
    if (gt >= NSMP * 384) return;
    const int si = gt / 384, ch = gt - si * 384, R = SEQ + si, b = si >> 3;
    const float h = ((const float*)(P->ws + WS_HL))[(size_t)R * 384 + ch] + ((const float*)(P->ws + WS_PC))[(size_t)R * 384 + ch] * P->in[I_SRG][((size_t)l * 32 + b) * 384 + ch];
    const float g = __uint_as_float((unsigned)((const bf16_t*)(P->ws + WS_PJ))[(size_t)R * PJP + C_GT + ch] << 16);
    ((bf16_t*)(P->ws + WS_MIX))[(size_t)R * DM + 640 + ch] = (bf16_t)(pk2(h * gelu_tanh(g), 0.f) & 0xffffu);
    if ((si & 7) == 7) P->out[OFF_SRG + ((size_t)l * 32 + b) * 384 + ch] = h;
}

__device__ __forceinline__ s16x4 vtr(const LAS unsigned char* p) { return __builtin_bit_cast(s16x4, __builtin_amdgcn_ds_read_tr16_b64_v4i16((LAS s16x4*)p)); }

constexpr int VRP = 144;
constexpr int ATT_STEPS = 23;
__device__ __forceinline__ void att_step_info(int st, int& sh, int& s) { if (st < 12) { sh = 0; s = st; } else if (st < 18) { sh = 2; s = st - 12; } else { sh = 4; s = st - 18; } }

struct AttKV { bf16x8 k[2][2]; u32x4 v[4]; };
__device__ __forceinline__ void att_load(AttKV& b, int st, int p0, int fr, int lane, const bf16_t* Kb, const bf16_t* Vb) {
    int sh, s; att_step_info(st, sh, s);
    const int kbase = p0 - (128 << sh);
#pragma unroll
    for (int kt = 0; kt < 2; ++kt) { int pk = kbase + ((32 * s + 16 * kt + fr) << sh); pk = pk < 0 ? 0 : (pk > MT - 1 ? MT - 1 : pk);
        b.k[kt][0] = *(const bf16x8*)(Kb + (size_t)pk * PJP); b.k[kt][1] = *(const bf16x8*)(Kb + (size_t)pk * PJP + 32); }
    int pv = kbase + ((32 * s + (lane >> 1)) << sh); pv = pv < 0 ? 0 : (pv > MT - 1 ? MT - 1 : pv);
#pragma unroll
    for (int i = 0; i < 4; ++i) b.v[i] = *(const u32x4*)(Vb + (size_t)pv * PJP + 8 * i);
}
__device__ __forceinline__ void att_compute(const AttKV& b, int st, int p0, int fr, int fq, const bf16x8 qf0, const bf16x8 qf1, float& m, float& lsum, f32x4 (&o)[4],
                                            LAS unsigned char* vw, const LAS unsigned char* vr) {
    int sh, s; att_step_info(st, sh, s);
    const int kbase = p0 - (128 << sh);
    f32x4 sc[2];
#pragma unroll
    for (int kt = 0; kt < 2; ++kt) {
        sc[kt] = __builtin_amdgcn_mfma_f32_16x16x32_bf16(b.k[kt][0], qf0, (f32x4){0.f, 0.f, 0.f, 0.f}, 0, 0, 0);
        sc[kt] = __builtin_amdgcn_mfma_f32_16x16x32_bf16(b.k[kt][1], qf1, sc[kt], 0, 0, 0);
    }
    const int e0 = ((16 >> sh) * fr) + 128 - (32 * s + 4 * fq);
    const unsigned emax = (unsigned)min(128, (p0 + 16 * fr) >> sh);
    float mx = -INFINITY;
#pragma unroll
    for (int kt = 0; kt < 2; ++kt)
#pragma unroll
        for (int i = 0; i < 4; ++i) {
            const bool ok = (unsigned)(e0 - 16 * kt - i) <= emax;
            sc[kt][i] = ok ? sc[kt][i] : -INFINITY;
            mx = fmaxf(mx, sc[kt][i]);
        }
    {
        const auto r16 = __builtin_amdgcn_permlane16_swap(__float_as_uint(mx), __float_as_uint(mx), false, false);
        mx = fmaxf(__uint_as_float(r16[0]), __uint_as_float(r16[1]));
        const auto r32 = __builtin_amdgcn_permlane32_swap(__float_as_uint(mx), __float_as_uint(mx), false, false);
        mx = fmaxf(__uint_as_float(r32[0]), __uint_as_float(r32[1]));
    }
    const float mn = fmaxf(m, mx), al = fexp2(m - mn);
    m = mn;
    float ps = 0.f;
#pragma unroll
    for (int kt = 0; kt < 2; ++kt)
#pragma unroll
        for (int i = 0; i < 4; ++i) { sc[kt][i] = fexp2(sc[kt][i] - mn); ps += sc[kt][i]; }
    lsum = lsum * al + ps;
    u32x4 pw; pw.x = pk2(sc[0][0], sc[0][1]); pw.y = pk2(sc[0][2], sc[0][3]); pw.z = pk2(sc[1][0], sc[1][1]); pw.w = pk2(sc[1][2], sc[1][3]);
    const bf16x8 pb8 = __builtin_bit_cast(bf16x8, pw);
#pragma unroll
    for (int i = 0; i < 4; ++i) *(LAS u32x4*)(vw + 16 * i) = b.v[i];
#pragma unroll
    for (int dt = 0; dt < 4; ++dt) {
        const s16x4 lo = vtr(vr + dt * 32), hi = vtr(vr + 16 * VRP + dt * 32);
        const bf16x8 vf = __builtin_shufflevector(lo, hi, 0, 1, 2, 3, 4, 5, 6, 7);
        o[dt] = o[dt] * al;
        o[dt] = __builtin_amdgcn_mfma_f32_16x16x32_bf16(vf, pb8, o[dt], 0, 0, 0);
    }
}

constexpr int CPY_SEG = 2040 * 384 / 4, CPY_KV = 32 * CPY_SEG, CPY_TOT = 2 * CPY_KV;
__device__ __forceinline__ void cpy_addr(KP P, int l, int i, const f32x4*& src, f32x4*& dst) {
    const int kv = i >= CPY_KV, r = i - kv * CPY_KV, b = r / CPY_SEG, off = r - b * CPY_SEG;
    src = (const f32x4*)(P->in[kv ? I_CV : I_CK] + (((size_t)l * 32 + b) * 2048 + 8) * 384) + off;
    dst = (f32x4*)(P->out + (kv ? OFF_SWV : OFF_SWK) + ((size_t)l * 32 + b) * 2048 * 384) + off;
}
constexpr int CPY_R1 = (int)(0.45 * CPY_TOT) & ~63, CPY_R2 = (int)(0.65 * CPY_TOT) & ~63;
__device__ __forceinline__ void copy_range(KP P, int l, int lo, int hi, int part, int nparts) {
    for (int i0 = lo + part; i0 < hi; i0 += 8 * nparts) {
        f32x4 v[8];
#pragma unroll
        for (int u = 0; u < 8; ++u) { const int i = i0 + u * nparts; if (i < hi) { const f32x4* sp; f32x4* dp; cpy_addr(P, l, i, sp, dp); v[u] = __builtin_nontemporal_load(sp); } }
#pragma unroll
        for (int u = 0; u < 8; ++u) { const int i = i0 + u * nparts; if (i < hi) { const f32x4* sp; f32x4* dp; cpy_addr(P, l, i, sp, dp); __builtin_nontemporal_store(v[u], dp); } }
    }
}
__device__ __forceinline__ void attn_tile(KP P, int l, int wt, int gw, int NGW, int tk, int lane, LAS unsigned char* vl) {
    const int r = wt & 15, hh = (wt >> 4) % 6, pb = wt / 96, p0 = pb * 256 + r, fr = lane & 15, fq = lane >> 4;
    const bf16_t* PJ = (const bf16_t*)(P->ws + WS_PJ); bf16_t* MIX = (bf16_t*)(P->ws + WS_MIX);
    const bf16_t* qp = PJ + (size_t)(p0 + 16 * fr) * PJP + C_Q + 64 * hh + 8 * fq;
    const bf16x8 qf0 = *(const bf16x8*)qp, qf1 = *(const bf16x8*)(qp + 32);
    const bf16_t* Kb = PJ + C_K + 64 * hh + 8 * fq;
    const bf16_t* Vb = PJ + C_V + 64 * hh + 32 * (lane & 1);
    float m = -1e30f, lsum = 0.f;
    f32x4 o[4];
#pragma unroll
    for (int dt = 0; dt < 4; ++dt) o[dt] = (f32x4){0.f, 0.f, 0.f, 0.f};
    LAS unsigned char* vw = vl + (lane >> 1) * VRP + (lane & 1) * 64;
    const LAS unsigned char* vr = vl + (4 * fq + (fr >> 2)) * VRP + (fr & 3) * 8;
    AttKV b0, b1, b2;
    att_load(b0, 0, p0, fr, lane, Kb, Vb); att_load(b1, 1, p0, fr, lane, Kb, Vb);
#pragma unroll 1
    for (int st = 0; st < ATT_STEPS; st += 3) {
        f32x4 cv_[4];
        const int cbase = ((tk * 8 + st / 3) * 4) * NGW + gw;
#pragma unroll
        for (int u = 0; u < 4; ++u) { const int i = CPY_R2 + (cbase + u * NGW) * 64 + lane; if (i < CPY_TOT) { const f32x4* sp; f32x4* dp; cpy_addr(P, l, i, sp, dp); cv_[u] = __builtin_nontemporal_load(sp); } }
        if (st + 2 < ATT_STEPS) att_load(b2, st + 2, p0, fr, lane, Kb, Vb);
        att_compute(b0, st, p0, fr, fq, qf0, qf1, m, lsum, o, vw, vr);
        if (st + 3 < ATT_STEPS) att_load(b0, st + 3, p0, fr, lane, Kb, Vb);
        if (st + 1 < ATT_STEPS) att_compute(b1, st + 1, p0, fr, fq, qf0, qf1, m, lsum, o, vw, vr);
        if (st + 4 < ATT_STEPS) att_load(b1, st + 4, p0, fr, lane, Kb, Vb);
        if (st + 2 < ATT_STEPS) att_compute(b2, st + 2, p0, fr, fq, qf0, qf1, m, lsum, o, vw, vr);
#pragma unroll
        for (int u = 0; u < 4; ++u) { const int i = CPY_R2 + (cbase + u * NGW) * 64 + lane; if (i < CPY_TOT) { const f32x4* sp; f32x4* dp; cpy_addr(P, l, i, sp, dp); __builtin_nontemporal_store(cv_[u], dp); } }
    }
    lsum += __shfl_xor(lsum, 16); lsum += __shfl_xor(lsum, 32);
    const float inv = 1.0f / lsum;
    bf16_t* op = MIX + (size_t)(p0 + 16 * fr) * DM + 64 * hh + 4 * fq;
#pragma unroll
    for (int dt = 0; dt < 4; ++dt) *(u32x2*)(op + 16 * dt) = f4_to_bf4(o[dt] * inv);
}

__device__ __forceinline__ void sattn_block_task(KP P, int l, int task, LAS unsigned char* lds) {
    const int tid = opaque_tid(), lane = tid & 63, wave = tid >> 6, l32 = lane & 31, half = lane >> 5;
    const int b = task >> 3, t = task & 7, row = SEQ + task;
    const bf16_t* PJ = (const bf16_t*)(P->ws + WS_PJ); bf16_t* MIX = (bf16_t*)(P->ws + WS_MIX);
    f32x4 q[3];
#pragma unroll
    for (int i = 0; i < 3; ++i) q[i] = bf4_to_f4(*(const u32x2*)(PJ + (size_t)row * PJP + C_Q + 4 * (l32 + 32 * i)));
    const float* ck = P->in[I_CK] + ((size_t)l * 32 + b) * 2048 * 384 + 4 * l32;
    const float* cv = P->in[I_CV] + ((size_t)l * 32 + b) * 2048 * 384 + 4 * l32;
    const float* sk = P->out + OFF_SWK + ((size_t)l * 32 + b) * 2048 * 384 + 4 * l32;
    const float* sv = P->out + OFF_SWV + ((size_t)l * 32 + b) * 2048 * 384 + 4 * l32;
    float m[3], ls[3]; f32x4 o[3];
#pragma unroll
    for (int i = 0; i < 3; ++i) { m[i] = -1e30f; ls[i] = 0.f; o[i] = (f32x4){0.f, 0.f, 0.f, 0.f}; }
    const int slot = 2 * wave + half;
#pragma unroll 1
    for (int it0 = 0; it0 < 28; it0 += 4) {
        f32x4 kr[4][3], vr[4][3];
#pragma unroll
        for (int u = 0; u < 4; ++u) {
            const int kk = (it0 + u) * 16 + slot, kc = kk < 387 ? kk : 386;
            const int pat = kc >= 258 ? 2 : (kc >= 129 ? 1 : 0), j = kc - 129 * pat, idx = 2048 + t - (j << (2 * pat));
            const float* kp = idx < 2048 ? ck + (size_t)idx * 384 : sk + (size_t)(idx - 8) * 384;
            const float* vp = idx < 2048 ? cv + (size_t)idx * 384 : sv + (size_t)(idx - 8) * 384;
#pragma unroll
            for (int i = 0; i < 3; ++i) { kr[u][i] = *(const f32x4*)(kp + 128 * i); vr[u][i] = *(const f32x4*)(vp + 128 * i); }
        }
#pragma unroll
        for (int u = 0; u < 4; ++u) {
            const bool valid = (it0 + u) * 16 + slot < 387;
#pragma unroll
            for (int i = 0; i < 3; ++i) {
                float sc = (q[i][0] * kr[u][i][0] + q[i][1] * kr[u][i][1]) + (q[i][2] * kr[u][i][2] + q[i][3] * kr[u][i][3]);
                sc += __shfl_xor(sc, 1); sc += __shfl_xor(sc, 2); sc += __shfl_xor(sc, 4); sc += __shfl_xor(sc, 8);
                if (!valid) sc = -INFINITY;
                const float mn = fmaxf(m[i], sc), al = fexp2(m[i] - mn), p = fexp2(sc - mn);
                ls[i] = ls[i] * al + p; o[i] = o[i] * al + vr[u][i] * p; m[i] = mn;
            }
        }
    }
    LAS float* part = (LAS float*)lds;
#pragma unroll
    for (int i = 0; i < 3; ++i) {
        const float mo = __shfl_xor(m[i], 32), lo = __shfl_xor(ls[i], 32);
        f32x4 oo;
#pragma unroll
        for (int e = 0; e < 4; ++e) oo[e] = __shfl_xor(o[i][e], 32);
        const float M = fmaxf(m[i], mo), a0 = fexp2(m[i] - M), a1 = fexp2(mo - M);
        const float L = ls[i] * a0 + lo * a1; const f32x4 O = o[i] * a0 + oo * a1;
        if (half == 0) { LAS float* d = part + ((wave * 96) + l32 + 32 * i) * 6; d[0] = M; d[1] = L; d[2] = O[0]; d[3] = O[1]; d[4] = O[2]; d[5] = O[3]; }
    }
    __syncthreads();
    if (tid < 96) {
        float M = -1e30f;
#pragma unroll
        for (int w = 0; w < 8; ++w) M = fmaxf(M, part[(w * 96 + tid) * 6]);
        float L = 0.f; f32x4 O = (f32x4){0.f, 0.f, 0.f, 0.f};
#pragma unroll
        for (int w = 0; w < 8; ++w) { const LAS float* d = part + (w * 96 + tid) * 6; const float a = fexp2(d[0] - M); L += d[1] * a; O += (f32x4){d[2], d[3], d[4], d[5]} * a; }
        *(u32x2*)(MIX + (size_t)row * DM + 4 * tid) = f4_to_bf4(O * (1.0f / L));
    }
    __syncthreads();
}

__device__ __forceinline__ void phase2(KP P, int l, LAS unsigned char* lds) {
    const int tid = opaque_tid(), lane = tid & 63, wave = tid >> 6;
    const int gw = blockIdx.x * 8 + wave, NGW = gridDim.x * 8;
    const int gt = blockIdx.x * 512 + tid, NGT = gridDim.x * 512;
    constexpr int NT_R = NCH * 6, NT_P = NCH * 4;
    LAS unsigned char* wl = lds + wave * 16384;
    if (wave < 4) { int ln = lane; asm volatile("" : "+v"(ln)); for (int t = gw; t < NT_R + NT_P; t += NGW) { if (t < NT_R) rglru_local_task(P, l, t, ln, wl); else pool_task(P, l, t - NT_R, ln, wl); } }
    {
        int ln = lane; asm volatile("" : "+v"(ln));
        const int vb = (blockIdx.x & 7) * (gridDim.x >> 3) + (blockIdx.x >> 3), gwv = vb * 8 + wave;
#pragma unroll 1
        for (int tk = 0; tk < 3; ++tk) attn_tile(P, l, 3 * gwv + tk, gw, NGW, tk, ln, wl);
    }
    if (wave >= 4) { int ln = lane; asm volatile("" : "+v"(ln)); for (int t = gw; t < NT_R + NT_P; t += NGW) { if (t < NT_R) rglru_local_task(P, l, t, ln, wl); else pool_task(P, l, t - NT_R, ln, wl); } }
    {
        const bf16_t* PJ = (const bf16_t*)(P->ws + WS_PJ); float* out = P->out;
        for (int i = gt; i < 2048 * 192; i += NGT) {
            const int r = i / 192, c4 = (i - r * 192) * 4, kv = c4 >= 384, c = c4 - 384 * kv;
            *(f32x4*)(out + (kv ? OFF_PWV : OFF_PWK) + ((size_t)l * 2048 + r) * 384 + c) = bf4_to_f4(*(const u32x2*)(PJ + (size_t)(SEQ - 2048 + r) * PJP + C_K + c4));
        }
        for (int i = gt; i < 256 * 192; i += NGT) {
            const int si = i / 192, c4 = (i - si * 192) * 4, kv = c4 >= 384, c = c4 - 384 * kv;
            *(f32x4*)(out + (kv ? OFF_SWV : OFF_SWK) + (((size_t)l * 32 + (si >> 3)) * 2048 + 2040 + (si & 7)) * 384 + c) = bf4_to_f4(*(const u32x2*)(PJ + (size_t)(SEQ + si) * PJP + C_K + c4));
        }
        for (int i = gt; i < 15 * 64; i += NGT) {
            const int r = i >> 6, c = (i & 63) * 4;
            *(f32x4*)(out + OFF_PPOOL + ((size_t)l * 15 + r) * 256 + c) = bf4_to_f4(*(const u32x2*)(PJ + (size_t)(SEQ - 15 + r) * PJP + C_U + c));
        }
        for (int i = gt; i < 256 * 64; i += NGT) {
            const int si = i >> 6, c = (i & 63) * 4;
            *(f32x4*)(out + OFF_SPOOL + (((size_t)l * 32 + (si >> 3)) * 15 + 7 + (si & 7)) * 256 + c) = bf4_to_f4(*(const u32x2*)(PJ + (size_t)(SEQ + si) * PJP + C_U + c));
        }
        for (int i = gt; i < 3 * 96; i += NGT) {
            const int r = i / 96, c = (i - r * 96) * 4;
            *(f32x4*)(out + OFF_PCONV + ((size_t)l * 3 + r) * 384 + c) = bf4_to_f4(*(const u32x2*)(PJ + (size_t)(SEQ - 3 + r) * PJP + C_XR + c));
        }
        for (int i = gt; i < 32 * 3 * 96; i += NGT) {
            const int br = i / 96, c = (i - br * 96) * 4, b = br / 3, r = br - 3 * b;
            *(f32x4*)(out + OFF_SCONV + (((size_t)l * 32 + b) * 3 + r) * 384 + c) = bf4_to_f4(*(const u32x2*)(PJ + (size_t)(SEQ + 8 * b + 5 + r) * PJP + C_XR + c));
        }
    }
    for (int i = gt; i < 32 * 7 * 256; i += NGT) {
        const int b = i / 1792, rem = i - b * 1792;
        P->out[OFF_SPOOL + ((size_t)l * 32 + b) * 15 * 256 + rem] = P->in[I_SPOOL][((size_t)l * 32 + b) * 15 * 256 + 8 * 256 + rem];
    }
}

__device__ __forceinline__ void phase3(KP P, int l, LAS unsigned char* lds) {
    const int tid = opaque_tid(), lane = tid & 63, wave = tid >> 6;
    const int gw = blockIdx.x * 8 + wave, NGW = gridDim.x * 8;
    rglru_fix_sample(P, l);
    for (int t = blockIdx.x; t < 256 * 3; t += gridDim.x) rglru_fix_task(P, l, t, lds);
    for (int t = blockIdx.x; t < NSMP; t += gridDim.x) sattn_block_task(P, l, (t & 7) * (NSMP >> 3) + (t >> 3), lds);
}

template <int K>
__device__ __forceinline__ void sample_proj(const bf16_t* A, const bf16_t* Bt, const float* base_s, float* X, bf16_t* XB, float* rss_out, LAS unsigned char* lds) {
    const int tid = opaque_tid(), lane = tid & 63, wave = tid >> 6, fr = lane & 15, fq = lane >> 4;
    const int rg = blockIdx.x >> 4, cg_ = blockIdx.x & 15;
    if (blockIdx.x >= 256) return;
    constexpr int KS = K / 8, NK = KS / 32;
    const bf16_t* ap = A + (size_t)(SEQ + 16 * rg + fr) * K + wave * KS + 8 * fq;
    const bf16_t* bp = Bt + (size_t)(64 * cg_ + fr) * K + wave * KS + 8 * fq;
    f32x4 acc[4];
#pragma unroll
    for (int ct = 0; ct < 4; ++ct) acc[ct] = (f32x4){0.f, 0.f, 0.f, 0.f};
#pragma unroll 1
    for (int k0 = 0; k0 < NK; k0 += 4) {
        bf16x8 af[4], bf[4][4];
#pragma unroll
        for (int u = 0; u < 4; ++u) { const int ks = (k0 + u) < NK ? (k0 + u) : (NK - 1); af[u] = *(const bf16x8*)(ap + 32 * ks);
#pragma unroll
            for (int ct = 0; ct < 4; ++ct) bf[u][ct] = *(const bf16x8*)(bp + (size_t)(16 * ct) * K + 32 * ks); }
#pragma unroll
        for (int u = 0; u < 4; ++u) if (k0 + u < NK) {
#pragma unroll
            for (int ct = 0; ct < 4; ++ct) acc[ct] = __builtin_amdgcn_mfma_f32_16x16x32_bf16(bf[u][ct], af[u], acc[ct], 0, 0, 0);
        }
    }
    LAS f32x4* red = (LAS f32x4*)lds;
#pragma unroll
    for (int ct = 0; ct < 4; ++ct) red[(wave * 4 + ct) * 64 + lane] = acc[ct];
    __syncthreads();
    if (wave < 4) {
        f32x4 sacc = (f32x4){0.f, 0.f, 0.f, 0.f};
#pragma unroll
        for (int w = 0; w < 8; ++w) sacc += red[(w * 4 + wave) * 64 + lane];
        const int row = 16 * rg + fr, col = 64 * cg_ + 16 * wave + 4 * fq;
        const f32x4 x = *(const f32x4*)(base_s + (size_t)row * DM + col) + sacc;
        *(f32x4*)(X + (size_t)(SEQ + row) * DM + col) = x;
        *(u32x2*)(XB + (size_t)(SEQ + row) * DM + col) = f4_to_bf4(x);
        float ss = (x[0] * x[0] + x[1] * x[1]) + (x[2] * x[2] + x[3] * x[3]);
        ss += __shfl_xor(ss, 16); ss += __shfl_xor(ss, 32);
        if (fq == 0) unsafeAtomicAdd(rss_out + SEQ + row, ss);
    }
    __syncthreads();
}

__device__ __forceinline__ void final_norm(KP P) {
    const int tid = opaque_tid(), lane = tid & 63, wave = tid >> 6;
    const int gw = blockIdx.x * 8 + wave, NGW = gridDim.x * 8;
    const float* X = (const float*)(P->ws + WS_X); const float* rss = (const float*)(P->ws + WS_RSS) + 4 * MT;
    for (int row = gw; row < MT; row += NGW) {
        const float rs = rsqrtf(rss[row] * (1.0f / DM) + EPS);
#pragma unroll
        for (int j = 0; j < 4; ++j) {
            const int c = 4 * lane + 256 * j;
            const f32x4 v = *(const f32x4*)(X + (size_t)row * DM + c) * rs * *(const f32x4*)(P->in[I_FING] + c);
            *(f32x4*)(P->out + (size_t)row * DM + c) = v;
        }
    }
}

#define XB_TMO      128
#define XB_XCNT(j)  (256  + 64 * (j))
#define XB_XSUB(j)  (1280 + 64 * (j))
#define XB_XGEN(j)  (2304 + 64 * (j))
#define XB_TOP      3328
#define XB_TOPGEN   3392
#define XCD_BAR_WORDS 3456
#define XB_SPIN_CAP (1u << 18)

__device__ __forceinline__ unsigned xb_ld(unsigned* p)              { return __hip_atomic_load(p, __ATOMIC_RELAXED, __HIP_MEMORY_SCOPE_AGENT); }
__device__ __forceinline__ unsigned xb_add(unsigned* p, unsigned v) { return __hip_atomic_fetch_add(p, v, __ATOMIC_RELAXED, __HIP_MEMORY_SCOPE_AGENT); }
__device__ __forceinline__ unsigned xb_xcc_id() { return (unsigned)__builtin_amdgcn_s_getreg((3 << 11) | 20) & 0xFu; }
#define XB_SPIN(cond, bar) do { unsigned _sp = 0; while (cond) { __builtin_amdgcn_s_sleep(1); \
    if ((++_sp & 255u) == 0u) { if (xb_ld(&(bar)[XB_TMO])) break; if (_sp > XB_SPIN_CAP) { atomicAdd(&(bar)[XB_TMO], 1u); break; } } } } while (0)

struct XcdBarrier {
    unsigned* bar; unsigned x;
    volatile LAS unsigned* st;
};

__device__ __forceinline__ XcdBarrier xcd_barrier_post(unsigned* bar, volatile LAS unsigned* st) {
    XcdBarrier b; b.bar = bar; b.x = (unsigned)__builtin_amdgcn_readfirstlane((int)xb_xcc_id()); b.st = st;
    if (threadIdx.x == 0) (void)xb_add(&bar[XB_XCNT(b.x)], 1u);
    return b;
}
__device__ __forceinline__ void xcd_barrier_complete(unsigned* bar, unsigned x, unsigned& nloc, unsigned& nx) {
    const unsigned G = gridDim.x * gridDim.y * gridDim.z;
    unsigned sum, cnt, mine, sp = 0u;
    for (;;) {
        sum = 0u; cnt = 0u; mine = 0u;
#pragma unroll
        for (unsigned j = 0; j < 16; ++j) { const unsigned c = xb_ld(&bar[XB_XCNT(j)]); sum += c; cnt += (c > 0u) ? 1u : 0u; mine = (j == x) ? c : mine; }
        if (sum == G) break;
        __builtin_amdgcn_s_sleep(1);
        if ((++sp & 255u) == 0u) { if (xb_ld(&bar[XB_TMO])) break; if (sp > XB_SPIN_CAP) { atomicAdd(&bar[XB_TMO], 1u); break; } }
    }
    nloc = mine > 0u ? mine : 1u; nx = cnt > 0u ? cnt : 1u;
}

__device__ __forceinline__ void xcd_barrier(const XcdBarrier& b) {
    unsigned bx_ = b.x; asm volatile("" : "+s"(bx_));
    asm volatile("s_waitcnt vmcnt(0)" ::: "memory");
    __syncthreads();
    if (threadIdx.x == 0) {
        unsigned* bar = b.bar; asm volatile("" : "+s"(bar));
        __builtin_amdgcn_s_waitcnt(0);
        unsigned nloc = b.st[0], nx = b.st[1];
        if (nloc == 0u) { xcd_barrier_complete(bar, bx_, nloc, nx); b.st[0] = nloc; b.st[1] = nx; }
        const unsigned old = xb_add(&bar[XB_XSUB(bx_)], 1u);
        const unsigned gen = old / nloc;
        if (old + 1u == (gen + 1u) * nloc) {
            __builtin_amdgcn_fence(__ATOMIC_RELEASE, "agent");
            asm volatile("s_waitcnt vmcnt(0)" ::: "memory");
            const unsigned og = xb_add(&bar[XB_TOP], 1u);
            const unsigned tg = og / nx;
            if (og + 1u == (tg + 1u) * nx) xb_add(&bar[XB_TOPGEN], 1u);
            else XB_SPIN(xb_ld(&bar[XB_TOPGEN]) == tg, bar);
            __builtin_amdgcn_fence(__ATOMIC_ACQUIRE, "agent");
            xb_add(&bar[XB_XGEN(bx_)], 1u);
            asm volatile("s_waitcnt vmcnt(0)" ::: "memory");
        } else {
            XB_SPIN(xb_ld(&bar[XB_XGEN(bx_)]) == gen, bar);
            __builtin_amdgcn_fence(__ATOMIC_ACQUIRE, "agent");
            asm volatile("s_waitcnt vmcnt(0)" ::: "memory");
        }
    }
    __syncthreads();
}

__global__ void __launch_bounds__(512) mega_fwd(Params Pval) {
    extern __shared__ __attribute__((aligned(16))) unsigned char lds_raw[];
    LAS unsigned char* lds = (LAS unsigned char*)lds_raw;
    cg::grid_group grid = cg::this_grid();
    if (Pval.ws == nullptr) grid.sync();
    volatile LAS unsigned* bst = (volatile LAS unsigned*)(lds + pg8::STAGE_BYTES);
    if (threadIdx.x < 2) bst[threadIdx.x] = 0u;
    __syncthreads();
    XcdBarrier bar = xcd_barrier_post((unsigned*)(Pval.ws + WS_BAR), bst);
    prologue(kargs(), lds);
    xcd_barrier(bar);
#pragma unroll 1
    for (int l = 0; l < 2; ++l) {
        {
            KP P = kargs(); unsigned char* ws = P->ws; float* rss = (float*)(ws + WS_RSS);
            pg8::Gemm g{(const bf16_t*)(ws + WS_XB), (const bf16_t*)(ws + WS_WIN) + (size_t)l * DINP * DM, MT, DINP, DM}; pg8::StaticOrder S; S.init(MT, DINP, gridDim.x, blockIdx.x);
            EpiInProj E{(bf16_t*)(ws + WS_PJ), rss + (size_t)(2 * l) * MT, (const float*)(ws + WS_ROPE)};
            pg8::gemm_phase<EpiInProj, pg8::StaticOrder, true, true>(lds, g, S, E);
            { const int nfull = (MT / 256) * (DINP / 256) % (int)gridDim.x; if ((int)blockIdx.x >= nfull) copy_range(P, l, 0, CPY_R1, ((int)blockIdx.x - nfull) * 512 + opaque_tid(), ((int)gridDim.x - nfull) * 512); }
        }
        xcd_barrier(bar);
        phase2(kargs(), l, lds);
        xcd_barrier(bar);
        phase3(kargs(), l, lds);
        xcd_barrier(bar);
        {
            KP P = kargs(); unsigned char* ws = P->ws; float* rss = (float*)(ws + WS_RSS); float* X = (float*)(ws + WS_X);
            pg8::Gemm g{(const bf16_t*)(ws + WS_MIX), (const bf16_t*)(ws + WS_WOUT) + (size_t)l * DM * DM, SEQ, DM, DM}; pg8::StaticOrder S; S.init(SEQ, DM, gridDim.x, blockIdx.x);
            EpiResid E{l == 0 ? P->in[I_XP] : X, l == 0 ? P->in[I_XS] : X + (size_t)SEQ * DM, X, (bf16_t*)(ws + WS_XB), rss + (size_t)(2 * l + 1) * MT};
            pg8::gemm_phase<EpiResid, pg8::StaticOrder, true, true>(lds, g, S, E);
            sample_proj<DM>((const bf16_t*)(ws + WS_MIX), (const bf16_t*)(ws + WS_WOUT) + (size_t)l * DM * DM, l == 0 ? P->in[I_XS] : X + (size_t)SEQ * DM, X, (bf16_t*)(ws + WS_XB), rss + (size_t)(2 * l + 1) * MT, lds);
        }
        xcd_barrier(bar);
        {
            KP P = kargs(); unsigned char* ws = P->ws; float* rss = (float*)(ws + WS_RSS);
            pg8::Gemm g{(const bf16_t*)(ws + WS_XB), (const bf16_t*)(ws + WS_WGU) + (size_t)l * NGU * DM, MT, NGU, DM}; pg8::StaticOrder S; S.init(MT, NGU, gridDim.x, blockIdx.x);
            EpiGateUp E{(bf16_t*)(ws + WS_HB), rss + (size_t)(2 * l + 1) * MT};
            pg8::gemm_phase<EpiGateUp, pg8::StaticOrder, true, true>(lds, g, S, E);
            { const int nfull = (MT / 256) * (NGU / 256) % (int)gridDim.x; if ((int)blockIdx.x >= nfull) copy_range(P, l, CPY_R1, CPY_R2, ((int)blockIdx.x - nfull) * 512 + opaque_tid(), ((int)gridDim.x - nfull) * 512); }
        }
        xcd_barrier(bar);
        {
            KP P = kargs(); unsigned char* ws = P->ws; float* rss = (float*)(ws + WS_RSS); float* X = (float*)(ws + WS_X);
            pg8::Gemm g{(const bf16_t*)(ws + WS_HB), (const bf16_t*)(ws + WS_WDN) + (size_t)l * DM * DFF, SEQ, DM, DFF}; pg8::StaticOrder S; S.init(SEQ, DM, gridDim.x, blockIdx.x);
            EpiResid E{X, X + (size_t)SEQ * DM, X, (bf16_t*)(ws + WS_XB), rss + (size_t)(2 * l + 2) * MT};
            pg8::gemm_phase<EpiResid, pg8::StaticOrder, true, true>(lds, g, S, E);
            sample_proj<DFF>((const bf16_t*)(ws + WS_HB), (const bf16_t*)(ws + WS_WDN) + (size_t)l * DM * DFF, X + (size_t)SEQ * DM, X, (bf16_t*)(ws + WS_XB), rss + (size_t)(2 * l + 2) * MT, lds);
        }
        xcd_barrier(bar);
    }
    final_norm(kargs());
}

constexpr int LDS_BYTES = pg8::STAGE_BYTES + 256;

extern "C" void kernel_launch(void* const* d_in, const int* in_sizes, int n_in, void* d_out, int out_size, void* d_ws, size_t ws_size, hipStream_t stream) {
    static int grid = 0;
    if (grid == 0) {
        if (n_in != 23 || (size_t)out_size != OUT_TOTAL || ws_size < WS_END) { fprintf(stderr, "kernel_launch: unexpected shapes (n_in %d out %d ws %zu need %zu)\n", n_in, out_size, ws_size, (size_t)WS_END); grid = -1; return; }
        int dev = 0, cus = 0, per_cu = 0;
        hipGetDevice(&dev); hipDeviceGetAttribute(&cus, hipDeviceAttributeMultiprocessorCount, dev);
        hipFuncSetAttribute((const void*)mega_fwd, hipFuncAttributeMaxDynamicSharedMemorySize, LDS_BYTES);
        hipOccupancyMaxActiveBlocksPerMultiprocessor(&per_cu, (const void*)mega_fwd, 512, LDS_BYTES);
        if (per_cu < 1) { fprintf(stderr, "kernel_launch: occupancy query says %d blocks/CU\n", per_cu); per_cu = 1; }
        grid = 256;
        (void)hipGetLastError();
    }
    if (grid < 0) return;
    if (hipMemsetAsync((unsigned char*)d_ws + WS_BAR, 0, 16384, stream) != hipSuccess) { fprintf(stderr, "kernel_launch: memset of the barrier words failed\n"); return; }
    Params p{};
    for (int i = 0; i < 23; ++i) p.in[i] = (const float*)d_in[i];
    p.out = (float*)d_out; p.ws = (unsigned char*)d_ws;
    void* args[] = {&p};
    hipError_t e = hipLaunchCooperativeKernel((const void*)mega_fwd, dim3(grid), dim3(512), args, LDS_BYTES, stream);
    if (e != hipSuccess) fprintf(stderr, "cooperative launch failed: %s (grid %d)\n", hipGetErrorString(e), grid);
}
```

```cpp
#include <hip/hip_runtime.h>
#include <hip/hip_cooperative_groups.h>
#include <cstdio>
#include <cstdint>
namespace cg = cooperative_groups;
namespace pg8 {
#define PG8_LAS __attribute__((address_space(3)))
typedef unsigned short bf16_t;
typedef short bf16x8 __attribute__((ext_vector_type(8)));
typedef float f32x4 __attribute__((ext_vector_type(4)));
typedef unsigned u32x4 __attribute__((ext_vector_type(4)));
constexpr int BM = 256, BK = 64, HALF = 128, HTB = HALF * BK * 2  , STAGE_BYTES = 8 * HTB, NXCD = 8, WGM = 8;

__host__ __device__ __forceinline__ int lds_byte(int r, int c) { const int st = (r >> 4) * 2 + (c >> 5), rr = r & 15, cc = c & 31, ob = rr * 64 + cc * 2; return st * 1024 + (ob ^ (((ob >> 9) & 1) << 5)); }
__host__ __device__ __forceinline__ void stage_rc(int b, int& R, int& C) { const int st = b / 1024, sb = b % 1024, swz = sb ^ (((sb >> 9) & 1) << 5); R = (st >> 1) * 16 + swz / 64; C = (st & 1) * 32 + (swz % 64) / 2; }
__host__ __device__ __forceinline__ int perm32(int rho) { const int n = rho >> 4, i = rho & 15; return 8 * (i >> 2) + 4 * n + (i & 3); }

struct Unit { int pm, pn; };
struct Gemm { const bf16_t* A; const bf16_t* Bt; int M, N, K; };

struct StaticOrder {
    int nM, nN, nwg, G, c;
    __host__ __device__ void init(int M, int N, int G_, int c_) { nM = M / BM; nN = N / BM; nwg = nM * nN; G = G_; c = c_; }
    __host__ __device__ bool next(int i, Unit& u) const {
        const long L = (long)i * G + c; if (L >= nwg) return false;
        int wgid = (int)L; { const int q = nwg / NXCD, r = nwg % NXCD, xcd = wgid % NXCD, off = wgid / NXCD; wgid = (xcd < r ? xcd * (q + 1) : r * (q + 1) + (xcd - r) * q) + off; }
        const int nig = WGM * nN, gid = wgid / nig, fm = gid * WGM, gsz = (nM - fm) < WGM ? (nM - fm) : WGM;
        u.pm = fm + ((wgid % nig) % gsz); u.pn = (wgid % nig) / gsz; return true;
    }
    __device__ __forceinline__ void a_ready(const Unit&) const {}
    __device__ __forceinline__ void done(const Unit&) const {}
};

__device__ __forceinline__ unsigned cvt_pk_bf16(float lo, float hi) { unsigned r; asm volatile("v_cvt_pk_bf16_f32 %0, %1, %2" : "=v"(r) : "v"(lo), "v"(hi)); return r; }
template <class Epi, class Sched, bool ALIGN_EPI = false, bool SP2 = false>
__device__ __forceinline__ void gemm_phase(PG8_LAS unsigned char* lds, const Gemm g, const Sched& S, const Epi& E) {
    int tid_ = threadIdx.x; asm volatile("" : "+v"(tid_));
    const int tid = tid_, wid = __builtin_amdgcn_readfirstlane(tid >> 6), lane = tid & 63, wr = wid >> 2, wc = wid & 3, fr = lane & 15, fq = lane >> 4;
    const int K = g.K, nt = K / BK;
    unsigned voffA[2], voffB[2];
#pragma unroll
    for (int i = 0; i < 2; ++i) { int R, C; stage_rc(tid * 16 + i * 8192, R, C); const int Rb = Epi::PERM ? ((R & ~31) + perm32(R & 31)) : R;
        voffA[i] = (unsigned)(R * K + C) * 2u; voffB[i] = (unsigned)(Rb * K + C) * 2u; }
    const size_t kstep = (size_t)(BK * 2);
    const size_t hstep = (size_t)HALF * K * 2;
    const size_t tstep = 2 * hstep;
    const unsigned ldsw = (unsigned)wid * 1024u;
    const int aoff = lds_byte(wr * 64 + fr, fq * 8), boff = lds_byte(wc * 32 + fr, fq * 8);
#define PG8_SA(b, h) (((b) * 2 + (h)) * HTB)
#define PG8_SB(b, h) ((4 + (b) * 2 + (h)) * HTB)
#define PG8_STAGE(bufoff, gbase, voff) do { _Pragma("unroll") for (int _i = 0; _i < 2; ++_i) \
        __builtin_amdgcn_global_load_lds((const unsigned*)((const char*)(gbase) + (voff)[_i]), (PG8_LAS unsigned*)(lds + (bufoff) + ldsw + _i * 8192), 16, 0, 0); } while (0)
#define PG8_LDA(dst, b, h) do { _Pragma("unroll") for (int m = 0; m < 4; ++m) _Pragma("unroll") for (int k = 0; k < 2; ++k) dst[m][k] = *(const PG8_LAS bf16x8*)(lds + PG8_SA(b, h) + aoff + m * 2048 + k * 1024); } while (0)
#define PG8_LDB(dst, b, h) do { _Pragma("unroll") for (int n = 0; n < 2; ++n) _Pragma("unroll") for (int k = 0; k < 2; ++k) dst[n][k] = *(const PG8_LAS bf16x8*)(lds + PG8_SB(b, h) + boff + n * 2048 + k * 1024); } while (0)
#define PG8_MMA(ai, bj, At, Bt) do { __builtin_amdgcn_s_setprio(1); _Pragma("unroll") for (int m = 0; m < 4; ++m) _Pragma("unroll") for (int n = 0; n < 2; ++n) _Pragma("unroll") for (int k = 0; k < 2; ++k) \
        acc[ai][bj][m][n] = __builtin_amdgcn_mfma_f32_16x16x32_bf16(Bt[n][k], At[m][k], acc[ai][bj][m][n], 0, 0, 0); __builtin_amdgcn_s_setprio(0); } while (0)
#define PG8_WAIT_V(n) asm volatile("s_waitcnt vmcnt(" #n ")" ::: "memory")
#define PG8_WAIT_L(n) asm volatile("s_waitcnt lgkmcnt(" #n ")" ::: "memory")
#define PG8_BAR __builtin_amdgcn_s_barrier()
#define PG8_SCHED __builtin_amdgcn_sched_barrier(0)
    Unit cur, nxt; int ui = 0;
    if (!S.next(0, cur)) return;
    f32x4 acc[2][2][4][2];
#pragma unroll
    for (int a = 0; a < 2; ++a)
#pragma unroll
        for (int b = 0; b < 2; ++b)
#pragma unroll
            for (int m = 0; m < 4; ++m)
#pragma unroll
                for (int n = 0; n < 2; ++n) acc[a][b][m][n] = (f32x4){0.f, 0.f, 0.f, 0.f};
    bf16x8 At[4][2], B0[2][2], B1[2][2];
    const char* cA = (const char*)g.A + (size_t)cur.pm * tstep; const char* cB = (const char*)g.Bt + (size_t)cur.pn * tstep;
    S.a_ready(cur);
    if constexpr (SP2) {
        PG8_STAGE(PG8_SB(0, 0), cB, voffB); PG8_STAGE(PG8_SB(0, 1), cB + hstep, voffB); PG8_STAGE(PG8_SA(0, 0), cA, voffA); PG8_STAGE(PG8_SA(0, 1), cA + hstep, voffA);
        if (wr == 1) PG8_BAR;
        PG8_WAIT_V(2); PG8_BAR;
        PG8_STAGE(PG8_SB(1, 0), cB + kstep, voffB); PG8_STAGE(PG8_SA(1, 0), cA + kstep, voffA); PG8_STAGE(PG8_SB(1, 1), cB + hstep + kstep, voffB);
        PG8_WAIT_V(6); PG8_BAR;
    } else {
        PG8_STAGE(PG8_SB(0, 0), cB, voffB); PG8_STAGE(PG8_SA(0, 0), cA, voffA); PG8_STAGE(PG8_SB(0, 1), cB + hstep, voffB); PG8_STAGE(PG8_SA(0, 1), cA + hstep, voffA);
        if (wr == 1) PG8_BAR;
        PG8_WAIT_V(4); PG8_BAR;
        PG8_STAGE(PG8_SB(1, 0), cB + kstep, voffB); PG8_STAGE(PG8_SA(1, 0), cA + kstep, voffA); PG8_STAGE(PG8_SB(1, 1), cB + hstep + kstep, voffB);
        PG8_WAIT_V(6); PG8_BAR;
    }
    for (;;) {
        const bool has_next = S.next(ui + 1, nxt);
        const char* nA = has_next ? (const char*)g.A + (size_t)nxt.pm * tstep : cA; const char* nB = has_next ? (const char*)g.Bt + (size_t)nxt.pn * tstep : cB;
        for (int t = 0; t < nt; t += 2) {
            const bool last = (t == nt - 2);
            const char* a1 = cA + (size_t)(t + 1) * kstep;
            const char* a2 = last ? nA : cA + (size_t)(t + 2) * kstep; const char* b2 = last ? nB : cB + (size_t)(t + 2) * kstep;
            const char* a3 = a2 + kstep; const char* b3 = b2 + kstep;
            if (last && has_next) S.a_ready(nxt);
            if constexpr (SP2) {
            PG8_LDB(B0, 0, 0); PG8_LDB(B1, 0, 1); PG8_SCHED; PG8_LDA(At, 0, 0); PG8_STAGE(PG8_SA(1, 1), a1 + hstep, voffA);
            PG8_WAIT_V(8); PG8_WAIT_L(0); PG8_BAR; PG8_MMA(0, 0, At, B0); PG8_MMA(0, 1, At, B1); PG8_BAR; PG8_SCHED;
            PG8_LDA(At, 0, 1); PG8_STAGE(PG8_SB(0, 0), b2, voffB); PG8_STAGE(PG8_SB(0, 1), b2 + hstep, voffB); PG8_STAGE(PG8_SA(0, 0), a2, voffA);
            PG8_WAIT_V(8); PG8_WAIT_L(0); PG8_BAR; PG8_MMA(1, 0, At, B0); PG8_MMA(1, 1, At, B1); PG8_BAR; PG8_SCHED;
            PG8_LDB(B0, 1, 0); PG8_LDB(B1, 1, 1); PG8_SCHED; PG8_LDA(At, 1, 0); PG8_STAGE(PG8_SA(0, 1), a2 + hstep, voffA);
            PG8_WAIT_V(8); PG8_WAIT_L(0); PG8_BAR; PG8_MMA(0, 0, At, B0); PG8_MMA(0, 1, At, B1); PG8_BAR; PG8_SCHED;
            PG8_LDA(At, 1, 1); PG8_STAGE(PG8_SB(1, 0), b3, voffB); PG8_STAGE(PG8_SB(1, 1), b3 + hstep, voffB); PG8_STAGE(PG8_SA(1, 0), a3, voffA);
            PG8_WAIT_V(8); PG8_WAIT_L(0); PG8_BAR; PG8_MMA(1, 0, At, B0); PG8_MMA(1, 1, At, B1); PG8_BAR; PG8_SCHED;
            } else {
            PG8_LDB(B0, 0, 0); PG8_SCHED; PG8_LDA(At, 0, 0); PG8_STAGE(PG8_SA(1, 1), a1 + hstep, voffA);
            PG8_WAIT_L(8); PG8_BAR; PG8_WAIT_L(0); PG8_MMA(0, 0, At, B0); PG8_BAR; PG8_SCHED;
            PG8_LDB(B1, 0, 1); PG8_STAGE(PG8_SB(0, 0), b2, voffB);
            PG8_BAR; PG8_WAIT_L(0); PG8_MMA(0, 1, At, B1); PG8_BAR;
            PG8_LDA(At, 0, 1); PG8_STAGE(PG8_SA(0, 0), a2, voffA);
            PG8_BAR; PG8_WAIT_L(0); PG8_MMA(1, 0, At, B0); PG8_BAR; PG8_SCHED;
            PG8_STAGE(PG8_SB(0, 1), b2 + hstep, voffB);
            PG8_WAIT_V(6); PG8_BAR; PG8_MMA(1, 1, At, B1); PG8_BAR;
            PG8_LDB(B0, 1, 0); PG8_SCHED; PG8_LDA(At, 1, 0); PG8_STAGE(PG8_SA(0, 1), a2 + hstep, voffA);
            PG8_WAIT_L(8); PG8_BAR; PG8_WAIT_L(0); PG8_MMA(0, 0, At, B0); PG8_BAR; PG8_SCHED;
            PG8_LDB(B1, 1, 1); PG8_STAGE(PG8_SB(1, 0), b3, voffB);
            PG8_BAR; PG8_WAIT_L(0); PG8_MMA(0, 1, At, B1); PG8_BAR;
            PG8_LDA(At, 1, 1); PG8_STAGE(PG8_SA(1, 0), a3, voffA);
            PG8_BAR; PG8_WAIT_L(0); PG8_MMA(1, 0, At, B0); PG8_BAR; PG8_SCHED;
            PG8_STAGE(PG8_SB(1, 1), b3 + hstep, voffB);
            PG8_WAIT_V(6); PG8_BAR; PG8_MMA(1, 1, At, B1); PG8_BAR;
            }
        }
        if constexpr (ALIGN_EPI) { if (wr == 0) PG8_BAR; }
        if constexpr (!Epi::AFTER_DRAIN) { E(acc, cur, wr, wc, fr, fq); S.done(cur); }
        if (!has_next) break;
#pragma unroll
        for (int a = 0; a < 2; ++a)
#pragma unroll
            for (int b = 0; b < 2; ++b)
#pragma unroll
                for (int m = 0; m < 4; ++m)
#pragma unroll
                    for (int n = 0; n < 2; ++n) acc[a][b][m][n] = (f32x4){0.f, 0.f, 0.f, 0.f};
        cur = nxt; cA = nA; cB = nB; ++ui;
        if constexpr (ALIGN_EPI) { if (wr == 1) PG8_BAR; }
    }
    PG8_WAIT_V(0);
    if constexpr (!ALIGN_EPI) { if (wr == 0) PG8_BAR; }
    PG8_BAR;
    if constexpr (Epi::AFTER_DRAIN) { E.fused(acc, cur, wr, wc, fr, fq, lds, wid, lane); S.done(cur); }
#undef PG8_SA
#undef PG8_SB
#undef PG8_STAGE
#undef PG8_LDA
#undef PG8_LDB
#undef PG8_MMA
#undef PG8_WAIT_V
#undef PG8_WAIT_L
#undef PG8_BAR
#undef PG8_SCHED
}
}

using pg8::bf16_t; using pg8::bf16x8; using pg8::f32x4; using pg8::u32x4;
#define LAS __attribute__((address_space(3)))
typedef short s16x4 __attribute__((ext_vector_type(4)));
typedef unsigned u32x2 __attribute__((ext_vector_type(2)));
typedef float f32x2 __attribute__((ext_vector_type(2)));

constexpr int DM = 1024, SEQ = 16384, NSMP = 256, MT = SEQ + NSMP;
constexpr int DIN = 2176, DINP = 2304, DFF = 2816, NGU = 2 * DFF;
constexpr int C_Q = 0, C_K = 384, C_V = 768, C_U = 1152, C_XR = 1408, C_GT = 1792, PJP = 2176;
constexpr int NCH = MT / 64;
constexpr float EPS = 1e-6f;
constexpr float QSCALE = 0.125f * 1.4426950408889634f;

constexpr size_t OFF_YP = 0, OFF_YS = OFF_YP + (size_t)SEQ * DM, OFF_PWK = OFF_YS + (size_t)NSMP * DM, OFF_PWV = OFF_PWK + 2ull * 2048 * 384,
                 OFF_PPOOL = OFF_PWV + 2ull * 2048 * 384, OFF_PCONV = OFF_PPOOL + 2 * 15 * 256, OFF_PRG = OFF_PCONV + 2 * 3 * 384, OFF_SWK = OFF_PRG + 2 * 384,
                 OFF_SWV = OFF_SWK + 2ull * 32 * 2048 * 384, OFF_SPOOL = OFF_SWV + 2ull * 32 * 2048 * 384, OFF_SCONV = OFF_SPOOL + 2 * 32 * 15 * 256,
                 OFF_SRG = OFF_SCONV + 2 * 32 * 3 * 384, OUT_TOTAL = OFF_SRG + 2 * 32 * 384;

constexpr size_t al256(size_t x) { return (x + 255) & ~(size_t)255; }
constexpr size_t WS_WIN = 0;
constexpr size_t WS_WOUT = WS_WIN + al256(2ull * DINP * DM * 2);
constexpr size_t WS_WGU = WS_WOUT + al256(2ull * DM * DM * 2);
constexpr size_t WS_WDN = WS_WGU + al256(2ull * NGU * DM * 2);
constexpr size_t WS_WA = WS_WDN + al256(2ull * DM * DFF * 2);
constexpr size_t WS_WX = WS_WA + al256(2ull * 6 * 64 * 64 * 2);
constexpr size_t WS_WP = WS_WX + al256(2ull * 6 * 64 * 64 * 2);
constexpr size_t WS_ROPE = WS_WP + al256(2ull * 4 * 64 * 64 * 2);
constexpr size_t WS_RSS = WS_ROPE + al256(16392ull * 32 * 8);
constexpr size_t WS_XB = WS_RSS + al256(5ull * MT * 4);
constexpr size_t WS_PJ = WS_XB + al256((size_t)MT * DM * 2);
constexpr size_t WS_HL = WS_PJ + al256((size_t)MT * PJP * 2);
constexpr size_t WS_PC = WS_HL + al256((size_t)MT * 384 * 4);
constexpr size_t WS_CA = WS_PC + al256((size_t)MT * 384 * 4);
constexpr size_t WS_CH = WS_CA + al256((size_t)NCH * 384 * 4);
constexpr size_t WS_MIX = WS_CH + al256((size_t)NCH * 384 * 4);
constexpr size_t WS_X = WS_MIX + al256((size_t)MT * DM * 2);
constexpr size_t WS_HB = WS_X + al256((size_t)MT * DM * 4);
constexpr size_t WS_BAR = WS_HB + al256((size_t)MT * DFF * 2);
constexpr size_t WS_END = WS_BAR + 16384;

struct Params { const float* in[23]; float* out; unsigned char* ws; };
typedef const __attribute__((address_space(4))) Params* KP;
__device__ __forceinline__ KP kargs() { auto p = __builtin_amdgcn_kernarg_segment_ptr(); asm volatile("" : "+s"(p)); return (KP)p; }
enum { I_XP = 0, I_XS, I_CK, I_CV, I_SPOOL, I_SCONV, I_SRG, I_N1G, I_WIN, I_POOLW, I_POOLS, I_CONVW, I_CONVB, I_GAW, I_GAB, I_GXW, I_GXB, I_LAM, I_WOUT, I_N2G, I_WGU, I_WDN, I_FING };

__device__ __forceinline__ int opaque_tid() { int t = threadIdx.x; asm volatile("" : "+v"(t)); return t; }
__device__ __forceinline__ unsigned pk2(float lo, float hi) { return pg8::cvt_pk_bf16(lo, hi); }
__device__ __forceinline__ float bf_lo(unsigned w) { return __uint_as_float(w << 16); }
__device__ __forceinline__ float bf_hi(unsigned w) { return __uint_as_float(w & 0xffff0000u); }
__device__ __forceinline__ f32x4 bf4_to_f4(u32x2 w) { return (f32x4){bf_lo(w.x), bf_hi(w.x), bf_lo(w.y), bf_hi(w.y)}; }
__device__ __forceinline__ u32x2 f4_to_bf4(f32x4 v) { u32x2 w; w.x = pk2(v[0], v[1]); w.y = pk2(v[2], v[3]); return w; }
__device__ __forceinline__ float wave_sum(float v) {
#pragma unroll
    for (int o = 1; o < 64; o <<= 1) v += __shfl_xor(v, o);
    return v;
}
__device__ __forceinline__ float fexp2(float x) { return __builtin_amdgcn_exp2f(x); }
__device__ __forceinline__ float fsigmoid(float x) { return __builtin_amdgcn_rcpf(1.0f + fexp2(-1.4426950408889634f * x)); }
template <int N> __device__ __forceinline__ float dpp_row_shr_c(float v) { return __int_as_float(__builtin_amdgcn_update_dpp(0, __float_as_int(v), 0x110 + N, 0xf, 0xf, false)); }
__device__ __forceinline__ float dpp_row_shr(float v, int n) { return n == 1 ? dpp_row_shr_c<1>(v) : n == 2 ? dpp_row_shr_c<2>(v) : n == 4 ? dpp_row_shr_c<4>(v) : dpp_row_shr_c<8>(v); }
__device__ __forceinline__ float sigmoidf_(float x) { return 1.0f / (1.0f + __expf(-x)); }
__device__ __forceinline__ float gelu_tanh(float x) { const float z = 0.7978845608028654f * (x + 0.044715f * x * x * x); const float e = __expf(2.0f * z); return 0.5f * x * (2.0f - 2.0f / (e + 1.0f)); }

struct EpiInProj {
    static constexpr bool PERM = true, AFTER_DRAIN = false;
    bf16_t* PJ; const float* rss; const float* rope;
    __device__ __forceinline__ void operator()(const f32x4 (&acc)[2][2][4][2], const pg8::Unit& u, int wr, int wc, int fr_, int fq_) const {
        int fr = fr_, fq = fq_; asm volatile("" : "+v"(fr), "+v"(fq));
#pragma unroll
        for (int bj = 0; bj < 2; ++bj) {
            const int cb = u.pn * 256 + bj * 128;
            if (cb >= DIN) continue;
            const int c0 = cb + wc * 32 + fq * 8;
            if (cb < C_V) {
                const bool isk = cb >= C_K; const int sb = isk ? C_K : 0; const int o = c0 - sb; const int hb = o & ~63; const int j0 = (o & 63) >> 1;
                const float qs = isk ? 1.0f : QSCALE;
#pragma unroll
                for (int ai = 0; ai < 2; ++ai)
#pragma unroll
                    for (int m = 0; m < 4; ++m) {
                        const int row = u.pm * 256 + ai * 128 + wr * 64 + m * 16 + fr;
                        const int pos = row < SEQ ? row : SEQ + ((row - SEQ) & 7);
                        const f32x4 t0 = *(const f32x4*)(rope + ((size_t)pos * 32 + j0) * 2), t1 = *(const f32x4*)(rope + ((size_t)pos * 32 + j0) * 2 + 4);
                        const float rsv = rsqrtf(rss[row] * (1.0f / DM) + EPS) * qs;
                        const f32x4 v0 = acc[ai][bj][m][0] * rsv, v1 = acc[ai][bj][m][1] * rsv;
                        f32x4 o1, o2;
                        o1[0] = v0[0] * t0[0] - v0[1] * t0[1]; o2[0] = v0[1] * t0[0] + v0[0] * t0[1];
                        o1[1] = v0[2] * t0[2] - v0[3] * t0[3]; o2[1] = v0[3] * t0[2] + v0[2] * t0[3];
                        o1[2] = v1[0] * t1[0] - v1[1] * t1[1]; o2[2] = v1[1] * t1[0] + v1[0] * t1[1];
                        o1[3] = v1[2] * t1[2] - v1[3] * t1[3]; o2[3] = v1[3] * t1[2] + v1[2] * t1[3];
                        bf16_t* pj = PJ + (size_t)row * PJP + sb + hb + j0;
                        *(u32x2*)pj = f4_to_bf4(o1); *(u32x2*)(pj + 32) = f4_to_bf4(o2);
                    }
            } else {
#pragma unroll
                for (int ai = 0; ai < 2; ++ai)
#pragma unroll
                    for (int m = 0; m < 4; ++m) {
                        const int row = u.pm * 256 + ai * 128 + wr * 64 + m * 16 + fr;
                        const float rsv = rsqrtf(rss[row] * (1.0f / DM) + EPS);
                        const f32x4 v0 = acc[ai][bj][m][0] * rsv, v1 = acc[ai][bj][m][1] * rsv;
                        u32x4 w; w.x = pk2(v0[0], v0[1]); w.y = pk2(v0[2], v0[3]); w.z = pk2(v1[0], v1[1]); w.w = pk2(v1[2], v1[3]);
                        *(u32x4*)(PJ + (size_t)row * PJP + c0) = w;
                    }
            }
        }
    }
};

struct EpiResid {
    static constexpr bool PERM = false, AFTER_DRAIN = false;
    const float* base_p; const float* base_s; float* X; bf16_t* XB; float* rss_out; int store_x;
    __device__ __forceinline__ void operator()(const f32x4 (&acc)[2][2][4][2], const pg8::Unit& u, int wr, int wc, int fr, int fq) const {
#pragma unroll
        for (int ai = 0; ai < 2; ++ai)
#pragma unroll
            for (int m = 0; m < 4; ++m) {
                const int row = u.pm * 256 + ai * 128 + wr * 64 + m * 16 + fr;
                const float* b = row < SEQ ? base_p + (size_t)row * DM : base_s + (size_t)(row - SEQ) * DM;
                float ss = 0.f;
#pragma unroll
                for (int bj = 0; bj < 2; ++bj)
#pragma unroll
                    for (int n = 0; n < 2; ++n) {
                        const int col = u.pn * 256 + bj * 128 + wc * 32 + n * 16 + fq * 4;
                        const f32x4 x = *(const f32x4*)(b + col) + acc[ai][bj][m][n];
                        if (store_x) *(f32x4*)(X + (size_t)row * DM + col) = x;
                        *(u32x2*)(XB + (size_t)row * DM + col) = f4_to_bf4(x);
                        ss += (x[0] * x[0] + x[1] * x[1]) + (x[2] * x[2] + x[3] * x[3]);
                    }
                ss += __shfl_xor(ss, 16); ss += __shfl_xor(ss, 32);
                if (fq == 0) unsafeAtomicAdd(rss_out + row, ss);
            }
    }
};

struct EpiGateUp {
    static constexpr bool PERM = true, AFTER_DRAIN = false;
    bf16_t* HB; const float* rss;
    __device__ __forceinline__ void operator()(const f32x4 (&acc)[2][2][4][2], const pg8::Unit& u, int wr, int wc, int fr, int fq) const {
#pragma unroll
        for (int ai = 0; ai < 2; ++ai)
#pragma unroll
            for (int m = 0; m < 4; ++m) {
                const int row = u.pm * 256 + ai * 128 + wr * 64 + m * 16 + fr;
                const float rs = rsqrtf(rss[row] * (1.0f / DM) + EPS);
#pragma unroll
                for (int bj = 0; bj < 2; ++bj) {
                    const int hc = u.pn * 128 + bj * 64 + wc * 16 + fq * 4;
                    const f32x4 g = acc[ai][bj][m][0] * rs, up = acc[ai][bj][m][1] * rs;
                    f32x4 h;
#pragma unroll
                    for (int i = 0; i < 4; ++i) h[i] = g[i] * fsigmoid(g[i]) * up[i];
                    *(u32x2*)(HB + (size_t)row * DFF + hc) = f4_to_bf4(h);
                }
            }
    }
};

__device__ __forceinline__ int colmap_in(int n) { if (n >= DIN) return -1; if (n >= C_V) return n; const int sb = n >= C_K ? C_K : 0; const int o = n - sb; return sb + (o & ~63) + ((o & 63) >> 1) + 32 * (o & 1); }
__device__ __forceinline__ int colmap_gu(int n) { return ((n >> 3) << 2) + (n & 3) + DFF * ((n >> 2) & 1); }

__device__ __forceinline__ void transpose_item(const float* __restrict__ W, int K, int Nsrc, const float* __restrict__ kscale, bf16_t* WT, int item, int nblk, int mode, LAS float* scr, int lane) {
    const int kb = item / nblk, nb = item - kb * nblk, k0 = 64 * kb, n0 = 32 * nb;
    const int ch = lane & 7, rsub = lane >> 3, c4 = ch & 3, hi = ch >> 2;
    int srccol, x0, xs;
    bool zero = false;
    if (mode == 1 && n0 < C_V) { const int sb = n0 >= C_K ? C_K : 0, o = n0 - sb; srccol = sb + (o & ~63) + ((o & 63) >> 1) + 32 * hi + 4 * c4; x0 = 8 * c4 + hi; xs = 2; }
    else if (mode == 2) { srccol = (n0 >> 1) + DFF * hi + 4 * c4; x0 = 8 * c4 + 4 * hi; xs = 1; }
    else { srccol = n0 + 4 * ch; x0 = 4 * ch; xs = 1; zero = (mode == 1 && n0 >= DIN); }
    f32x4 v[8];
#pragma unroll
    for (int i = 0; i < 8; ++i) v[i] = zero ? (f32x4){0.f, 0.f, 0.f, 0.f} : *(const f32x4*)(W + (size_t)(k0 + 8 * i + rsub) * Nsrc + srccol);
#pragma unroll
    for (int i = 0; i < 8; ++i) {
        const int kk = 8 * i + rsub; const float sc = kscale ? kscale[k0 + kk] : 1.0f;
#pragma unroll
        for (int e = 0; e < 4; ++e) scr[kk * 33 + x0 + xs * e] = v[i][e] * sc;
    }
    asm volatile("s_waitcnt lgkmcnt(0)" ::: "memory");
    const int c = lane & 7;
#pragma unroll
    for (int j = 0; j < 4; ++j) {
        const int n = (lane >> 3) + 8 * j; const LAS float* s = scr + (8 * c) * 33 + n;
        u32x4 o; o.x = pk2(s[0 * 33], s[1 * 33]); o.y = pk2(s[2 * 33], s[3 * 33]); o.z = pk2(s[4 * 33], s[5 * 33]); o.w = pk2(s[6 * 33], s[7 * 33]);
        *(u32x4*)(WT + (size_t)(n0 + n) * K + k0 + 8 * c) = o;
    }
    asm volatile("s_waitcnt lgkmcnt(0)" ::: "memory");
}

__device__ __forceinline__ void prologue(KP P, LAS unsigned char* lds) {
    const int tid = opaque_tid(), lane = tid & 63, wave = tid >> 6;
    const int gw = blockIdx.x * 8 + wave, NGW = gridDim.x * 8;
    const int gt = blockIdx.x * 512 + tid, NGT = gridDim.x * 512;
    unsigned char* ws = P->ws;
    LAS float* scr = (LAS float*)(lds + wave * 8704);
    constexpr int I_IN = 16 * (DINP / 32), I_OUT = 16 * (DM / 32), I_GU = 16 * (NGU / 32), I_DN = (DFF / 64) * (DM / 32), I_L = I_IN + I_OUT + I_GU + I_DN;
    for (int it = gw; it < 2 * I_L; it += NGW) {
        const int l = it / I_L; int r = it - l * I_L;
        if (r < I_IN) { transpose_item(P->in[I_WIN] + (size_t)l * DM * DIN, DM, DIN, P->in[I_N1G] + l * DM, (bf16_t*)(ws + WS_WIN) + (size_t)l * DINP * DM, r, DINP / 32, 1, scr, lane); continue; } r -= I_IN;
        if (r < I_OUT) { transpose_item(P->in[I_WOUT] + (size_t)l * DM * DM, DM, DM, nullptr, (bf16_t*)(ws + WS_WOUT) + (size_t)l * DM * DM, r, DM / 32, 0, scr, lane); continue; } r -= I_OUT;
        if (r < I_GU) { transpose_item(P->in[I_WGU] + (size_t)l * DM * NGU, DM, NGU, P->in[I_N2G] + l * DM, (bf16_t*)(ws + WS_WGU) + (size_t)l * NGU * DM, r, NGU / 32, 2, scr, lane); continue; } r -= I_GU;
        transpose_item(P->in[I_WDN] + (size_t)l * DFF * DM, DFF, DM, nullptr, (bf16_t*)(ws + WS_WDN) + (size_t)l * DM * DFF, r, DM / 32, 0, scr, lane);
    }
    float* rss = (float*)(ws + WS_RSS);
    bf16_t* XB = (bf16_t*)(ws + WS_XB);
    for (int row0 = gw; row0 < MT; row0 += 4 * NGW) {
        f32x4 v[4][4];
#pragma unroll
        for (int r = 0; r < 4; ++r) { const int row = row0 + r * NGW; if (row < MT) { const float* xr = row < SEQ ? P->in[I_XP] + (size_t)row * DM : P->in[I_XS] + (size_t)(row - SEQ) * DM;
#pragma unroll
            for (int j = 0; j < 4; ++j) v[r][j] = *(const f32x4*)(xr + 4 * lane + 256 * j); } }
#pragma unroll
        for (int r = 0; r < 4; ++r) { const int row = row0 + r * NGW; if (row < MT) { float sm = 0.f;
#pragma unroll
            for (int j = 0; j < 4; ++j) { const f32x4 x = v[r][j]; sm += (x[0] * x[0] + x[1] * x[1]) + (x[2] * x[2] + x[3] * x[3]); *(u32x2*)(XB + (size_t)row * DM + 4 * lane + 256 * j) = f4_to_bf4(x); }
            sm = wave_sum(sm);
            if (lane == 0) rss[row] = sm; } }
    }
    for (int i = gt; i < 4 * MT; i += NGT) rss[MT + i] = 0.f;
    bf16_t* WA = (bf16_t*)(ws + WS_WA); bf16_t* WX = (bf16_t*)(ws + WS_WX); bf16_t* WP = (bf16_t*)(ws + WS_WP);
    for (int i = gt; i < 2 * 6 * 64 * 64; i += NGT) {
        const int slot = i & 63, d = (i >> 6) & 63, ln = i >> 12;
        const int kk = slot >> 5, q = (slot >> 3) & 3, e = slot & 7, c = 16 * (2 * kk + (e >> 2)) + 4 * q + (e & 3);
        const size_t src = ((size_t)ln * 64 + c) * 64 + d;
        WA[i] = (bf16_t)(pk2(P->in[I_GAW][src], 0.f) & 0xffffu); WX[i] = (bf16_t)(pk2(P->in[I_GXW][src], 0.f) & 0xffffu);
    }
    for (int i = gt; i < 2 * 4 * 64 * 64; i += NGT) {
        const int c = i & 63, d = (i >> 6) & 63, lg = i >> 12;
        WP[i] = (bf16_t)(pk2(P->in[I_POOLW][((size_t)lg * 64 + c) * 64 + d], 0.f) & 0xffffu);
    }
    float* rope = (float*)(ws + WS_ROPE);
    {
        const int j = gt & 31;
        const float inv = (float)exp2(-(double)j * (13.287712379549449 / 32.0));
        for (int pos = gt >> 5; pos < 16392; pos += NGT >> 5) {
            const float ang = (float)pos * inv;
            double rev = (double)ang * 0.15915494309189535; rev -= floor(rev);
            const float rf = (float)rev;
            *(f32x2*)(rope + 2 * ((size_t)pos * 32 + j)) = (f32x2){__builtin_amdgcn_cosf(rf), __builtin_amdgcn_sinf(rf)};
        }
    }
}

__device__ __forceinline__ void pool_row8(KP P, const bf16_t* PJ, int l, int R, int k, int ch, float (&v)[8]) {
    if (R < SEQ) {
        const int rr = R - k;
        if (rr < 0) {
#pragma unroll
            for (int i = 0; i < 8; ++i) v[i] = 0.f;
            return; }
        const u32x4 w = *(const u32x4*)(PJ + (size_t)rr * PJP + C_U + ch);
        v[0] = bf_lo(w.x); v[1] = bf_hi(w.x); v[2] = bf_lo(w.y); v[3] = bf_hi(w.y); v[4] = bf_lo(w.z); v[5] = bf_hi(w.z); v[6] = bf_lo(w.w); v[7] = bf_hi(w.w);
    } else {
        const int si = R - SEQ, b = si >> 3, t = si & 7, tk = t - k;
        if (tk >= 0) {
            const u32x4 w = *(const u32x4*)(PJ + (size_t)(SEQ + 8 * b + tk) * PJP + C_U + ch);
            v[0] = bf_lo(w.x); v[1] = bf_hi(w.x); v[2] = bf_lo(w.y); v[3] = bf_hi(w.y); v[4] = bf_lo(w.z); v[5] = bf_hi(w.z); v[6] = bf_lo(w.w); v[7] = bf_hi(w.w);
        } else {
            const float* s = P->in[I_SPOOL] + (((size_t)l * 32 + b) * 15 + (15 + tk)) * 256 + ch;
            const f32x4 a = *(const f32x4*)s, c = *(const f32x4*)(s + 4);
            v[0] = a[0]; v[1] = a[1]; v[2] = a[2]; v[3] = a[3]; v[4] = c[0]; v[5] = c[1]; v[6] = c[2]; v[7] = c[3];
        }
    }
}

constexpr int TLP = 136;
__device__ __forceinline__ void pool_task(KP P, int l, int task, int lane, LAS unsigned char* wl) {
    const int g = task & 3, T0 = (task >> 2) * 64, w = 2 << g, fr = lane & 15, fq = lane >> 4;
    const bool smp = T0 >= SEQ;
    const bf16_t* PJ = (const bf16_t*)(P->ws + WS_PJ); bf16_t* MIX = (bf16_t*)(P->ws + WS_MIX);
    const bf16_t* WP = (const bf16_t*)(P->ws + WS_WP) + (size_t)(l * 4 + g) * 4096;
    if (!smp) {
#pragma unroll
        for (int i = 0; i < 10; ++i) {
            const int rr = 8 * i + (lane >> 3), gr = T0 - 15 + rr;
            u32x4 v = (u32x4){0u, 0u, 0u, 0u};
            if (rr < 79 && gr >= 0) v = *(const u32x4*)(PJ + (size_t)gr * PJP + C_U + 64 * g + 8 * (lane & 7));
            if (rr < 79) *(LAS u32x4*)(wl + rr * TLP + 16 * (lane & 7)) = v;
        }
    }
    bf16x8 af[4][2];
#pragma unroll
    for (int dt = 0; dt < 4; ++dt)
#pragma unroll
        for (int kk = 0; kk < 2; ++kk) af[dt][kk] = *(const bf16x8*)(WP + (16 * dt + fr) * 64 + 32 * kk + 8 * fq);
    f32x4 sc[4];
#pragma unroll
    for (int dt = 0; dt < 4; ++dt) sc[dt] = *(const f32x4*)(P->in[I_POOLS] + l * 256 + 64 * g + 16 * dt + 4 * fq);
#pragma unroll 1
    for (int tt = 0; tt < 4; ++tt) {
        const int R = T0 + 16 * tt + fr;
        const int pos1 = R < SEQ ? R + 1 : SEQ + 1;
        const float rc = 1.0f / (float)(pos1 < w ? pos1 : w);
        bf16x8 bfr[2];
#pragma unroll
        for (int kk = 0; kk < 2; ++kk) {
            float s[8], u0[8];
            if (!smp) {
                const LAS unsigned char* rp = wl + (15 + 16 * tt + fr) * TLP + 2 * (32 * kk + 8 * fq);
                { const u32x4 x = *(const LAS u32x4*)rp; u0[0] = bf_lo(x.x); u0[1] = bf_hi(x.x); u0[2] = bf_lo(x.y); u0[3] = bf_hi(x.y); u0[4] = bf_lo(x.z); u0[5] = bf_hi(x.z); u0[6] = bf_lo(x.w); u0[7] = bf_hi(x.w); }
#pragma unroll
                for (int i = 0; i < 8; ++i) s[i] = u0[i];
                for (int k = 1; k < w; ++k) {
                    const u32x4 x = *(const LAS u32x4*)(rp - k * TLP);
                    s[0] += bf_lo(x.x); s[1] += bf_hi(x.x); s[2] += bf_lo(x.y); s[3] += bf_hi(x.y); s[4] += bf_lo(x.z); s[5] += bf_hi(x.z); s[6] += bf_lo(x.w); s[7] += bf_hi(x.w);
                }
            } else {
                const int ch = 64 * g + 32 * kk + 8 * fq;
                pool_row8(P, PJ, l, R, 0, ch, u0);
#pragma unroll
                for (int i = 0; i < 8; ++i) s[i] = u0[i];
                for (int k = 1; k < w; ++k) {
                    float v[8]; pool_row8(P, PJ, l, R, k, ch, v);
#pragma unroll
                    for (int i = 0; i < 8; ++i) s[i] += v[i];
                }
            }
            u32x4 pw;
            pw.x = pk2(s[0] * rc - u0[0], s[1] * rc - u0[1]); pw.y = pk2(s[2] * rc - u0[2], s[3] * rc - u0[3]);
            pw.z = pk2(s[4] * rc - u0[4], s[5] * rc - u0[5]); pw.w = pk2(s[6] * rc - u0[6], s[7] * rc - u0[7]);
            bfr[kk] = __builtin_bit_cast(bf16x8, pw);
        }
#pragma unroll
        for (int dt = 0; dt < 4; ++dt) {
            f32x4 y = (f32x4){0.f, 0.f, 0.f, 0.f};
            y = __builtin_amdgcn_mfma_f32_16x16x32_bf16(af[dt][0], bfr[0], y, 0, 0, 0);
            y = __builtin_amdgcn_mfma_f32_16x16x32_bf16(af[dt][1], bfr[1], y, 0, 0, 0);
            y = y * sc[dt];
            *(u32x2*)(MIX + (size_t)R * DM + 384 + 64 * g + 16 * dt + 4 * fq) = f4_to_bf4(y);
        }
    }
}

__device__ __forceinline__ void rglru_local_task(KP P, int l, int task, int lane, LAS unsigned char* wl) {
    const int c64 = task / 6, n = task - 6 * c64, T0 = c64 * 64, fr = lane & 15, fq = lane >> 4;
    const bool smp = T0 >= SEQ;
    const bf16_t* PJ = (const bf16_t*)(P->ws + WS_PJ);
    float* HL = (float*)(P->ws + WS_HL); float* PC = (float*)(P->ws + WS_PC);
    const bf16_t* WA = (const bf16_t*)(P->ws + WS_WA) + (size_t)(l * 6 + n) * 4096; const bf16_t* WX = (const bf16_t*)(P->ws + WS_WX) + (size_t)(l * 6 + n) * 4096;
    LAS float* cst = (LAS float*)(wl + 12288);
    if (!smp) {
#pragma unroll
        for (int i = 0; i < 9; ++i) {
            const int rr = 8 * i + (lane >> 3), gr = T0 - 3 + rr;
            u32x4 v = (u32x4){0u, 0u, 0u, 0u};
            if (rr < 67 && gr >= 0) v = *(const u32x4*)(PJ + (size_t)gr * PJP + C_XR + 64 * n + 8 * (lane & 7));
            if (rr < 67) *(LAS u32x4*)(wl + rr * TLP + 16 * (lane & 7)) = v;
        }
    } else {
#pragma unroll 1
        for (int i = 0; i < 11; ++i) {
            const int rr = 8 * i + (lane >> 3), bb = rr / 11, k = rr - 11 * bb, b = ((T0 - SEQ) >> 3) + bb, c8 = 64 * n + 8 * (lane & 7);
            u32x4 v;
            if (k < 3) { const float* sp = P->in[I_SCONV] + (((size_t)l * 32 + b) * 3 + k) * 384 + c8; const f32x4 a = *(const f32x4*)sp, c = *(const f32x4*)(sp + 4);
                v.x = pk2(a[0], a[1]); v.y = pk2(a[2], a[3]); v.z = pk2(c[0], c[1]); v.w = pk2(c[2], c[3]); }
            else v = *(const u32x4*)(PJ + (size_t)(SEQ + 8 * b + (k - 3)) * PJP + C_XR + c8);
            *(LAS u32x4*)(wl + rr * TLP + 16 * (lane & 7)) = v;
        }
    }
    {
        const int ch = l * 384 + 64 * n + lane;
#pragma unroll
        for (int j = 0; j < 4; ++j) cst[j * 64 + lane] = P->in[I_CONVW][(size_t)l * 3 * 384 + j * 384 + ch];
        cst[4 * 64 + lane] = P->in[I_CONVB][ch]; cst[5 * 64 + lane] = P->in[I_GAB][ch]; cst[6 * 64 + lane] = P->in[I_GXB][ch];
        cst[7 * 64 + lane] = -log1pf(__expf(-P->in[I_LAM][ch]));
    }
    __builtin_amdgcn_sched_barrier(0);
    bf16x8 wa[4][2], wx[4][2];
#pragma unroll
    for (int dt = 0; dt < 4; ++dt)
#pragma unroll
        for (int kk = 0; kk < 2; ++kk) { wa[dt][kk] = *(const bf16x8*)(WA + (16 * dt + fr) * 64 + 32 * kk + 8 * fq); wx[dt][kk] = *(const bf16x8*)(WX + (16 * dt + fr) * 64 + 32 * kk + 8 * fq); }
    f32x4 Pc[4], Hc[4];
#pragma unroll
    for (int dt = 0; dt < 4; ++dt) { Pc[dt] = (f32x4){1.f, 1.f, 1.f, 1.f}; Hc[dt] = (f32x4){0.f, 0.f, 0.f, 0.f}; }
    const int segm = smp ? 7 : 15;
#pragma unroll 1
    for (int tt = 0; tt < 4; ++tt) {
        const int ti = 16 * tt + fr, R = T0 + ti;
        const int trow = smp ? (ti >> 3) * 11 + (ti & 7) : ti;
        f32x4 xc[4];
#pragma unroll
        for (int dt = 0; dt < 4; ++dt) {
            const int cl = 16 * dt + 4 * fq;
            f32x4 a = *(const LAS f32x4*)(cst + 4 * 64 + cl);
#pragma unroll
            for (int j = 0; j < 4; ++j) a += *(const LAS f32x4*)(cst + j * 64 + cl) * bf4_to_f4(*(const LAS u32x2*)(wl + (trow + j) * TLP + 2 * cl));
            xc[dt] = a;
        }
        bf16x8 bfr[2];
#pragma unroll
        for (int kk = 0; kk < 2; ++kk) { u32x4 pw; pw.x = pk2(xc[2 * kk][0], xc[2 * kk][1]); pw.y = pk2(xc[2 * kk][2], xc[2 * kk][3]); pw.z = pk2(xc[2 * kk + 1][0], xc[2 * kk + 1][1]); pw.w = pk2(xc[2 * kk + 1][2], xc[2 * kk + 1][3]); bfr[kk] = __builtin_bit_cast(bf16x8, pw); }
#pragma unroll
        for (int dt = 0; dt < 4; ++dt) {
            const int cl = 16 * dt + 4 * fq, ch = 64 * n + cl;
            f32x4 ra = (f32x4){0.f, 0.f, 0.f, 0.f}, ia = (f32x4){0.f, 0.f, 0.f, 0.f};
            ra = __builtin_amdgcn_mfma_f32_16x16x32_bf16(wa[dt][0], bfr[0], ra, 0, 0, 0); ra = __builtin_amdgcn_mfma_f32_16x16x32_bf16(wa[dt][1], bfr[1], ra, 0, 0, 0);
            ia = __builtin_amdgcn_mfma_f32_16x16x32_bf16(wx[dt][0], bfr[0], ia, 0, 0, 0); ia = __builtin_amdgcn_mfma_f32_16x16x32_bf16(wx[dt][1], bfr[1], ia, 0, 0, 0);
            const f32x4 ba = *(const LAS f32x4*)(cst + 5 * 64 + cl), bx = *(const LAS f32x4*)(cst + 6 * 64 + cl), ls = *(const LAS f32x4*)(cst + 7 * 64 + cl);
            f32x4 A, B;
#pragma unroll
            for (int i = 0; i < 4; ++i) {
                const float r = fsigmoid(ra[i] + ba[i]), ig = fsigmoid(ia[i] + bx[i]);
                const float a = fexp2(11.541560327111707f * r * ls[i]);
                A[i] = a; B[i] = __builtin_amdgcn_sqrtf(fmaxf(1.0f - a * a, 0.f)) * ig * xc[dt][i];
            }
#pragma unroll
            for (int off = 1; off < 16; off <<= 1) {
                if (off == 8 && smp) break;
                const bool cnd = (fr & segm) >= off;
#pragma unroll
                for (int i = 0; i < 4; ++i) {
                    const float ap = dpp_row_shr(A[i], off), bp = dpp_row_shr(B[i], off);
                    if (cnd) { B[i] = A[i] * bp + B[i]; A[i] = A[i] * ap; }
                }
            }
            const f32x4 h = B + A * Hc[dt], p = A * Pc[dt];
            *(f32x4*)(HL + (size_t)R * 384 + ch) = h; *(f32x4*)(PC + (size_t)R * 384 + ch) = p;
            if (!smp) {
#pragma unroll
                for (int i = 0; i < 4; ++i) { Hc[dt][i] = __shfl(h[i], (lane & 48) | 15); Pc[dt][i] = __shfl(p[i], (lane & 48) | 15); }
            }
        }
    }
    if (!smp && fr == 0) {
#pragma unroll
        for (int dt = 0; dt < 4; ++dt) {
            const int ch = 64 * n + 16 * dt + 4 * fq;
            *(f32x4*)((float*)(P->ws + WS_CA) + (size_t)c64 * 384 + ch) = Pc[dt]; *(f32x4*)((float*)(P->ws + WS_CH) + (size_t)c64 * 384 + ch) = Hc[dt];
        }
    }
}

__device__ __forceinline__ void rglru_fix_task(KP P, int l, int task, LAS unsigned char* lds) {
    const int tid = opaque_tid(), c = task / 3, cg_ = task - 3 * c, chl = tid & 127, seg = tid >> 7, ch = 128 * cg_ + chl;
    const float* CA = (const float*)(P->ws + WS_CA); const float* CH = (const float*)(P->ws + WS_CH);
    const float* HL = (const float*)(P->ws + WS_HL); const float* PC = (const float*)(P->ws + WS_PC);
    const bf16_t* PJ = (const bf16_t*)(P->ws + WS_PJ); bf16_t* MIX = (bf16_t*)(P->ws + WS_MIX);
    LAS float* sA = (LAS float*)lds; LAS float* sH = sA + 512;
    const int T0 = c * 64 + seg * 16;
    float hl[16], pc[16]; unsigned short gg[16];
#pragma unroll
    for (int i = 0; i < 16; ++i) { const int R = T0 + i; hl[i] = HL[(size_t)R * 384 + ch]; pc[i] = PC[(size_t)R * 384 + ch]; gg[i] = PJ[(size_t)R * PJP + C_GT + ch]; }
    float carry = 0.f;
    {
        const int q = (c + 3) >> 2, k0 = seg * q, k1 = (k0 + q) < c ? (k0 + q) : c;
        float a = 1.f, h = 0.f;
        for (int kb_ = k0; kb_ < k1; kb_ += 32) {
            float ak[32], hk[32];
#pragma unroll
            for (int u_ = 0; u_ < 32; ++u_) { const int k = (kb_ + u_) < k1 ? (kb_ + u_) : (k1 - 1); ak[u_] = CA[(size_t)k * 384 + ch]; hk[u_] = CH[(size_t)k * 384 + ch]; }
#pragma unroll
            for (int u_ = 0; u_ < 32; ++u_) if (kb_ + u_ < k1) { h = ak[u_] * h + hk[u_]; a *= ak[u_]; }
        }
        sA[seg * 128 + chl] = a; sH[seg * 128 + chl] = h;
        __syncthreads();
#pragma unroll
        for (int s = 0; s < 4; ++s) carry = sA[s * 128 + chl] * carry + sH[s * 128 + chl];
    }
#pragma unroll
    for (int i = 0; i < 16; ++i) {
        const int R = T0 + i;
        const float h = hl[i] + pc[i] * carry;
        const float g = __uint_as_float((unsigned)gg[i] << 16);
        const float y = h * gelu_tanh(g);
        MIX[(size_t)R * DM + 640 + ch] = (bf16_t)(pk2(y, 0.f) & 0xffffu);
        if (R == SEQ - 1) P->out[OFF_PRG + l * 384 + ch] = h;
    }
    __syncthreads();
}
__device__ __forceinline__ void rglru_fix_sample(KP P, int l) {
    const int gt = blockIdx.x * 512 + opaque_tid();
    if (gt >= NSMP * 384) return;
    const int si = gt / 384, ch = gt - si * 384, R = SEQ + si, b = si >> 3;
    const float h = ((const float*)(P->ws + WS_HL))[(size_t)R * 384 + ch] + ((const float*)(P->ws + WS_PC))[(size_t)R * 384 + ch] * P->in[I_SRG][((size_t)l * 32 + b) * 384 + ch];
    const float g = __uint_as_float((unsigned)((const bf16_t*)(P->ws + WS_PJ))[(size_t)R * PJP + C_GT + ch] << 16);
    ((bf16_t*)(P->ws + WS_MIX))[(size_t)R * DM + 640 + ch] = (bf16_t)(pk2(h * gelu_tanh(g), 0.f) & 0xffffu);
    if ((si & 7) == 7) P->out[OFF_SRG + ((size_t)l * 32 + b) * 384 + ch] = h;
}

__device__ __forceinline__ s16x4 vtr(const LAS unsigned char* p) { return __builtin_bit_cast(s16x4, __builtin_amdgcn_ds_read_tr16_b64_v4i16((LAS s16x4*)p)); }

constexpr int VRP = 144;
constexpr int ATT_STEPS = 23;
__device__ __forceinline__ void att_step_info(int st, int& sh, int& s) { if (st < 12) { sh = 0; s = st; } else if (st < 18) { sh = 2; s = st - 12; } else { sh = 4; s = st - 18; } }

struct AttKV { bf16x8 k[2][2]; u32x4 v[4]; };
__device__ __forceinline__ void att_load(AttKV& b, int st, int p0, int fr, int lane, const bf16_t* Kb, const bf16_t* Vb) {
    int sh, s; att_step_info(st, sh, s);
    const int kbase = p0 - (128 << sh);
#pragma unroll
    for (int kt = 0; kt < 2; ++kt) { int pk = kbase + ((32 * s + 16 * kt + fr) << sh); pk = pk < 0 ? 0 : (pk > MT - 1 ? MT - 1 : pk);
        b.k[kt][0] = *(const bf16x8*)(Kb + (size_t)pk * PJP); b.k[kt][1] = *(const bf16x8*)(Kb + (size_t)pk * PJP + 32); }
    int pv = kbase + ((32 * s + (lane >> 1)) << sh); pv = pv < 0 ? 0 : (pv > MT - 1 ? MT - 1 : pv);
#pragma unroll
    for (int i = 0; i < 4; ++i) b.v[i] = *(const u32x4*)(Vb + (size_t)pv * PJP + 8 * i);
}
__device__ __forceinline__ void att_compute(const AttKV& b, int st, int p0, int fr, int fq, const bf16x8 qf0, const bf16x8 qf1, float& m, float& lsum, f32x4 (&o)[4],
                                            LAS unsigned char* vw, const LAS unsigned char* vr) {
    int sh, s; att_step_info(st, sh, s);
    const int kbase = p0 - (128 << sh);
    f32x4 sc[2];
#pragma unroll
    for (int kt = 0; kt < 2; ++kt) {
        sc[kt] = __builtin_amdgcn_mfma_f32_16x16x32_bf16(b.k[kt][0], qf0, (f32x4){0.f, 0.f, 0.f, 0.f}, 0, 0, 0);
        sc[kt] = __builtin_amdgcn_mfma_f32_16x16x32_bf16(b.k[kt][1], qf1, sc[kt], 0, 0, 0);
    }
    const int e0 = ((16 >> sh) * fr) + 128 - (32 * s + 4 * fq);
    const unsigned emax = (unsigned)min(128, (p0 + 16 * fr) >> sh);
    float mx = -INFINITY;
#pragma unroll
    for (int kt = 0; kt < 2; ++kt)
#pragma unroll
        for (int i = 0; i < 4; ++i) {
            const bool ok = (unsigned)(e0 - 16 * kt - i) <= emax;
            sc[kt][i] = ok ? sc[kt][i] : -INFINITY;
            mx = fmaxf(mx, sc[kt][i]);
        }
    {
        const auto r16 = __builtin_amdgcn_permlane16_swap(__float_as_uint(mx), __float_as_uint(mx), false, false);
        mx = fmaxf(__uint_as_float(r16[0]), __uint_as_float(r16[1]));
        const auto r32 = __builtin_amdgcn_permlane32_swap(__float_as_uint(mx), __float_as_uint(mx), false, false);
        mx = fmaxf(__uint_as_float(r32[0]), __uint_as_float(r32[1]));
    }
    const float mn = fmaxf(m, mx), al = fexp2(m - mn);
    m = mn;
    float ps = 0.f;
#pragma unroll
    for (int kt = 0; kt < 2; ++kt)
#pragma unroll
        for (int i = 0; i < 4; ++i) { sc[kt][i] = fexp2(sc[kt][i] - mn); ps += sc[kt][i]; }
    lsum = lsum * al + ps;
    u32x4 pw; pw.x = pk2(sc[0][0], sc[0][1]); pw.y = pk2(sc[0][2], sc[0][3]); pw.z = pk2(sc[1][0], sc[1][1]); pw.w = pk2(sc[1][2], sc[1][3]);
    const bf16x8 pb8 = __builtin_bit_cast(bf16x8, pw);
#pragma unroll
    for (int i = 0; i < 4; ++i) *(LAS u32x4*)(vw + 16 * i) = b.v[i];
#pragma unroll
    for (int dt = 0; dt < 4; ++dt) {
        const s16x4 lo = vtr(vr + dt * 32), hi = vtr(vr + 16 * VRP + dt * 32);
        const bf16x8 vf = __builtin_shufflevector(lo, hi, 0, 1, 2, 3, 4, 5, 6, 7);
        o[dt] = o[dt] * al;
        o[dt] = __builtin_amdgcn_mfma_f32_16x16x32_bf16(vf, pb8, o[dt], 0, 0, 0);
    }
}

constexpr int CPY_SEG = 2040 * 384 / 4, CPY_KV = 32 * CPY_SEG, CPY_TOT = 2 * CPY_KV;
__device__ __forceinline__ void cpy_addr(KP P, int l, int i, const f32x4*& src, f32x4*& dst) {
    const int kv = i >= CPY_KV, r = i - kv * CPY_KV, b = r / CPY_SEG, off = r - b * CPY_SEG;
    const float* ck_ = P->in[I_CK]; const float* cv_ = P->in[I_CV];
    src = (const f32x4*)((kv ? cv_ : ck_) + (((size_t)l * 32 + b) * 2048 + 8) * 384) + off;
    dst = (f32x4*)(P->out + (kv ? OFF_SWV : OFF_SWK) + ((size_t)l * 32 + b) * 2048 * 384) + off;
}
constexpr int CPY_R1 = (int)(0.45 * CPY_TOT) & ~63, CPY_R2 = (int)(0.65 * CPY_TOT) & ~63;
__device__ __forceinline__ void copy_range(KP P, int l, int lo, int hi, int part, int nparts) {
    for (int i0 = lo + part; i0 < hi; i0 += 8 * nparts) {
        f32x4 v[8];
#pragma unroll
        for (int u = 0; u < 8; ++u) { const int i = i0 + u * nparts; if (i < hi) { const f32x4* sp; f32x4* dp; cpy_addr(P, l, i, sp, dp); v[u] = __builtin_nontemporal_load(sp); } }
#pragma unroll
        for (int u = 0; u < 8; ++u) { const int i = i0 + u * nparts; if (i < hi) { const f32x4* sp; f32x4* dp; cpy_addr(P, l, i, sp, dp); __builtin_nontemporal_store(v[u], dp); } }
    }
}
__device__ __forceinline__ void attn_tile(KP P, int l, int wt, int gw, int NGW, int tk, int lane, LAS unsigned char* vl) {
    const int r = wt & 15, hh = (wt >> 4) % 6, pb = wt / 96, p0 = pb * 256 + r, fr = lane & 15, fq = lane >> 4;
    const bf16_t* PJ = (const bf16_t*)(P->ws + WS_PJ); bf16_t* MIX = (bf16_t*)(P->ws + WS_MIX);
    __builtin_amdgcn_s_waitcnt(0);
    const bf16_t* qp = PJ + (size_t)(p0 + 16 * fr) * PJP + C_Q + 64 * hh + 8 * fq;
    const bf16x8 qf0 = *(const bf16x8*)qp, qf1 = *(const bf16x8*)(qp + 32);
    const bf16_t* Kb = PJ + C_K + 64 * hh + 8 * fq;
    const bf16_t* Vb = PJ + C_V + 64 * hh + 32 * (lane & 1);
    float m = -1e30f, lsum = 0.f;
    f32x4 o[4];
#pragma unroll
    for (int dt = 0; dt < 4; ++dt) o[dt] = (f32x4){0.f, 0.f, 0.f, 0.f};
    LAS unsigned char* vw = vl + (lane >> 1) * VRP + (lane & 1) * 64;
    const LAS unsigned char* vr = vl + (4 * fq + (fr >> 2)) * VRP + (fr & 3) * 8;
    AttKV b0, b1, b2;
    att_load(b0, 0, p0, fr, lane, Kb, Vb); att_load(b1, 1, p0, fr, lane, Kb, Vb);
#pragma unroll 1
    for (int st = 0; st < 24; st += 3) {
        att_load(b2, st + 2, p0, fr, lane, Kb, Vb);
        att_compute(b0, st, p0, fr, fq, qf0, qf1, m, lsum, o, vw, vr);
        att_load(b0, st + 3 < 24 ? st + 3 : 23, p0, fr, lane, Kb, Vb);
        att_compute(b1, st + 1, p0, fr, fq, qf0, qf1, m, lsum, o, vw, vr);
        att_load(b1, st + 4 < 24 ? st + 4 : 23, p0, fr, lane, Kb, Vb);
        att_compute(b2, st + 2, p0, fr, fq, qf0, qf1, m, lsum, o, vw, vr);
    }
    lsum += __shfl_xor(lsum, 16); lsum += __shfl_xor(lsum, 32);
    const float inv = 1.0f / lsum;
    bf16_t* op = MIX + (size_t)(p0 + 16 * fr) * DM + 64 * hh + 4 * fq;
#pragma unroll
    for (int dt = 0; dt < 4; ++dt) *(u32x2*)(op + 16 * dt) = f4_to_bf4(o[dt] * inv);
}

__device__ __forceinline__ void sattn_block_task(KP P, int l, int task, LAS unsigned char* lds) {
    const int tid = opaque_tid(), lane = tid & 63, wave = tid >> 6, l32 = lane & 31, half = lane >> 5;
    const int b = task >> 3, t = task & 7, row = SEQ + task;
    const bf16_t* PJ = (const bf16_t*)(P->ws + WS_PJ); bf16_t* MIX = (bf16_t*)(P->ws + WS_MIX);
    f32x4 q[3];
#pragma unroll
    for (int i = 0; i < 3; ++i) q[i] = bf4_to_f4(*(const u32x2*)(PJ + (size_t)row * PJP + C_Q + 4 * (l32 + 32 * i)));
    const float* ck = P->in[I_CK] + ((size_t)l * 32 + b) * 2048 * 384 + 4 * l32;
    const float* cv = P->in[I_CV] + ((size_t)l * 32 + b) * 2048 * 384 + 4 * l32;
    const float* sk = P->out + OFF_SWK + ((size_t)l * 32 + b) * 2048 * 384 + 4 * l32;
    const float* sv = P->out + OFF_SWV + ((size_t)l * 32 + b) * 2048 * 384 + 4 * l32;
    float m[3], ls[3]; f32x4 o[3];
#pragma unroll
    for (int i = 0; i < 3; ++i) { m[i] = -1e30f; ls[i] = 0.f; o[i] = (f32x4){0.f, 0.f, 0.f, 0.f}; }
    const int slot = 2 * wave + half;
#pragma unroll 1
    for (int it0 = 0; it0 < 28; it0 += 4) {
        f32x4 kr[4][3], vr[4][3];
#pragma unroll
        for (int u = 0; u < 4; ++u) {
            const int kk = (it0 + u) * 16 + slot, kc = kk < 387 ? kk : 386;
            const int pat = kc >= 258 ? 2 : (kc >= 129 ? 1 : 0), j = kc - 129 * pat, idx = 2048 + t - (j << (2 * pat));
            const float* kp = idx < 2048 ? ck + (size_t)idx * 384 : sk + (size_t)(idx - 8) * 384;
            const float* vp = idx < 2048 ? cv + (size_t)idx * 384 : sv + (size_t)(idx - 8) * 384;
#pragma unroll
            for (int i = 0; i < 3; ++i) { kr[u][i] = *(const f32x4*)(kp + 128 * i); vr[u][i] = *(const f32x4*)(vp + 128 * i); }
        }
#pragma unroll
        for (int u = 0; u < 4; ++u) {
            const bool valid = (it0 + u) * 16 + slot < 387;
#pragma unroll
            for (int i = 0; i < 3; ++i) {
                float sc = (q[i][0] * kr[u][i][0] + q[i][1] * kr[u][i][1]) + (q[i][2] * kr[u][i][2] + q[i][3] * kr[u][i][3]);
                sc += __shfl_xor(sc, 1); sc += __shfl_xor(sc, 2); sc += __shfl_xor(sc, 4); sc += __shfl_xor(sc, 8);
                if (!valid) sc = -INFINITY;
                const float mn = fmaxf(m[i], sc), al = fexp2(m[i] - mn), p = fexp2(sc - mn);
                ls[i] = ls[i] * al + p; o[i] = o[i] * al + vr[u][i] * p; m[i] = mn;
            }
        }
    }
    LAS float* part = (LAS float*)lds;
#pragma unroll
    for (int i = 0; i < 3; ++i) {
        const float mo = __shfl_xor(m[i], 32), lo = __shfl_xor(ls[i], 32);
        f32x4 oo;
#pragma unroll
        for (int e = 0; e < 4; ++e) oo[e] = __shfl_xor(o[i][e], 32);
        const float M = fmaxf(m[i], mo), a0 = fexp2(m[i] - M), a1 = fexp2(mo - M);
        const float L = ls[i] * a0 + lo * a1; const f32x4 O = o[i] * a0 + oo * a1;
        if (half == 0) { LAS float* d = part + ((wave * 96) + l32 + 32 * i) * 6; d[0] = M; d[1] = L; d[2] = O[0]; d[3] = O[1]; d[4] = O[2]; d[5] = O[3]; }
    }
    __syncthreads();
    if (tid < 96) {
        float M = -1e30f;
#pragma unroll
        for (int w = 0; w < 8; ++w) M = fmaxf(M, part[(w * 96 + tid) * 6]);
        float L = 0.f; f32x4 O = (f32x4){0.f, 0.f, 0.f, 0.f};
#pragma unroll
        for (int w = 0; w < 8; ++w) { const LAS float* d = part + (w * 96 + tid) * 6; const float a = fexp2(d[0] - M); L += d[1] * a; O += (f32x4){d[2], d[3], d[4], d[5]} * a; }
        *(u32x2*)(MIX + (size_t)row * DM + 4 * tid) = f4_to_bf4(O * (1.0f / L));
    }
    __syncthreads();
}

__device__ __forceinline__ void p2_copy(KP P, int l, int wave, int lane) {
    constexpr int PER_B = ((CPY_TOT - CPY_R2) / 256 + 63) & ~63;
    const int cum0 = wave < 2 ? 2 * wave : (wave < 6 ? 4 + 5 * (wave - 2) : 24 + 8 * (wave - 6));
    const int cum1 = wave < 2 ? cum0 + 2 : (wave < 6 ? cum0 + 5 : cum0 + 8);
    const int base = CPY_R2 + (int)blockIdx.x * PER_B;
    int lo = base + ((PER_B / 64 * cum0 / 40) * 64), hi = base + ((PER_B / 64 * cum1 / 40) * 64);
    if (wave == 7) hi = base + PER_B;
    lo = lo < CPY_TOT ? lo : CPY_TOT; hi = hi < CPY_TOT ? hi : CPY_TOT;
    copy_range(P, l, lo, hi, lane, 64);
}

__device__ __forceinline__ void phase2(KP P, int l, LAS unsigned char* lds) {
    const int tid = opaque_tid(), lane = tid & 63, wave = tid >> 6;
    const int gw = blockIdx.x * 8 + wave, NGW = gridDim.x * 8;
    const int gt = blockIdx.x * 512 + tid, NGT = gridDim.x * 512;
    constexpr int NT_R = NCH * 6, NT_P = NCH * 4;
    LAS unsigned char* wl = lds + wave * 16384;
    if (wave < 4) { int ln = lane; asm volatile("" : "+v"(ln)); for (int t = blockIdx.x + gridDim.x * wave; t < NT_R + NT_P; t += NGW) { if (t < NT_R) rglru_local_task(P, l, t, ln, wl); else pool_task(P, l, t - NT_R, ln, wl); }
        p2_copy(P, l, wave, ln); }
    {
        int ln = lane; asm volatile("" : "+v"(ln));
        const int xcd = blockIdx.x & 7, jw = (blockIdx.x >> 3) * 8 + wave;
#pragma unroll 1
        for (int tk = 0; tk < 3; ++tk) attn_tile(P, l, 768 * xcd + 256 * tk + jw, gw, NGW, tk, ln, wl);
    }
    if (wave >= 4) { int ln = lane; asm volatile("" : "+v"(ln)); for (int t = blockIdx.x + gridDim.x * wave; t < NT_R + NT_P; t += NGW) { if (t < NT_R) rglru_local_task(P, l, t, ln, wl); else pool_task(P, l, t - NT_R, ln, wl); }
        p2_copy(P, l, wave, ln); }
    {
        const bf16_t* PJ = (const bf16_t*)(P->ws + WS_PJ); float* out = P->out;
        for (int i = gt; i < 2048 * 192; i += NGT) {
            const int r = i / 192, c4 = (i - r * 192) * 4, kv = c4 >= 384, c = c4 - 384 * kv;
            *(f32x4*)(out + (kv ? OFF_PWV : OFF_PWK) + ((size_t)l * 2048 + r) * 384 + c) = bf4_to_f4(*(const u32x2*)(PJ + (size_t)(SEQ - 2048 + r) * PJP + C_K + c4));
        }
        for (int i = gt; i < 256 * 192; i += NGT) {
            const int si = i / 192, c4 = (i - si * 192) * 4, kv = c4 >= 384, c = c4 - 384 * kv;
            *(f32x4*)(out + (kv ? OFF_SWV : OFF_SWK) + (((size_t)l * 32 + (si >> 3)) * 2048 + 2040 + (si & 7)) * 384 + c) = bf4_to_f4(*(const u32x2*)(PJ + (size_t)(SEQ + si) * PJP + C_K + c4));
        }
        for (int i = gt; i < 15 * 64; i += NGT) {
            const int r = i >> 6, c = (i & 63) * 4;
            *(f32x4*)(out + OFF_PPOOL + ((size_t)l * 15 + r) * 256 + c) = bf4_to_f4(*(const u32x2*)(PJ + (size_t)(SEQ - 15 + r) * PJP + C_U + c));
        }
        for (int i = gt; i < 256 * 64; i += NGT) {
            const int si = i >> 6, c = (i & 63) * 4;
            *(f32x4*)(out + OFF_SPOOL + (((size_t)l * 32 + (si >> 3)) * 15 + 7 + (si & 7)) * 256 + c) = bf4_to_f4(*(const u32x2*)(PJ + (size_t)(SEQ + si) * PJP + C_U + c));
        }
        for (int i = gt; i < 3 * 96; i += NGT) {
            const int r = i / 96, c = (i - r * 96) * 4;
            *(f32x4*)(out + OFF_PCONV + ((size_t)l * 3 + r) * 384 + c) = bf4_to_f4(*(const u32x2*)(PJ + (size_t)(SEQ - 3 + r) * PJP + C_XR + c));
        }
        for (int i = gt; i < 32 * 3 * 96; i += NGT) {
            const int br = i / 96, c = (i - br * 96) * 4, b = br / 3, r = br - 3 * b;
            *(f32x4*)(out + OFF_SCONV + (((size_t)l * 32 + b) * 3 + r) * 384 + c) = bf4_to_f4(*(const u32x2*)(PJ + (size_t)(SEQ + 8 * b + 5 + r) * PJP + C_XR + c));
        }
    }
    for (int i = gt; i < 32 * 7 * 256; i += NGT) {
        const int b = i / 1792, rem = i - b * 1792;
        P->out[OFF_SPOOL + ((size_t)l * 32 + b) * 15 * 256 + rem] = P->in[I_SPOOL][((size_t)l * 32 + b) * 15 * 256 + 8 * 256 + rem];
    }
}

__device__ __forceinline__ void phase3(KP P, int l, LAS unsigned char* lds) {
    const int tid = opaque_tid(), lane = tid & 63, wave = tid >> 6;
    const int gw = blockIdx.x * 8 + wave, NGW = gridDim.x * 8;
    rglru_fix_sample(P, l);
    for (int t = blockIdx.x; t < 256 * 3; t += gridDim.x) rglru_fix_task(P, l, t, lds);
    for (int t = blockIdx.x; t < NSMP; t += gridDim.x) sattn_block_task(P, l, (t & 7) * (NSMP >> 3) + (t >> 3), lds);
}

template <int K>
__device__ __forceinline__ void sample_proj(const bf16_t* A, const bf16_t* Bt, const float* base_s, float* X, bf16_t* XB, float* rss_out, LAS unsigned char* lds) {
    const int tid = opaque_tid(), lane = tid & 63, wave = tid >> 6, fr = lane & 15, fq = lane >> 4;
    const int rg = blockIdx.x >> 4, cg_ = blockIdx.x & 15;
    if (blockIdx.x >= 256) return;
    constexpr int KS = K / 8, NK = KS / 32;
    const bf16_t* ap = A + (size_t)(SEQ + 16 * rg + fr) * K + wave * KS + 8 * fq;
    const bf16_t* bp = Bt + (size_t)(64 * cg_ + fr) * K + wave * KS + 8 * fq;
    f32x4 acc[4];
#pragma unroll
    for (int ct = 0; ct < 4; ++ct) acc[ct] = (f32x4){0.f, 0.f, 0.f, 0.f};
#pragma unroll 1
    for (int k0 = 0; k0 < NK; k0 += 4) {
        bf16x8 af[4], bf[4][4];
#pragma unroll
        for (int u = 0; u < 4; ++u) { const int ks = (k0 + u) < NK ? (k0 + u) : (NK - 1); af[u] = *(const bf16x8*)(ap + 32 * ks);
#pragma unroll
            for (int ct = 0; ct < 4; ++ct) bf[u][ct] = *(const bf16x8*)(bp + (size_t)(16 * ct) * K + 32 * ks); }
#pragma unroll
        for (int u = 0; u < 4; ++u) if (k0 + u < NK) {
#pragma unroll
            for (int ct = 0; ct < 4; ++ct) acc[ct] = __builtin_amdgcn_mfma_f32_16x16x32_bf16(bf[u][ct], af[u], acc[ct], 0, 0, 0);
        }
    }
    LAS f32x4* red = (LAS f32x4*)lds;
#pragma unroll
    for (int ct = 0; ct < 4; ++ct) red[(wave * 4 + ct) * 64 + lane] = acc[ct];
    __syncthreads();
    if (wave < 4) {
        f32x4 sacc = (f32x4){0.f, 0.f, 0.f, 0.f};
#pragma unroll
        for (int w = 0; w < 8; ++w) sacc += red[(w * 4 + wave) * 64 + lane];
        const int row = 16 * rg + fr, col = 64 * cg_ + 16 * wave + 4 * fq;
        const f32x4 x = *(const f32x4*)(base_s + (size_t)row * DM + col) + sacc;
        *(f32x4*)(X + (size_t)(SEQ + row) * DM + col) = x;
        *(u32x2*)(XB + (size_t)(SEQ + row) * DM + col) = f4_to_bf4(x);
        float ss = (x[0] * x[0] + x[1] * x[1]) + (x[2] * x[2] + x[3] * x[3]);
        ss += __shfl_xor(ss, 16); ss += __shfl_xor(ss, 32);
        if (fq == 0) unsafeAtomicAdd(rss_out + SEQ + row, ss);
    }
    __syncthreads();
}

__device__ __forceinline__ void final_norm(KP P) {
    const int tid = opaque_tid(), lane = tid & 63, wave = tid >> 6;
    const int gw = blockIdx.x * 8 + wave, NGW = gridDim.x * 8;
    const bf16_t* XB = (const bf16_t*)(P->ws + WS_XB); const float* rss = (const float*)(P->ws + WS_RSS) + 4 * MT;
    const f32x4 g0 = *(const f32x4*)(P->in[I_FING] + 8 * lane), g1 = *(const f32x4*)(P->in[I_FING] + 8 * lane + 4), g2 = *(const f32x4*)(P->in[I_FING] + 512 + 8 * lane), g3 = *(const f32x4*)(P->in[I_FING] + 512 + 8 * lane + 4);
    for (int row0 = gw; row0 < MT; row0 += 4 * NGW) {
        u32x4 v[4][2]; float rs[4];
#pragma unroll
        for (int r = 0; r < 4; ++r) { const int row = row0 + r * NGW; if (row < MT) { v[r][0] = *(const u32x4*)(XB + (size_t)row * DM + 8 * lane); v[r][1] = *(const u32x4*)(XB + (size_t)row * DM + 512 + 8 * lane); rs[r] = rsqrtf(rss[row] * (1.0f / DM) + EPS); } }
#pragma unroll
        for (int r = 0; r < 4; ++r) { const int row = row0 + r * NGW; if (row < MT) {
            float* o = P->out + (size_t)row * DM + 8 * lane;
            *(f32x4*)o = (f32x4){bf_lo(v[r][0].x), bf_hi(v[r][0].x), bf_lo(v[r][0].y), bf_hi(v[r][0].y)} * rs[r] * g0;
            *(f32x4*)(o + 4) = (f32x4){bf_lo(v[r][0].z), bf_hi(v[r][0].z), bf_lo(v[r][0].w), bf_hi(v[r][0].w)} * rs[r] * g1;
            *(f32x4*)(o + 512) = (f32x4){bf_lo(v[r][1].x), bf_hi(v[r][1].x), bf_lo(v[r][1].y), bf_hi(v[r][1].y)} * rs[r] * g2;
            *(f32x4*)(o + 516) = (f32x4){bf_lo(v[r][1].z), bf_hi(v[r][1].z), bf_lo(v[r][1].w), bf_hi(v[r][1].w)} * rs[r] * g3; } }
    }
}

#define XB_TMO      128
#define XB_XCNT(j)  (256  + 64 * (j))
#define XB_XSUB(j)  (1280 + 64 * (j))
#define XB_XGEN(j)  (2304 + 64 * (j))
#define XB_TOP      3328
#define XB_TOPGEN   3392
#define XCD_BAR_WORDS 3456
#define XB_SPIN_CAP (1u << 18)

__device__ __forceinline__ unsigned xb_ld(unsigned* p)              { return __hip_atomic_load(p, __ATOMIC_RELAXED, __HIP_MEMORY_SCOPE_AGENT); }
__device__ __forceinline__ unsigned xb_add(unsigned* p, unsigned v) { return __hip_atomic_fetch_add(p, v, __ATOMIC_RELAXED, __HIP_MEMORY_SCOPE_AGENT); }
__device__ __forceinline__ unsigned xb_xcc_id() { return (unsigned)__builtin_amdgcn_s_getreg((3 << 11) | 20) & 0xFu; }
#define XB_SPIN(cond, bar) do { unsigned _sp = 0; while (cond) { __builtin_amdgcn_s_sleep(1); \
    if ((++_sp & 255u) == 0u) { if (xb_ld(&(bar)[XB_TMO])) break; if (_sp > XB_SPIN_CAP) { atomicAdd(&(bar)[XB_TMO], 1u); break; } } } } while (0)

struct XcdBarrier {
    unsigned* bar; unsigned x;
    volatile LAS unsigned* st;
};

__device__ __forceinline__ XcdBarrier xcd_barrier_post(unsigned* bar, volatile LAS unsigned* st) {
    XcdBarrier b; b.bar = bar; b.x = (unsigned)__builtin_amdgcn_readfirstlane((int)xb_xcc_id()); b.st = st;
    if (threadIdx.x == 0) (void)xb_add(&bar[XB_XCNT(b.x)], 1u);
    return b;
}
__device__ __forceinline__ void xcd_barrier_complete(unsigned* bar, unsigned x, unsigned& nloc, unsigned& nx) {
    const unsigned G = gridDim.x * gridDim.y * gridDim.z;
    unsigned sum, cnt, mine, sp = 0u;
    for (;;) {
        sum = 0u; cnt = 0u; mine = 0u;
#pragma unroll
        for (unsigned j = 0; j < 16; ++j) { const unsigned c = xb_ld(&bar[XB_XCNT(j)]); sum += c; cnt += (c > 0u) ? 1u : 0u; mine = (j == x) ? c : mine; }
        if (sum == G) break;
        __builtin_amdgcn_s_sleep(1);
        if ((++sp & 255u) == 0u) { if (xb_ld(&bar[XB_TMO])) break; if (sp > XB_SPIN_CAP) { atomicAdd(&bar[XB_TMO], 1u); break; } }
    }
    nloc = mine > 0u ? mine : 1u; nx = cnt > 0u ? cnt : 1u;
}

__device__ __forceinline__ void xcd_barrier(const XcdBarrier& b) {
    unsigned bx_ = b.x; asm volatile("" : "+s"(bx_));
    asm volatile("s_waitcnt vmcnt(0)" ::: "memory");
    __syncthreads();
    if (threadIdx.x == 0) {
        unsigned* bar = b.bar; asm volatile("" : "+s"(bar));
        __builtin_amdgcn_s_waitcnt(0);
        unsigned nloc = b.st[0], nx = b.st[1];
        if (nloc == 0u) { xcd_barrier_complete(bar, bx_, nloc, nx); b.st[0] = nloc; b.st[1] = nx; }
        const unsigned old = xb_add(&bar[XB_XSUB(bx_)], 1u);
        const unsigned gen = old / nloc;
        if (old + 1u == (gen + 1u) * nloc) {
            __builtin_amdgcn_fence(__ATOMIC_RELEASE, "agent");
            asm volatile("s_waitcnt vmcnt(0)" ::: "memory");
            const unsigned og = xb_add(&bar[XB_TOP], 1u);
            const unsigned tg = og / nx;
            if (og + 1u == (tg + 1u) * nx) xb_add(&bar[XB_TOPGEN], 1u);
            else XB_SPIN(xb_ld(&bar[XB_TOPGEN]) == tg, bar);
            __builtin_amdgcn_fence(__ATOMIC_ACQUIRE, "agent");
            xb_add(&bar[XB_XGEN(bx_)], 1u);
            asm volatile("s_waitcnt vmcnt(0)" ::: "memory");
        } else {
            XB_SPIN(xb_ld(&bar[XB_XGEN(bx_)]) == gen, bar);
            __builtin_amdgcn_fence(__ATOMIC_ACQUIRE, "agent");
            asm volatile("s_waitcnt vmcnt(0)" ::: "memory");
        }
    }
    __syncthreads();
}

__global__ void __launch_bounds__(512) mega_fwd(Params Pval) {
    extern __shared__ __attribute__((aligned(16))) unsigned char lds_raw[];
    LAS unsigned char* lds = (LAS unsigned char*)lds_raw;
    cg::grid_group grid = cg::this_grid();
    if (Pval.ws == nullptr) grid.sync();
    volatile LAS unsigned* bst = (volatile LAS unsigned*)(lds + pg8::STAGE_BYTES);
    if (threadIdx.x < 2) bst[threadIdx.x] = 0u;
    __syncthreads();
    XcdBarrier bar = xcd_barrier_post((unsigned*)(Pval.ws + WS_BAR), bst);
    prologue(kargs(), lds);
    xcd_barrier(bar);
#pragma unroll 1
    for (int l = 0; l < 2; ++l) {
        {
            KP P = kargs(); unsigned char* ws = P->ws; float* rss = (float*)(ws + WS_RSS);
            pg8::Gemm g{(const bf16_t*)(ws + WS_XB), (const bf16_t*)(ws + WS_WIN) + (size_t)l * DINP * DM, MT, DINP, DM}; pg8::StaticOrder S; S.init(MT, DINP, gridDim.x, blockIdx.x);
            EpiInProj E{(bf16_t*)(ws + WS_PJ), rss + (size_t)(2 * l) * MT, (const float*)(ws + WS_ROPE)};
            pg8::gemm_phase<EpiInProj, pg8::StaticOrder, true, true>(lds, g, S, E);
            { const int nfull = (MT / 256) * (DINP / 256) % (int)gridDim.x; if ((int)blockIdx.x >= nfull) copy_range(P, l, 0, CPY_R1, ((int)blockIdx.x - nfull) * 512 + opaque_tid(), ((int)gridDim.x - nfull) * 512); }
        }
        xcd_barrier(bar);
        phase2(kargs(), l, lds);
        xcd_barrier(bar);
        phase3(kargs(), l, lds);
        xcd_barrier(bar);
        {
            KP P = kargs(); unsigned char* ws = P->ws; float* rss = (float*)(ws + WS_RSS); float* X = (float*)(ws + WS_X);
            pg8::Gemm g{(const bf16_t*)(ws + WS_MIX), (const bf16_t*)(ws + WS_WOUT) + (size_t)l * DM * DM, SEQ, DM, DM}; pg8::StaticOrder S; S.init(SEQ, DM, gridDim.x, blockIdx.x);
            EpiResid E{l == 0 ? P->in[I_XP] : X, l == 0 ? P->in[I_XS] : X + (size_t)SEQ * DM, X, (bf16_t*)(ws + WS_XB), rss + (size_t)(2 * l + 1) * MT, 1};
            pg8::gemm_phase<EpiResid, pg8::StaticOrder, true, true>(lds, g, S, E);
            sample_proj<DM>((const bf16_t*)(ws + WS_MIX), (const bf16_t*)(ws + WS_WOUT) + (size_t)l * DM * DM, l == 0 ? P->in[I_XS] : X + (size_t)SEQ * DM, X, (bf16_t*)(ws + WS_XB), rss + (size_t)(2 * l + 1) * MT, lds);
        }
        xcd_barrier(bar);
        {
            KP P = kargs(); unsigned char* ws = P->ws; float* rss = (float*)(ws + WS_RSS);
            pg8::Gemm g{(const bf16_t*)(ws + WS_XB), (const bf16_t*)(ws + WS_WGU) + (size_t)l * NGU * DM, MT, NGU, DM}; pg8::StaticOrder S; S.init(MT, NGU, gridDim.x, blockIdx.x);
            EpiGateUp E{(bf16_t*)(ws + WS_HB), rss + (size_t)(2 * l + 1) * MT};
            pg8::gemm_phase<EpiGateUp, pg8::StaticOrder, true, true>(lds, g, S, E);
            { const int nfull = (MT / 256) * (NGU / 256) % (int)gridDim.x; if ((int)blockIdx.x >= nfull) copy_range(P, l, CPY_R1, CPY_R2, ((int)blockIdx.x - nfull) * 512 + opaque_tid(), ((int)gridDim.x - nfull) * 512); }
        }
        xcd_barrier(bar);
        {
            KP P = kargs(); unsigned char* ws = P->ws; float* rss = (float*)(ws + WS_RSS); float* X = (float*)(ws + WS_X);
            pg8::Gemm g{(const bf16_t*)(ws + WS_HB), (const bf16_t*)(ws + WS_WDN) + (size_t)l * DM * DFF, SEQ, DM, DFF}; pg8::StaticOrder S; S.init(SEQ, DM, gridDim.x, blockIdx.x);
            EpiResid E{X, X + (size_t)SEQ * DM, X, (bf16_t*)(ws + WS_XB), rss + (size_t)(2 * l + 2) * MT, l == 0};
            pg8::gemm_phase<EpiResid, pg8::StaticOrder, true, true>(lds, g, S, E);
            sample_proj<DFF>((const bf16_t*)(ws + WS_HB), (const bf16_t*)(ws + WS_WDN) + (size_t)l * DM * DFF, X + (size_t)SEQ * DM, X, (bf16_t*)(ws + WS_XB), rss + (size_t)(2 * l + 2) * MT, lds);
        }
        xcd_barrier(bar);
    }
    final_norm(kargs());
}

constexpr int LDS_BYTES = pg8::STAGE_BYTES + 256;

extern "C" void kernel_launch(void* const* d_in, const int* in_sizes, int n_in, void* d_out, int out_size, void* d_ws, size_t ws_size, hipStream_t stream) {
    static int grid = 0;
    if (grid == 0) {
        if (n_in != 23 || (size_t)out_size != OUT_TOTAL || ws_size < WS_END) { fprintf(stderr, "kernel_launch: unexpected shapes (n_in %d out %d ws %zu need %zu)\n", n_in, out_size, ws_size, (size_t)WS_END); grid = -1; return; }
        int dev = 0, cus = 0, per_cu = 0;
        hipGetDevice(&dev); hipDeviceGetAttribute(&cus, hipDeviceAttributeMultiprocessorCount, dev);
        hipFuncSetAttribute((const void*)mega_fwd, hipFuncAttributeMaxDynamicSharedMemorySize, LDS_BYTES);
        hipOccupancyMaxActiveBlocksPerMultiprocessor(&per_cu, (const void*)mega_fwd, 512, LDS_BYTES);
        if (per_cu < 1) { fprintf(stderr, "kernel_launch: occupancy query says %d blocks/CU\n", per_cu); per_cu = 1; }
        grid = 256;
        (void)hipGetLastError();
    }
    if (grid < 0) return;
    if (hipMemsetAsync((unsigned char*)d_ws + WS_BAR, 0, 16384, stream) != hipSuccess) { fprintf(stderr, "kernel_launch: memset of the barrier words failed\n"); return; }
    Params p{};
    for (int i = 0; i < 23; ++i) p.in[i] = (const float*)d_in[i];
    p.out = (float*)d_out; p.ws = (unsigned char*)d_ws;
    void* args[] = {&p};
    hipError_t e = hipLaunchCooperativeKernel((const void*)mega_fwd, dim3(grid), dim3(512), args, LDS_BYTES, stream);
    if (e != hipSuccess) fprintf(stderr, "cooperative launch failed: %s (grid %d)\n", hipGetErrorString(e), grid);
}
```

```cpp
#include <hip/hip_runtime.h>
#include <hip/hip_cooperative_groups.h>
#include <cstdio>
#include <cstdint>
namespace cg = cooperative_groups;
namespace pg8 {
#define PG8_LAS __attribute__((address_space(3)))
typedef unsigned short bf16_t;
typedef short bf16x8 __attribute__((ext_vector_type(8)));
typedef float f32x4 __attribute__((ext_vector_type(4)));
typedef unsigned u32x4 __attribute__((ext_vector_type(4)));
constexpr int BM = 256, BK = 64, HALF = 128, HTB = HALF * BK * 2  , STAGE_BYTES = 8 * HTB, NXCD = 8, WGM = 8;

__host__ __device__ __forceinline__ int lds_byte(int r, int c) { const int st = (r >> 4) * 2 + (c >> 5), rr = r & 15, cc = c & 31, ob = rr * 64 + cc * 2; return st * 1024 + (ob ^ (((ob >> 9) & 1) << 5)); }
__host__ __device__ __forceinline__ void stage_rc(int b, int& R, int& C) { const int st = b / 1024, sb = b % 1024, swz = sb ^ (((sb >> 9) & 1) << 5); R = (st >> 1) * 16 + swz / 64; C = (st & 1) * 32 + (swz % 64) / 2; }
__host__ __device__ __forceinline__ int perm32(int rho) { const int n = rho >> 4, i = rho & 15; return 8 * (i >> 2) + 4 * n + (i & 3); }

struct Unit { int pm, pn; };
struct Gemm { const bf16_t* A; const bf16_t* Bt; int M, N, K; };

struct StaticOrder {
    int nM, nN, nwg, G, c;
    __host__ __device__ void init(int M, int N, int G_, int c_) { nM = M / BM; nN = N / BM; nwg = nM * nN; G = G_; c = c_; }
    __host__ __device__ bool next(int i, Unit& u) const {
        const long L = (long)i * G + c; if (L >= nwg) return false;
        int wgid = (int)L; { const int q = nwg / NXCD, r = nwg % NXCD, xcd = wgid % NXCD, off = wgid / NXCD; wgid = (xcd < r ? xcd * (q + 1) : r * (q + 1) + (xcd - r) * q) + off; }
        const int nig = WGM * nN, gid = wgid / nig, fm = gid * WGM, gsz = (nM - fm) < WGM ? (nM - fm) : WGM;
        u.pm = fm + ((wgid % nig) % gsz); u.pn = (wgid % nig) / gsz; return true;
    }
    __device__ __forceinline__ void a_ready(const Unit&) const {}
    __device__ __forceinline__ void done(const Unit&) const {}
};

__device__ __forceinline__ unsigned cvt_pk_bf16(float lo, float hi) { unsigned r; asm volatile("v_cvt_pk_bf16_f32 %0, %1, %2" : "=v"(r) : "v"(lo), "v"(hi)); return r; }
template <class Epi, class Sched, bool ALIGN_EPI = false, bool SP2 = false>
__device__ __forceinline__ void gemm_phase(PG8_LAS unsigned char* lds, const Gemm g, const Sched& S, const Epi& E) {
    int tid_ = threadIdx.x; asm volatile("" : "+v"(tid_));
    const int tid = tid_, wid = __builtin_amdgcn_readfirstlane(tid >> 6), lane = tid & 63, wr = wid >> 2, wc = wid & 3, fr = lane & 15, fq = lane >> 4;
    const int K = g.K, nt = K / BK;
    unsigned voffA[2], voffB[2];
#pragma unroll
    for (int i = 0; i < 2; ++i) { int R, C; stage_rc(tid * 16 + i * 8192, R, C); const int Rb = Epi::PERM ? ((R & ~31) + perm32(R & 31)) : R;
        voffA[i] = (unsigned)(R * K + C) * 2u; voffB[i] = (unsigned)(Rb * K + C) * 2u; }
    const size_t kstep = (size_t)(BK * 2);
    const size_t hstep = (size_t)HALF * K * 2;
    const size_t tstep = 2 * hstep;
    const unsigned ldsw = (unsigned)wid * 1024u;
    const int aoff = lds_byte(wr * 64 + fr, fq * 8), boff = lds_byte(wc * 32 + fr, fq * 8);
#define PG8_SA(b, h) (((b) * 2 + (h)) * HTB)
#define PG8_SB(b, h) ((4 + (b) * 2 + (h)) * HTB)
#define PG8_STAGE(bufoff, gbase, voff) do { _Pragma("unroll") for (int _i = 0; _i < 2; ++_i) \
        __builtin_amdgcn_global_load_lds((const unsigned*)((const char*)(gbase) + (voff)[_i]), (PG8_LAS unsigned*)(lds + (bufoff) + ldsw + _i * 8192), 16, 0, 0); } while (0)
#define PG8_LDA(dst, b, h) do { _Pragma("unroll") for (int m = 0; m < 4; ++m) _Pragma("unroll") for (int k = 0; k < 2; ++k) dst[m][k] = *(const PG8_LAS bf16x8*)(lds + PG8_SA(b, h) + aoff + m * 2048 + k * 1024); } while (0)
#define PG8_LDB(dst, b, h) do { _Pragma("unroll") for (int n = 0; n < 2; ++n) _Pragma("unroll") for (int k = 0; k < 2; ++k) dst[n][k] = *(const PG8_LAS bf16x8*)(lds + PG8_SB(b, h) + boff + n * 2048 + k * 1024); } while (0)
#define PG8_MMA(ai, bj, At, Bt) do { __builtin_amdgcn_s_setprio(1); _Pragma("unroll") for (int m = 0; m < 4; ++m) _Pragma("unroll") for (int n = 0; n < 2; ++n) _Pragma("unroll") for (int k = 0; k < 2; ++k) \
        acc[ai][bj][m][n] = __builtin_amdgcn_mfma_f32_16x16x32_bf16(Bt[n][k], At[m][k], acc[ai][bj][m][n], 0, 0, 0); __builtin_amdgcn_s_setprio(0); } while (0)
#define PG8_WAIT_V(n) asm volatile("s_waitcnt vmcnt(" #n ")" ::: "memory")
#define PG8_WAIT_L(n) asm volatile("s_waitcnt lgkmcnt(" #n ")" ::: "memory")
#define PG8_BAR __builtin_amdgcn_s_barrier()
#define PG8_SCHED __builtin_amdgcn_sched_barrier(0)
    Unit cur, nxt; int ui = 0;
    if (!S.next(0, cur)) return;
    f32x4 acc[2][2][4][2];
#pragma unroll
    for (int a = 0; a < 2; ++a)
#pragma unroll
        for (int b = 0; b < 2; ++b)
#pragma unroll
            for (int m = 0; m < 4; ++m)
#pragma unroll
                for (int n = 0; n < 2; ++n) acc[a][b][m][n] = (f32x4){0.f, 0.f, 0.f, 0.f};
    bf16x8 At[4][2], B0[2][2], B1[2][2];
    const char* cA = (const char*)g.A + (size_t)cur.pm * tstep; const char* cB = (const char*)g.Bt + (size_t)cur.pn * tstep;
    S.a_ready(cur);
    if constexpr (SP2) {
        PG8_STAGE(PG8_SB(0, 0), cB, voffB); PG8_STAGE(PG8_SB(0, 1), cB + hstep, voffB); PG8_STAGE(PG8_SA(0, 0), cA, voffA); PG8_STAGE(PG8_SA(0, 1), cA + hstep, voffA);
        if (wr == 1) PG8_BAR;
        PG8_WAIT_V(2); PG8_BAR;
        PG8_STAGE(PG8_SB(1, 0), cB + kstep, voffB); PG8_STAGE(PG8_SA(1, 0), cA + kstep, voffA); PG8_STAGE(PG8_SB(1, 1), cB + hstep + kstep, voffB);
        PG8_WAIT_V(6); PG8_BAR;
    } else {
        PG8_STAGE(PG8_SB(0, 0), cB, voffB); PG8_STAGE(PG8_SA(0, 0), cA, voffA); PG8_STAGE(PG8_SB(0, 1), cB + hstep, voffB); PG8_STAGE(PG8_SA(0, 1), cA + hstep, voffA);
        if (wr == 1) PG8_BAR;
        PG8_WAIT_V(4); PG8_BAR;
        PG8_STAGE(PG8_SB(1, 0), cB + kstep, voffB); PG8_STAGE(PG8_SA(1, 0), cA + kstep, voffA); PG8_STAGE(PG8_SB(1, 1), cB + hstep + kstep, voffB);
        PG8_WAIT_V(6); PG8_BAR;
    }
    for (;;) {
        const bool has_next = S.next(ui + 1, nxt);
        const char* nA = has_next ? (const char*)g.A + (size_t)nxt.pm * tstep : cA; const char* nB = has_next ? (const char*)g.Bt + (size_t)nxt.pn * tstep : cB;
        for (int t = 0; t < nt; t += 2) {
            const bool last = (t == nt - 2);
            const char* a1 = cA + (size_t)(t + 1) * kstep;
            const char* a2 = last ? nA : cA + (size_t)(t + 2) * kstep; const char* b2 = last ? nB : cB + (size_t)(t + 2) * kstep;
            const char* a3 = a2 + kstep; const char* b3 = b2 + kstep;
            if (last && has_next) S.a_ready(nxt);
            if constexpr (SP2) {
            PG8_LDB(B0, 0, 0); PG8_LDB(B1, 0, 1); PG8_SCHED; PG8_LDA(At, 0, 0); PG8_STAGE(PG8_SA(1, 1), a1 + hstep, voffA);
            PG8_WAIT_V(8); PG8_WAIT_L(0); PG8_BAR; PG8_MMA(0, 0, At, B0); PG8_MMA(0, 1, At, B1); PG8_BAR; PG8_SCHED;
            PG8_LDA(At, 0, 1); PG8_STAGE(PG8_SB(0, 0), b2, voffB); PG8_STAGE(PG8_SB(0, 1), b2 + hstep, voffB); PG8_STAGE(PG8_SA(0, 0), a2, voffA);
            PG8_WAIT_V(8); PG8_WAIT_L(0); PG8_BAR; PG8_MMA(1, 0, At, B0); PG8_MMA(1, 1, At, B1); PG8_BAR; PG8_SCHED;
            PG8_LDB(B0, 1, 0); PG8_LDB(B1, 1, 1); PG8_SCHED; PG8_LDA(At, 1, 0); PG8_STAGE(PG8_SA(0, 1), a2 + hstep, voffA);
            PG8_WAIT_V(8); PG8_WAIT_L(0); PG8_BAR; PG8_MMA(0, 0, At, B0); PG8_MMA(0, 1, At, B1); PG8_BAR; PG8_SCHED;
            PG8_LDA(At, 1, 1); PG8_STAGE(PG8_SB(1, 0), b3, voffB); PG8_STAGE(PG8_SB(1, 1), b3 + hstep, voffB); PG8_STAGE(PG8_SA(1, 0), a3, voffA);
            PG8_WAIT_V(8); PG8_WAIT_L(0); PG8_BAR; PG8_MMA(1, 0, At, B0); PG8_MMA(1, 1, At, B1); PG8_BAR; PG8_SCHED;
            } else {
            PG8_LDB(B0, 0, 0); PG8_SCHED; PG8_LDA(At, 0, 0); PG8_STAGE(PG8_SA(1, 1), a1 + hstep, voffA);
            PG8_WAIT_L(8); PG8_BAR; PG8_WAIT_L(0); PG8_MMA(0, 0, At, B0); PG8_BAR; PG8_SCHED;
            PG8_LDB(B1, 0, 1); PG8_STAGE(PG8_SB(0, 0), b2, voffB);
            PG8_BAR; PG8_WAIT_L(0); PG8_MMA(0, 1, At, B1); PG8_BAR;
            PG8_LDA(At, 0, 1); PG8_STAGE(PG8_SA(0, 0), a2, voffA);
            PG8_BAR; PG8_WAIT_L(0); PG8_MMA(1, 0, At, B0); PG8_BAR; PG8_SCHED;
            PG8_STAGE(PG8_SB(0, 1), b2 + hstep, voffB);
            PG8_WAIT_V(6); PG8_BAR; PG8_MMA(1, 1, At, B1); PG8_BAR;
            PG8_LDB(B0, 1, 0); PG8_SCHED; PG8_LDA(At, 1, 0); PG8_STAGE(PG8_SA(0, 1), a2 + hstep, voffA);
            PG8_WAIT_L(8); PG8_BAR; PG8_WAIT_L(0); PG8_MMA(0, 0, At, B0); PG8_BAR; PG8_SCHED;
            PG8_LDB(B1, 1, 1); PG8_STAGE(PG8_SB(1, 0), b3, voffB);
            PG8_BAR; PG8_WAIT_L(0); PG8_MMA(0, 1, At, B1); PG8_BAR;
            PG8_LDA(At, 1, 1); PG8_STAGE(PG8_SA(1, 0), a3, voffA);
            PG8_BAR; PG8_WAIT_L(0); PG8_MMA(1, 0, At, B0); PG8_BAR; PG8_SCHED;
            PG8_STAGE(PG8_SB(1, 1), b3 + hstep, voffB);
            PG8_WAIT_V(6); PG8_BAR; PG8_MMA(1, 1, At, B1); PG8_BAR;
            }
        }
        if constexpr (ALIGN_EPI) { if (wr == 0) PG8_BAR; }
        if constexpr (!Epi::AFTER_DRAIN) { E(acc, cur, wr, wc, fr, fq); S.done(cur); }
        if (!has_next) break;
#pragma unroll
        for (int a = 0; a < 2; ++a)
#pragma unroll
            for (int b = 0; b < 2; ++b)
#pragma unroll
                for (int m = 0; m < 4; ++m)
#pragma unroll
                    for (int n = 0; n < 2; ++n) acc[a][b][m][n] = (f32x4){0.f, 0.f, 0.f, 0.f};
        cur = nxt; cA = nA; cB = nB; ++ui;
        if constexpr (ALIGN_EPI) { if (wr == 1) PG8_BAR; }
    }
    PG8_WAIT_V(0);
    if constexpr (!ALIGN_EPI) { if (wr == 0) PG8_BAR; }
    PG8_BAR;
    if constexpr (Epi::AFTER_DRAIN) { E.fused(acc, cur, wr, wc, fr, fq, lds, wid, lane); S.done(cur); }
#undef PG8_SA
#undef PG8_SB
#undef PG8_STAGE
#undef PG8_LDA
#undef PG8_LDB
#undef PG8_MMA
#undef PG8_WAIT_V
#undef PG8_WAIT_L
#undef PG8_BAR
#undef PG8_SCHED
}
}

using pg8::bf16_t; using pg8::bf16x8; using pg8::f32x4; using pg8::u32x4;
#define LAS __attribute__((address_space(3)))
typedef short s16x4 __attribute__((ext_vector_type(4)));
typedef unsigned u32x2 __attribute__((ext_vector_type(2)));
typedef float f32x2 __attribute__((ext_vector_type(2)));

constexpr int DM = 1024, SEQ = 16384, NSMP = 256, MT = SEQ + NSMP;
constexpr int DIN = 2176, DINP = 2304, DFF = 2816, NGU = 2 * DFF;
constexpr int C_Q = 0, C_K = 384, C_V = 768, C_U = 1152, C_XR = 1408, C_GT = 1792, PJP = 2176;
constexpr int NCH = MT / 64;
constexpr float EPS = 1e-6f;
constexpr float QSCALE = 0.125f * 1.4426950408889634f;

constexpr size_t OFF_YP = 0, OFF_YS = OFF_YP + (size_t)SEQ * DM, OFF_PWK = OFF_YS + (size_t)NSMP * DM, OFF_PWV = OFF_PWK + 2ull * 2048 * 384,
                 OFF_PPOOL = OFF_PWV + 2ull * 2048 * 384, OFF_PCONV = OFF_PPOOL + 2 * 15 * 256, OFF_PRG = OFF_PCONV + 2 * 3 * 384, OFF_SWK = OFF_PRG + 2 * 384,
                 OFF_SWV = OFF_SWK + 2ull * 32 * 2048 * 384, OFF_SPOOL = OFF_SWV + 2ull * 32 * 2048 * 384, OFF_SCONV = OFF_SPOOL + 2 * 32 * 15 * 256,
                 OFF_SRG = OFF_SCONV + 2 * 32 * 3 * 384, OUT_TOTAL = OFF_SRG + 2 * 32 * 384;

constexpr size_t al256(size_t x) { return (x + 255) & ~(size_t)255; }
constexpr size_t WS_WIN = 0;
constexpr size_t WS_WOUT = WS_WIN + al256(2ull * DINP * DM * 2);
constexpr size_t WS_WGU = WS_WOUT + al256(2ull * DM * DM * 2);
constexpr size_t WS_WDN = WS_WGU + al256(2ull * NGU * DM * 2);
constexpr size_t WS_WA = WS_WDN + al256(2ull * DM * DFF * 2);
constexpr size_t WS_WX = WS_WA + al256(2ull * 6 * 64 * 64 * 2);
constexpr size_t WS_WP = WS_WX + al256(2ull * 6 * 64 * 64 * 2);
constexpr size_t WS_ROPE = WS_WP + al256(2ull * 4 * 64 * 64 * 2);
constexpr size_t WS_RSS = WS_ROPE + al256(16392ull * 32 * 8);
constexpr size_t WS_XB = WS_RSS + al256(5ull * MT * 4);
constexpr size_t WS_PJ = WS_XB + al256((size_t)MT * DM * 2);
constexpr size_t WS_HL = WS_PJ + al256((size_t)MT * PJP * 2);
constexpr size_t WS_PC = WS_HL + al256((size_t)MT * 384 * 4);
constexpr size_t WS_CA = WS_PC + al256((size_t)MT * 384 * 4);
constexpr size_t WS_CH = WS_CA + al256((size_t)NCH * 384 * 4);
constexpr size_t WS_MIX = WS_CH + al256((size_t)NCH * 384 * 4);
constexpr size_t WS_X = WS_MIX + al256((size_t)MT * DM * 2);
constexpr size_t WS_HB = WS_X + al256((size_t)MT * DM * 4);
constexpr size_t WS_BAR = WS_HB + al256((size_t)MT * DFF * 2);
constexpr size_t WS_END = WS_BAR + 16384;

struct Params { const float* in[23]; float* out; unsigned char* ws; };
typedef const __attribute__((address_space(4))) Params* KP;
__device__ __forceinline__ KP kargs() { auto p = __builtin_amdgcn_kernarg_segment_ptr(); asm volatile("" : "+s"(p)); return (KP)p; }
enum { I_XP = 0, I_XS, I_CK, I_CV, I_SPOOL, I_SCONV, I_SRG, I_N1G, I_WIN, I_POOLW, I_POOLS, I_CONVW, I_CONVB, I_GAW, I_GAB, I_GXW, I_GXB, I_LAM, I_WOUT, I_N2G, I_WGU, I_WDN, I_FING };

__device__ __forceinline__ int opaque_tid() { int t = threadIdx.x; asm volatile("" : "+v"(t)); return t; }
__device__ __forceinline__ unsigned pk2(float lo, float hi) { return pg8::cvt_pk_bf16(lo, hi); }
__device__ __forceinline__ float bf_lo(unsigned w) { return __uint_as_float(w << 16); }
__device__ __forceinline__ float bf_hi(unsigned w) { return __uint_as_float(w & 0xffff0000u); }
__device__ __forceinline__ f32x4 bf4_to_f4(u32x2 w) { return (f32x4){bf_lo(w.x), bf_hi(w.x), bf_lo(w.y), bf_hi(w.y)}; }
__device__ __forceinline__ u32x2 f4_to_bf4(f32x4 v) { u32x2 w; w.x = pk2(v[0], v[1]); w.y = pk2(v[2], v[3]); return w; }
__device__ __forceinline__ float wave_sum(float v) {
#pragma unroll
    for (int o = 1; o < 64; o <<= 1) v += __shfl_xor(v, o);
    return v;
}
__device__ __forceinline__ float fexp2(float x) { return __builtin_amdgcn_exp2f(x); }
__device__ __forceinline__ float fsigmoid(float x) { return __builtin_amdgcn_rcpf(1.0f + fexp2(-1.4426950408889634f * x)); }
template <int N> __device__ __forceinline__ float dpp_row_shr_c(float v) { return __int_as_float(__builtin_amdgcn_update_dpp(0, __float_as_int(v), 0x110 + N, 0xf, 0xf, false)); }
__device__ __forceinline__ float dpp_row_shr(float v, int n) { return n == 1 ? dpp_row_shr_c<1>(v) : n == 2 ? dpp_row_shr_c<2>(v) : n == 4 ? dpp_row_shr_c<4>(v) : dpp_row_shr_c<8>(v); }
__device__ __forceinline__ float sigmoidf_(float x) { return 1.0f / (1.0f + __expf(-x)); }
__device__ __forceinline__ float gelu_tanh(float x) { const float z = 0.7978845608028654f * (x + 0.044715f * x * x * x); const float e = __expf(2.0f * z); return 0.5f * x * (2.0f - 2.0f / (e + 1.0f)); }

struct EpiInProj {
    static constexpr bool PERM = true, AFTER_DRAIN = false;
    bf16_t* PJ; const float* rss; const float* rope;
    __device__ __forceinline__ void operator()(const f32x4 (&acc)[2][2][4][2], const pg8::Unit& u, int wr, int wc, int fr_, int fq_) const {
        int fr = fr_, fq = fq_; asm volatile("" : "+v"(fr), "+v"(fq));
#pragma unroll
        for (int bj = 0; bj < 2; ++bj) {
            const int cb = u.pn * 256 + bj * 128;
            if (cb >= DIN) continue;
            const int c0 = cb + wc * 32 + fq * 8;
            if (cb < C_V) {
                const bool isk = cb >= C_K; const int sb = isk ? C_K : 0; const int o = c0 - sb; const int hb = o & ~63; const int j0 = (o & 63) >> 1;
                const float qs = isk ? 1.0f : QSCALE;
#pragma unroll
                for (int ai = 0; ai < 2; ++ai)
#pragma unroll
                    for (int m = 0; m < 4; ++m) {
                        const int row = u.pm * 256 + ai * 128 + wr * 64 + m * 16 + fr;
                        const int pos = row < SEQ ? row : SEQ + ((row - SEQ) & 7);
                        const f32x4 t0 = *(const f32x4*)(rope + ((size_t)pos * 32 + j0) * 2), t1 = *(const f32x4*)(rope + ((size_t)pos * 32 + j0) * 2 + 4);
                        const float rsv = rsqrtf(rss[row] * (1.0f / DM) + EPS) * qs;
                        const f32x4 v0 = acc[ai][bj][m][0] * rsv, v1 = acc[ai][bj][m][1] * rsv;
                        f32x4 o1, o2;
                        o1[0] = v0[0] * t0[0] - v0[1] * t0[1]; o2[0] = v0[1] * t0[0] + v0[0] * t0[1];
                        o1[1] = v0[2] * t0[2] - v0[3] * t0[3]; o2[1] = v0[3] * t0[2] + v0[2] * t0[3];
                        o1[2] = v1[0] * t1[0] - v1[1] * t1[1]; o2[2] = v1[1] * t1[0] + v1[0] * t1[1];
                        o1[3] = v1[2] * t1[2] - v1[3] * t1[3]; o2[3] = v1[3] * t1[2] + v1[2] * t1[3];
                        bf16_t* pj = PJ + (size_t)row * PJP + sb + hb + j0;
                        *(u32x2*)pj = f4_to_bf4(o1); *(u32x2*)(pj + 32) = f4_to_bf4(o2);
                    }
            } else {
#pragma unroll
                for (int ai = 0; ai < 2; ++ai)
#pragma unroll
                    for (int m = 0; m < 4; ++m) {
                        const int row = u.pm * 256 + ai * 128 + wr * 64 + m * 16 + fr;
                        const float rsv = rsqrtf(rss[row] * (1.0f / DM) + EPS);
                        const f32x4 v0 = acc[ai][bj][m][0] * rsv, v1 = acc[ai][bj][m][1] * rsv;
                        u32x4 w; w.x = pk2(v0[0], v0[1]); w.y = pk2(v0[2], v0[3]); w.z = pk2(v1[0], v1[1]); w.w = pk2(v1[2], v1[3]);
                        *(u32x4*)(PJ + (size_t)row * PJP + c0) = w;
                    }
            }
        }
    }
};

struct EpiResid {
    static constexpr bool PERM = false, AFTER_DRAIN = false;
    const float* base_p; const float* base_s; float* X; bf16_t* XB; float* rss_out; int store_x;
    __device__ __forceinline__ void operator()(const f32x4 (&acc)[2][2][4][2], const pg8::Unit& u, int wr, int wc, int fr, int fq) const {
#pragma unroll
        for (int ai = 0; ai < 2; ++ai)
#pragma unroll
            for (int m = 0; m < 4; ++m) {
                const int row = u.pm * 256 + ai * 128 + wr * 64 + m * 16 + fr;
                const float* b = row < SEQ ? base_p + (size_t)row * DM : base_s + (size_t)(row - SEQ) * DM;
                float ss = 0.f;
#pragma unroll
                for (int bj = 0; bj < 2; ++bj)
#pragma unroll
                    for (int n = 0; n < 2; ++n) {
                        const int col = u.pn * 256 + bj * 128 + wc * 32 + n * 16 + fq * 4;
                        const f32x4 x = *(const f32x4*)(b + col) + acc[ai][bj][m][n];
                        if (store_x) *(f32x4*)(X + (size_t)row * DM + col) = x;
                        *(u32x2*)(XB + (size_t)row * DM + col) = f4_to_bf4(x);
                        ss += (x[0] * x[0] + x[1] * x[1]) + (x[2] * x[2] + x[3] * x[3]);
                    }
                ss += __shfl_xor(ss, 16); ss += __shfl_xor(ss, 32);
                if (fq == 0) unsafeAtomicAdd(rss_out + row, ss);
            }
    }
};

struct EpiGateUp {
    static constexpr bool PERM = true, AFTER_DRAIN = false;
    bf16_t* HB; const float* rss;
    __device__ __forceinline__ void operator()(const f32x4 (&acc)[2][2][4][2], const pg8::Unit& u, int wr, int wc, int fr, int fq) const {
#pragma unroll
        for (int ai = 0; ai < 2; ++ai)
#pragma unroll
            for (int m = 0; m < 4; ++m) {
                const int row = u.pm * 256 + ai * 128 + wr * 64 + m * 16 + fr;
                const float rs = rsqrtf(rss[row] * (1.0f / DM) + EPS);
#pragma unroll
                for (int bj = 0; bj < 2; ++bj) {
                    const int hc = u.pn * 128 + bj * 64 + wc * 16 + fq * 4;
                    const f32x4 g = acc[ai][bj][m][0] * rs, up = acc[ai][bj][m][1] * rs;
                    f32x4 h;
#pragma unroll
                    for (int i = 0; i < 4; ++i) h[i] = g[i] * fsigmoid(g[i]) * up[i];
                    *(u32x2*)(HB + (size_t)row * DFF + hc) = f4_to_bf4(h);
                }
            }
    }
};

__device__ __forceinline__ int colmap_in(int n) { if (n >= DIN) return -1; if (n >= C_V) return n; const int sb = n >= C_K ? C_K : 0; const int o = n - sb; return sb + (o & ~63) + ((o & 63) >> 1) + 32 * (o & 1); }
__device__ __forceinline__ int colmap_gu(int n) { return ((n >> 3) << 2) + (n & 3) + DFF * ((n >> 2) & 1); }

__device__ __forceinline__ void transpose_item(const float* __restrict__ W, int K, int Nsrc, const float* __restrict__ kscale, bf16_t* WT, int item, int nblk, int mode, LAS float* scr, int lane) {
    const int kb = item / nblk, nb = item - kb * nblk, k0 = 64 * kb, n0 = 32 * nb;
    const int ch = lane & 7, rsub = lane >> 3, c4 = ch & 3, hi = ch >> 2;
    int srccol, x0, xs;
    bool zero = false;
    if (mode == 1 && n0 < C_V) { const int sb = n0 >= C_K ? C_K : 0, o = n0 - sb; srccol = sb + (o & ~63) + ((o & 63) >> 1) + 32 * hi + 4 * c4; x0 = 8 * c4 + hi; xs = 2; }
    else if (mode == 2) { srccol = (n0 >> 1) + DFF * hi + 4 * c4; x0 = 8 * c4 + 4 * hi; xs = 1; }
    else { srccol = n0 + 4 * ch; x0 = 4 * ch; xs = 1; zero = (mode == 1 && n0 >= DIN); }
    f32x4 v[8];
#pragma unroll
    for (int i = 0; i < 8; ++i) v[i] = zero ? (f32x4){0.f, 0.f, 0.f, 0.f} : *(const f32x4*)(W + (size_t)(k0 + 8 * i + rsub) * Nsrc + srccol);
#pragma unroll
    for (int i = 0; i < 8; ++i) {
        const int kk = 8 * i + rsub; const float sc = kscale ? kscale[k0 + kk] : 1.0f;
#pragma unroll
        for (int e = 0; e < 4; ++e) scr[kk * 33 + x0 + xs * e] = v[i][e] * sc;
    }
    asm volatile("s_waitcnt lgkmcnt(0)" ::: "memory");
    const int c = lane & 7;
#pragma unroll
    for (int j = 0; j < 4; ++j) {
        const int n = (lane >> 3) + 8 * j; const LAS float* s = scr + (8 * c) * 33 + n;
        u32x4 o; o.x = pk2(s[0 * 33], s[1 * 33]); o.y = pk2(s[2 * 33], s[3 * 33]); o.z = pk2(s[4 * 33], s[5 * 33]); o.w = pk2(s[6 * 33], s[7 * 33]);
        *(u32x4*)(WT + (size_t)(n0 + n) * K + k0 + 8 * c) = o;
    }
    asm volatile("s_waitcnt lgkmcnt(0)" ::: "memory");
}

__device__ __forceinline__ void prologue(KP P, LAS unsigned char* lds) {
    const int tid = opaque_tid(), lane = tid & 63, wave = tid >> 6;
    const int gw = blockIdx.x * 8 + wave, NGW = gridDim.x * 8;
    const int gt = blockIdx.x * 512 + tid, NGT = gridDim.x * 512;
    unsigned char* ws = P->ws;
    LAS float* scr = (LAS float*)(lds + wave * 8704);
    constexpr int I_IN = 16 * (DINP / 32), I_OUT = 16 * (DM / 32), I_GU = 16 * (NGU / 32), I_DN = (DFF / 64) * (DM / 32), I_L = I_IN + I_OUT + I_GU + I_DN;
    for (int it = gw; it < 2 * I_L; it += NGW) {
        const int l = it / I_L; int r = it - l * I_L;
        if (r < I_IN) { transpose_item(P->in[I_WIN] + (size_t)l * DM * DIN, DM, DIN, P->in[I_N1G] + l * DM, (bf16_t*)(ws + WS_WIN) + (size_t)l * DINP * DM, r, DINP / 32, 1, scr, lane); continue; } r -= I_IN;
        if (r < I_OUT) { transpose_item(P->in[I_WOUT] + (size_t)l * DM * DM, DM, DM, nullptr, (bf16_t*)(ws + WS_WOUT) + (size_t)l * DM * DM, r, DM / 32, 0, scr, lane); continue; } r -= I_OUT;
        if (r < I_GU) { transpose_item(P->in[I_WGU] + (size_t)l * DM * NGU, DM, NGU, P->in[I_N2G] + l * DM, (bf16_t*)(ws + WS_WGU) + (size_t)l * NGU * DM, r, NGU / 32, 2, scr, lane); continue; } r -= I_GU;
        transpose_item(P->in[I_WDN] + (size_t)l * DFF * DM, DFF, DM, nullptr, (bf16_t*)(ws + WS_WDN) + (size_t)l * DM * DFF, r, DM / 32, 0, scr, lane);
    }
    float* rss = (float*)(ws + WS_RSS);
    bf16_t* XB = (bf16_t*)(ws + WS_XB);
    for (int row0 = gw; row0 < MT; row0 += 4 * NGW) {
        f32x4 v[4][4];
#pragma unroll
        for (int r = 0; r < 4; ++r) { const int row = row0 + r * NGW; if (row < MT) { const float* xr = row < SEQ ? P->in[I_XP] + (size_t)row * DM : P->in[I_XS] + (size_t)(row - SEQ) * DM;
#pragma unroll
            for (int j = 0; j < 4; ++j) v[r][j] = *(const f32x4*)(xr + 4 * lane + 256 * j); } }
#pragma unroll
        for (int r = 0; r < 4; ++r) { const int row = row0 + r * NGW; if (row < MT) { float sm = 0.f;
#pragma unroll
            for (int j = 0; j < 4; ++j) { const f32x4 x = v[r][j]; sm += (x[0] * x[0] + x[1] * x[1]) + (x[2] * x[2] + x[3] * x[3]); *(u32x2*)(XB + (size_t)row * DM + 4 * lane + 256 * j) = f4_to_bf4(x); }
            sm = wave_sum(sm);
            if (lane == 0) rss[row] = sm; } }
    }
    for (int i = gt; i < 4 * MT; i += NGT) rss[MT + i] = 0.f;
    bf16_t* WA = (bf16_t*)(ws + WS_WA); bf16_t* WX = (bf16_t*)(ws + WS_WX); bf16_t* WP = (bf16_t*)(ws + WS_WP);
    for (int i = gt; i < 2 * 6 * 64 * 64; i += NGT) {
        const int slot = i & 63, d = (i >> 6) & 63, ln = i >> 12;
        const int kk = slot >> 5, q = (slot >> 3) & 3, e = slot & 7, c = 16 * (2 * kk + (e >> 2)) + 4 * q + (e & 3);
        const size_t src = ((size_t)ln * 64 + c) * 64 + d;
        WA[i] = (bf16_t)(pk2(P->in[I_GAW][src], 0.f) & 0xffffu); WX[i] = (bf16_t)(pk2(P->in[I_GXW][src], 0.f) & 0xffffu);
    }
    for (int i = gt; i < 2 * 4 * 64 * 64; i += NGT) {
        const int c = i & 63, d = (i >> 6) & 63, lg = i >> 12;
        WP[i] = (bf16_t)(pk2(P->in[I_POOLW][((size_t)lg * 64 + c) * 64 + d], 0.f) & 0xffffu);
    }
    float* rope = (float*)(ws + WS_ROPE);
    {
        const int j = gt & 31;
        const float inv = (float)exp2(-(double)j * (13.287712379549449 / 32.0));
        for (int pos = gt >> 5; pos < 16392; pos += NGT >> 5) {
            const float ang = (float)pos * inv;
            double rev = (double)ang * 0.15915494309189535; rev -= floor(rev);
            const float rf = (float)rev;
            *(f32x2*)(rope + 2 * ((size_t)pos * 32 + j)) = (f32x2){__builtin_amdgcn_cosf(rf), __builtin_amdgcn_sinf(rf)};
        }
    }
}

__device__ __forceinline__ void pool_row8(KP P, const bf16_t* PJ, int l, int R, int k, int ch, float (&v)[8]) {
    if (R < SEQ) {
        const int rr = R - k;
        if (rr < 0) {
#pragma unroll
            for (int i = 0; i < 8; ++i) v[i] = 0.f;
            return; }
        const u32x4 w = *(const u32x4*)(PJ + (size_t)rr * PJP + C_U + ch);
        v[0] = bf_lo(w.x); v[1] = bf_hi(w.x); v[2] = bf_lo(w.y); v[3] = bf_hi(w.y); v[4] = bf_lo(w.z); v[5] = bf_hi(w.z); v[6] = bf_lo(w.w); v[7] = bf_hi(w.w);
    } else {
        const int si = R - SEQ, b = si >> 3, t = si & 7, tk = t - k;
        if (tk >= 0) {
            const u32x4 w = *(const u32x4*)(PJ + (size_t)(SEQ + 8 * b + tk) * PJP + C_U + ch);
            v[0] = bf_lo(w.x); v[1] = bf_hi(w.x); v[2] = bf_lo(w.y); v[3] = bf_hi(w.y); v[4] = bf_lo(w.z); v[5] = bf_hi(w.z); v[6] = bf_lo(w.w); v[7] = bf_hi(w.w);
        } else {
            const float* s = P->in[I_SPOOL] + (((size_t)l * 32 + b) * 15 + (15 + tk)) * 256 + ch;
            const f32x4 a = *(const f32x4*)s, c = *(const f32x4*)(s + 4);
            v[0] = a[0]; v[1] = a[1]; v[2] = a[2]; v[3] = a[3]; v[4] = c[0]; v[5] = c[1]; v[6] = c[2]; v[7] = c[3];
        }
    }
}

constexpr int TLP = 136;
__device__ __forceinline__ void pool_task(KP P, int l, int task, int lane, LAS unsigned char* wl) {
    const int g = task & 3, T0 = (task >> 2) * 64, w = 2 << g, fr = lane & 15, fq = lane >> 4;
    const bool smp = T0 >= SEQ;
    const bf16_t* PJ = (const bf16_t*)(P->ws + WS_PJ); bf16_t* MIX = (bf16_t*)(P->ws + WS_MIX);
    const bf16_t* WP = (const bf16_t*)(P->ws + WS_WP) + (size_t)(l * 4 + g) * 4096;
    if (!smp) {
#pragma unroll
        for (int i = 0; i < 10; ++i) {
            const int rr = 8 * i + (lane >> 3), gr = T0 - 15 + rr;
            u32x4 v = (u32x4){0u, 0u, 0u, 0u};
            if (rr < 79 && gr >= 0) v = *(const u32x4*)(PJ + (size_t)gr * PJP + C_U + 64 * g + 8 * (lane & 7));
            if (rr < 79) *(LAS u32x4*)(wl + rr * TLP + 16 * (lane & 7)) = v;
        }
    }
    bf16x8 af[4][2];
#pragma unroll
    for (int dt = 0; dt < 4; ++dt)
#pragma unroll
        for (int kk = 0; kk < 2; ++kk) af[dt][kk] = *(const bf16x8*)(WP + (16 * dt + fr) * 64 + 32 * kk + 8 * fq);
    f32x4 sc[4];
#pragma unroll
    for (int dt = 0; dt < 4; ++dt) sc[dt] = *(const f32x4*)(P->in[I_POOLS] + l * 256 + 64 * g + 16 * dt + 4 * fq);
#pragma unroll 1
    for (int tt = 0; tt < 4; ++tt) {
        const int R = T0 + 16 * tt + fr;
        const int pos1 = R < SEQ ? R + 1 : SEQ + 1;
        const float rc = 1.0f / (float)(pos1 < w ? pos1 : w);
        bf16x8 bfr[2];
#pragma unroll
        for (int kk = 0; kk < 2; ++kk) {
            float s[8], u0[8];
            if (!smp) {
                const LAS unsigned char* rp = wl + (15 + 16 * tt + fr) * TLP + 2 * (32 * kk + 8 * fq);
                { const u32x4 x = *(const LAS u32x4*)rp; u0[0] = bf_lo(x.x); u0[1] = bf_hi(x.x); u0[2] = bf_lo(x.y); u0[3] = bf_hi(x.y); u0[4] = bf_lo(x.z); u0[5] = bf_hi(x.z); u0[6] = bf_lo(x.w); u0[7] = bf_hi(x.w); }
#pragma unroll
                for (int i = 0; i < 8; ++i) s[i] = u0[i];
                for (int k = 1; k < w; ++k) {
                    const u32x4 x = *(const LAS u32x4*)(rp - k * TLP);
                    s[0] += bf_lo(x.x); s[1] += bf_hi(x.x); s[2] += bf_lo(x.y); s[3] += bf_hi(x.y); s[4] += bf_lo(x.z); s[5] += bf_hi(x.z); s[6] += bf_lo(x.w); s[7] += bf_hi(x.w);
                }
            } else {
                const int ch = 64 * g + 32 * kk + 8 * fq;
                pool_row8(P, PJ, l, R, 0, ch, u0);
#pragma unroll
                for (int i = 0; i < 8; ++i) s[i] = u0[i];
                for (int k = 1; k < w; ++k) {
                    float v[8]; pool_row8(P, PJ, l, R, k, ch, v);
#pragma unroll
                    for (int i = 0; i < 8; ++i) s[i] += v[i];
                }
            }
            u32x4 pw;
            pw.x = pk2(s[0] * rc - u0[0], s[1] * rc - u0[1]); pw.y = pk2(s[2] * rc - u0[2], s[3] * rc - u0[3]);
            pw.z = pk2(s[4] * rc - u0[4], s[5] * rc - u0[5]); pw.w = pk2(s[6] * rc - u0[6], s[7] * rc - u0[7]);
            bfr[kk] = __builtin_bit_cast(bf16x8, pw);
        }
#pragma unroll
        for (int dt = 0; dt < 4; ++dt) {
            f32x4 y = (f32x4){0.f, 0.f, 0.f, 0.f};
            y = __builtin_amdgcn_mfma_f32_16x16x32_bf16(af[dt][0], bfr[0], y, 0, 0, 0);
            y = __builtin_amdgcn_mfma_f32_16x16x32_bf16(af[dt][1], bfr[1], y, 0, 0, 0);
            y = y * sc[dt];
            *(u32x2*)(MIX + (size_t)R * DM + 384 + 64 * g + 16 * dt + 4 * fq) = f4_to_bf4(y);
        }
    }
}

__device__ __forceinline__ void rglru_local_task(KP P, int l, int task, int lane, LAS unsigned char* wl) {
    const int c64 = task / 6, n = task - 6 * c64, T0 = c64 * 64, fr = lane & 15, fq = lane >> 4;
    const bool smp = T0 >= SEQ;
    const bf16_t* PJ = (const bf16_t*)(P->ws + WS_PJ);
    float* HL = (float*)(P->ws + WS_HL); float* PC = (float*)(P->ws + WS_PC);
    const bf16_t* WA = (const bf16_t*)(P->ws + WS_WA) + (size_t)(l * 6 + n) * 4096; const bf16_t* WX = (const bf16_t*)(P->ws + WS_WX) + (size_t)(l * 6 + n) * 4096;
    LAS float* cst = (LAS float*)(wl + 12288);
    if (!smp) {
#pragma unroll
        for (int i = 0; i < 9; ++i) {
            const int rr = 8 * i + (lane >> 3), gr = T0 - 3 + rr;
            u32x4 v = (u32x4){0u, 0u, 0u, 0u};
            if (rr < 67 && gr >= 0) v = *(const u32x4*)(PJ + (size_t)gr * PJP + C_XR + 64 * n + 8 * (lane & 7));
            if (rr < 67) *(LAS u32x4*)(wl + rr * TLP + 16 * (lane & 7)) = v;
        }
    } else {
#pragma unroll 1
        for (int i = 0; i < 11; ++i) {
            const int rr = 8 * i + (lane >> 3), bb = rr / 11, k = rr - 11 * bb, b = ((T0 - SEQ) >> 3) + bb, c8 = 64 * n + 8 * (lane & 7);
            u32x4 v;
            if (k < 3) { const float* sp = P->in[I_SCONV] + (((size_t)l * 32 + b) * 3 + k) * 384 + c8; const f32x4 a = *(const f32x4*)sp, c = *(const f32x4*)(sp + 4);
                v.x = pk2(a[0], a[1]); v.y = pk2(a[2], a[3]); v.z = pk2(c[0], c[1]); v.w = pk2(c[2], c[3]); }
            else v = *(const u32x4*)(PJ + (size_t)(SEQ + 8 * b + (k - 3)) * PJP + C_XR + c8);
            *(LAS u32x4*)(wl + rr * TLP + 16 * (lane & 7)) = v;
        }
    }
    {
        const int ch = l * 384 + 64 * n + lane;
#pragma unroll
        for (int j = 0; j < 4; ++j) cst[j * 64 + lane] = P->in[I_CONVW][(size_t)l * 3 * 384 + j * 384 + ch];
        cst[4 * 64 + lane] = P->in[I_CONVB][ch]; cst[5 * 64 + lane] = P->in[I_GAB][ch]; cst[6 * 64 + lane] = P->in[I_GXB][ch];
        cst[7 * 64 + lane] = -log1pf(__expf(-P->in[I_LAM][ch]));
    }
    __builtin_amdgcn_sched_barrier(0);
    bf16x8 wa[4][2], wx[4][2];
#pragma unroll
    for (int dt = 0; dt < 4; ++dt)
#pragma unroll
        for (int kk = 0; kk < 2; ++kk) { wa[dt][kk] = *(const bf16x8*)(WA + (16 * dt + fr) * 64 + 32 * kk + 8 * fq); wx[dt][kk] = *(const bf16x8*)(WX + (16 * dt + fr) * 64 + 32 * kk + 8 * fq); }
    f32x4 Pc[4], Hc[4];
#pragma unroll
    for (int dt = 0; dt < 4; ++dt) { Pc[dt] = (f32x4){1.f, 1.f, 1.f, 1.f}; Hc[dt] = (f32x4){0.f, 0.f, 0.f, 0.f}; }
    const int segm = smp ? 7 : 15;
#pragma unroll 1
    for (int tt = 0; tt < 4; ++tt) {
        const int ti = 16 * tt + fr, R = T0 + ti;
        const int trow = smp ? (ti >> 3) * 11 + (ti & 7) : ti;
        f32x4 xc[4];
#pragma unroll
        for (int dt = 0; dt < 4; ++dt) {
            const int cl = 16 * dt + 4 * fq;
            f32x4 a = *(const LAS f32x4*)(cst + 4 * 64 + cl);
#pragma unroll
            for (int j = 0; j < 4; ++j) a += *(const LAS f32x4*)(cst + j * 64 + cl) * bf4_to_f4(*(const LAS u32x2*)(wl + (trow + j) * TLP + 2 * cl));
            xc[dt] = a;
        }
        bf16x8 bfr[2];
#pragma unroll
        for (int kk = 0; kk < 2; ++kk) { u32x4 pw; pw.x = pk2(xc[2 * kk][0], xc[2 * kk][1]); pw.y = pk2(xc[2 * kk][2], xc[2 * kk][3]); pw.z = pk2(xc[2 * kk + 1][0], xc[2 * kk + 1][1]); pw.w = pk2(xc[2 * kk + 1][2], xc[2 * kk + 1][3]); bfr[kk] = __builtin_bit_cast(bf16x8, pw); }
#pragma unroll
        for (int dt = 0; dt < 4; ++dt) {
            const int cl = 16 * dt + 4 * fq, ch = 64 * n + cl;
            f32x4 ra = (f32x4){0.f, 0.f, 0.f, 0.f}, ia = (f32x4){0.f, 0.f, 0.f, 0.f};
            ra = __builtin_amdgcn_mfma_f32_16x16x32_bf16(wa[dt][0], bfr[0], ra, 0, 0, 0); ra = __builtin_amdgcn_mfma_f32_16x16x32_bf16(wa[dt][1], bfr[1], ra, 0, 0, 0);
            ia = __builtin_amdgcn_mfma_f32_16x16x32_bf16(wx[dt][0], bfr[0], ia, 0, 0, 0); ia = __builtin_amdgcn_mfma_f32_16x16x32_bf16(wx[dt][1], bfr[1], ia, 0, 0, 0);
            const f32x4 ba = *(const LAS f32x4*)(cst + 5 * 64 + cl), bx = *(const LAS f32x4*)(cst + 6 * 64 + cl), ls = *(const LAS f32x4*)(cst + 7 * 64 + cl);
            f32x4 A, B;
#pragma unroll
            for (int i = 0; i < 4; ++i) {
                const float r = fsigmoid(ra[i] + ba[i]), ig = fsigmoid(ia[i] + bx[i]);
                const float a = fexp2(11.541560327111707f * r * ls[i]);
                A[i] = a; B[i] = __builtin_amdgcn_sqrtf(fmaxf(1.0f - a * a, 0.f)) * ig * xc[dt][i];
            }
#pragma unroll
            for (int off = 1; off < 16; off <<= 1) {
                if (off == 8 && smp) break;
                const bool cnd = (fr & segm) >= off;
#pragma unroll
                for (int i = 0; i < 4; ++i) {
                    const float ap = dpp_row_shr(A[i], off), bp = dpp_row_shr(B[i], off);
                    if (cnd) { B[i] = A[i] * bp + B[i]; A[i] = A[i] * ap; }
                }
            }
            const f32x4 h = B + A * Hc[dt], p = A * Pc[dt];
            *(f32x4*)(HL + (size_t)R * 384 + ch) = h; *(f32x4*)(PC + (size_t)R * 384 + ch) = p;
            if (!smp) {
#pragma unroll
                for (int i = 0; i < 4; ++i) { Hc[dt][i] = __shfl(h[i], (lane & 48) | 15); Pc[dt][i] = __shfl(p[i], (lane & 48) | 15); }
            }
        }
    }
    if (!smp && fr == 0) {
#pragma unroll
        for (int dt = 0; dt < 4; ++dt) {
            const int ch = 64 * n + 16 * dt + 4 * fq;
            *(f32x4*)((float*)(P->ws + WS_CA) + (size_t)c64 * 384 + ch) = Pc[dt]; *(f32x4*)((float*)(P->ws + WS_CH) + (size_t)c64 * 384 + ch) = Hc[dt];
        }
    }
}

__device__ __forceinline__ void rglru_fix_task(KP P, int l, int task, LAS unsigned char* lds) {
    const int tid = opaque_tid(), c = task / 3, cg_ = task - 3 * c, chl = tid & 127, seg = tid >> 7, ch = 128 * cg_ + chl;
    const float* CA = (const float*)(P->ws + WS_CA); const float* CH = (const float*)(P->ws + WS_CH);
    const float* HL = (const float*)(P->ws + WS_HL); const float* PC = (const float*)(P->ws + WS_PC);
    const bf16_t* PJ = (const bf16_t*)(P->ws + WS_PJ); bf16_t* MIX = (bf16_t*)(P->ws + WS_MIX);
    LAS float* sA = (LAS float*)lds; LAS float* sH = sA + 512;
    const int T0 = c * 64 + seg * 16;
    float hl[16], pc[16]; unsigned short gg[16];
#pragma unroll
    for (int i = 0; i < 16; ++i) { const int R = T0 + i; hl[i] = HL[(size_t)R * 384 + ch]; pc[i] = PC[(size_t)R * 384 + ch]; gg[i] = PJ[(size_t)R * PJP + C_GT + ch]; }
    float carry = 0.f;
    {
        const int q = (c + 3) >> 2, k0 = seg * q, k1 = (k0 + q) < c ? (k0 + q) : c;
        float a = 1.f, h = 0.f;
        for (int kb_ = k0; kb_ < k1; kb_ += 32) {
            float ak[32], hk[32];
#pragma unroll
            for (int u_ = 0; u_ < 32; ++u_) { const int k = (kb_ + u_) < k1 ? (kb_ + u_) : (k1 - 1); ak[u_] = CA[(size_t)k * 384 + ch]; hk[u_] = CH[(size_t)k * 384 + ch]; }
#pragma unroll
            for (int u_ = 0; u_ < 32; ++u_) if (kb_ + u_ < k1) { h = ak[u_] * h + hk[u_]; a *= ak[u_]; }
        }
        sA[seg * 128 + chl] = a; sH[seg * 128 + chl] = h;
        __syncthreads();
#pragma unroll
        for (int s = 0; s < 4; ++s) carry = sA[s * 128 + chl] * carry + sH[s * 128 + chl];
    }
#pragma unroll
    for (int i = 0; i < 16; ++i) {
        const int R = T0 + i;
        const float h = hl[i] + pc[i] * carry;
        const float g = __uint_as_float((unsigned)gg[i] << 16);
        const float y = h * gelu_tanh(g);
        MIX[(size_t)R * DM + 640 + ch] = (bf16_t)(pk2(y, 0.f) & 0xffffu);
        if (R == SEQ - 1) P->out[OFF_PRG + l * 384 + ch] = h;
    }
    __syncthreads();
}
__device__ __forceinline__ void rglru_fix_sample(KP P, int l) {
    const int gt = blockIdx.x * 512 + opaque_tid();
    if (gt >= NSMP * 384) return;
    const int si = gt / 384, ch = gt - si * 384, R = SEQ + si, b = si >> 3;
    const float h = ((const float*)(P->ws + WS_HL))[(size_t)R * 384 + ch] + ((const float*)(P->ws + WS_PC))[(size_t)R * 384 + ch] * P->in[I_SRG][((size_t)l * 32 + b) * 384 + ch];
    const float g = __uint_as_float((unsigned)((const bf16_t*)(P->ws + WS_PJ))[(size_t)R * PJP + C_GT + ch] << 16);
    ((bf16_t*)(P->ws + WS_MIX))[(size_t)R * DM + 640 + ch] = (bf16_t)(pk2(h * gelu_tanh(g), 0.f) & 0xffffu);
    if ((si & 7) == 7) P->out[OFF_SRG + ((size_t)l * 32 + b) * 384 + ch] = h;
}

__device__ __forceinline__ s16x4 vtr(const LAS unsigned char* p) { return __builtin_bit_cast(s16x4, __builtin_amdgcn_ds_read_tr16_b64_v4i16((LAS s16x4*)p)); }

constexpr int VRP = 144;
constexpr int ATT_STEPS = 23;
__device__ __forceinline__ void att_step_info(int st, int& sh, int& s) { const int a = st >= 12, b = st >= 18; sh = 2 * (a + b); s = st - 12 * a - 6 * b; }

struct AttKV { bf16x8 k[2][2]; u32x4 v[4]; };
__device__ __forceinline__ void att_load(AttKV& b, int st, int p0, int fr, int lane, const bf16_t* Kb, const bf16_t* Vb) {
    int sh, s; att_step_info(st, sh, s);
    const int kbase = p0 - (128 << sh);
#pragma unroll
    for (int kt = 0; kt < 2; ++kt) { int pk = kbase + ((32 * s + 16 * kt + fr) << sh); pk = pk < 0 ? 0 : (pk > MT - 1 ? MT - 1 : pk);
        b.k[kt][0] = *(const bf16x8*)(Kb + (size_t)pk * PJP); b.k[kt][1] = *(const bf16x8*)(Kb + (size_t)pk * PJP + 32); }
    int pv = kbase + ((32 * s + (lane >> 1)) << sh); pv = pv < 0 ? 0 : (pv > MT - 1 ? MT - 1 : pv);
#pragma unroll
    for (int i = 0; i < 4; ++i) b.v[i] = *(const u32x4*)(Vb + (size_t)pv * PJP + 8 * i);
}
__device__ __forceinline__ void att_compute(const AttKV& b, int st, int p0, int fr, int fq, const bf16x8 qf0, const bf16x8 qf1, float& m, float& lsum, f32x4 (&o)[4],
                                            LAS unsigned char* vw, const LAS unsigned char* vr) {
    int sh, s; att_step_info(st, sh, s);
    const int kbase = p0 - (128 << sh);
    f32x4 sc[2];
#pragma unroll
    for (int kt = 0; kt < 2; ++kt) {
        sc[kt] = __builtin_amdgcn_mfma_f32_16x16x32_bf16(b.k[kt][0], qf0, (f32x4){0.f, 0.f, 0.f, 0.f}, 0, 0, 0);
        sc[kt] = __builtin_amdgcn_mfma_f32_16x16x32_bf16(b.k[kt][1], qf1, sc[kt], 0, 0, 0);
    }
    const int e0 = ((16 >> sh) * fr) + 128 - (32 * s + 4 * fq);
    const unsigned emax = (unsigned)min(128, (p0 + 16 * fr) >> sh);
    float mx = -INFINITY;
#pragma unroll
    for (int kt = 0; kt < 2; ++kt)
#pragma unroll
        for (int i = 0; i < 4; ++i) {
            const bool ok = (unsigned)(e0 - 16 * kt - i) <= emax;
            sc[kt][i] = ok ? sc[kt][i] : -INFINITY;
            mx = fmaxf(mx, sc[kt][i]);
        }
    {
        const auto r16 = __builtin_amdgcn_permlane16_swap(__float_as_uint(mx), __float_as_uint(mx), false, false);
        mx = fmaxf(__uint_as_float(r16[0]), __uint_as_float(r16[1]));
        const auto r32 = __builtin_amdgcn_permlane32_swap(__float_as_uint(mx), __float_as_uint(mx), false, false);
        mx = fmaxf(__uint_as_float(r32[0]), __uint_as_float(r32[1]));
    }
    const float mn = fmaxf(m, mx), al = fexp2(m - mn);
    m = mn;
    float ps = 0.f;
#pragma unroll
    for (int kt = 0; kt < 2; ++kt)
#pragma unroll
        for (int i = 0; i < 4; ++i) { sc[kt][i] = fexp2(sc[kt][i] - mn); ps += sc[kt][i]; }
    lsum = lsum * al + ps;
    u32x4 pw; pw.x = pk2(sc[0][0], sc[0][1]); pw.y = pk2(sc[0][2], sc[0][3]); pw.z = pk2(sc[1][0], sc[1][1]); pw.w = pk2(sc[1][2], sc[1][3]);
    const bf16x8 pb8 = __builtin_bit_cast(bf16x8, pw);
#pragma unroll
    for (int i = 0; i < 4; ++i) *(LAS u32x4*)(vw + 16 * i) = b.v[i];
#pragma unroll
    for (int dt = 0; dt < 4; ++dt) {
        const s16x4 lo = vtr(vr + dt * 32), hi = vtr(vr + 16 * VRP + dt * 32);
        const bf16x8 vf = __builtin_shufflevector(lo, hi, 0, 1, 2, 3, 4, 5, 6, 7);
        o[dt] = o[dt] * al;
        o[dt] = __builtin_amdgcn_mfma_f32_16x16x32_bf16(vf, pb8, o[dt], 0, 0, 0);
    }
}

constexpr int CPY_SEG = 2040 * 384 / 4, CPY_KV = 32 * CPY_SEG, CPY_TOT = 2 * CPY_KV;
__device__ __forceinline__ void cpy_addr(KP P, int l, int i, const f32x4*& src, f32x4*& dst) {
    const int kv = i >= CPY_KV, r = i - kv * CPY_KV, b = r / CPY_SEG, off = r - b * CPY_SEG;
    const float* ck_ = P->in[I_CK]; const float* cv_ = P->in[I_CV];
    src = (const f32x4*)((kv ? cv_ : ck_) + (((size_t)l * 32 + b) * 2048 + 8) * 384) + off;
    dst = (f32x4*)(P->out + (kv ? OFF_SWV : OFF_SWK) + ((size_t)l * 32 + b) * 2048 * 384) + off;
}
constexpr int CPY_R1 = (int)(0.45 * CPY_TOT) & ~63, CPY_R2 = (int)(0.65 * CPY_TOT) & ~63;
__device__ __forceinline__ void copy_range(KP P, int l, int lo, int hi, int part, int nparts) {
    for (int i0 = lo + part; i0 < hi; i0 += 8 * nparts) {
        f32x4 v[8];
#pragma unroll
        for (int u = 0; u < 8; ++u) { const int i = i0 + u * nparts; if (i < hi) { const f32x4* sp; f32x4* dp; cpy_addr(P, l, i, sp, dp); v[u] = __builtin_nontemporal_load(sp); } }
#pragma unroll
        for (int u = 0; u < 8; ++u) { const int i = i0 + u * nparts; if (i < hi) { const f32x4* sp; f32x4* dp; cpy_addr(P, l, i, sp, dp); __builtin_nontemporal_store(v[u], dp); } }
    }
}
__device__ __forceinline__ void attn_tile(KP P, int l, int wt, int gw, int NGW, int tk, int lane, LAS unsigned char* vl) {
    const int r = wt & 15, hh = (wt >> 4) % 6, pb = wt / 96, p0 = pb * 256 + r, fr = lane & 15, fq = lane >> 4;
    const bf16_t* PJ = (const bf16_t*)(P->ws + WS_PJ); bf16_t* MIX = (bf16_t*)(P->ws + WS_MIX);
    __builtin_amdgcn_s_waitcnt(0);
    const bf16_t* qp = PJ + (size_t)(p0 + 16 * fr) * PJP + C_Q + 64 * hh + 8 * fq;
    const bf16x8 qf0 = *(const bf16x8*)qp, qf1 = *(const bf16x8*)(qp + 32);
    const bf16_t* Kb = PJ + C_K + 64 * hh + 8 * fq;
    const bf16_t* Vb = PJ + C_V + 64 * hh + 32 * (lane & 1);
    float m = -1e30f, lsum = 0.f;
    f32x4 o[4];
#pragma unroll
    for (int dt = 0; dt < 4; ++dt) o[dt] = (f32x4){0.f, 0.f, 0.f, 0.f};
    LAS unsigned char* vw = vl + (lane >> 1) * VRP + (lane & 1) * 64;
    const LAS unsigned char* vr = vl + (4 * fq + (fr >> 2)) * VRP + (fr & 3) * 8;
    AttKV b0, b1, b2;
    att_load(b0, 0, p0, fr, lane, Kb, Vb); att_load(b1, 1, p0, fr, lane, Kb, Vb);
#pragma unroll 1
    for (int st = 0; st < 21; st += 3) {
        att_load(b2, st + 2, p0, fr, lane, Kb, Vb);
        att_compute(b0, st, p0, fr, fq, qf0, qf1, m, lsum, o, vw, vr);
        att_load(b0, st + 3, p0, fr, lane, Kb, Vb);
        att_compute(b1, st + 1, p0, fr, fq, qf0, qf1, m, lsum, o, vw, vr);
        att_load(b1, st + 4, p0, fr, lane, Kb, Vb);
        att_compute(b2, st + 2, p0, fr, fq, qf0, qf1, m, lsum, o, vw, vr);
    }
    att_compute(b0, 21, p0, fr, fq, qf0, qf1, m, lsum, o, vw, vr);
    att_compute(b1, 22, p0, fr, fq, qf0, qf1, m, lsum, o, vw, vr);
    lsum += __shfl_xor(lsum, 16); lsum += __shfl_xor(lsum, 32);
    const float inv = 1.0f / lsum;
    bf16_t* op = MIX + (size_t)(p0 + 16 * fr) * DM + 64 * hh + 4 * fq;
#pragma unroll
    for (int dt = 0; dt < 4; ++dt) *(u32x2*)(op + 16 * dt) = f4_to_bf4(o[dt] * inv);
}

__device__ __forceinline__ void sattn_block_task(KP P, int l, int task, LAS unsigned char* lds) {
    const int tid = opaque_tid(), lane = tid & 63, wave = tid >> 6, l32 = lane & 31, half = lane >> 5;
    const int b = task >> 3, t = task & 7, row = SEQ + task;
    const bf16_t* PJ = (const bf16_t*)(P->ws + WS_PJ); bf16_t* MIX = (bf16_t*)(P->ws + WS_MIX);
    f32x4 q[3];
#pragma unroll
    for (int i = 0; i < 3; ++i) q[i] = bf4_to_f4(*(const u32x2*)(PJ + (size_t)row * PJP + C_Q + 4 * (l32 + 32 * i)));
    const float* ck = P->in[I_CK] + ((size_t)l * 32 + b) * 2048 * 384 + 4 * l32;
    const float* cv = P->in[I_CV] + ((size_t)l * 32 + b) * 2048 * 384 + 4 * l32;
    const float* sk = P->out + OFF_SWK + ((size_t)l * 32 + b) * 2048 * 384 + 4 * l32;
    const float* sv = P->out + OFF_SWV + ((size_t)l * 32 + b) * 2048 * 384 + 4 * l32;
    float m[3], ls[3]; f32x4 o[3];
#pragma unroll
    for (int i = 0; i < 3; ++i) { m[i] = -1e30f; ls[i] = 0.f; o[i] = (f32x4){0.f, 0.f, 0.f, 0.f}; }
    const int slot = 2 * wave + half;
#pragma unroll 1
    for (int it0 = 0; it0 < 28; it0 += 4) {
        f32x4 kr[4][3], vr[4][3];
#pragma unroll
        for (int u = 0; u < 4; ++u) {
            const int kk = (it0 + u) * 16 + slot, kc = kk < 387 ? kk : 386;
            const int pat = kc >= 258 ? 2 : (kc >= 129 ? 1 : 0), j = kc - 129 * pat, idx = 2048 + t - (j << (2 * pat));
            const float* kp = idx < 2048 ? ck + (size_t)idx * 384 : sk + (size_t)(idx - 8) * 384;
            const float* vp = idx < 2048 ? cv + (size_t)idx * 384 : sv + (size_t)(idx - 8) * 384;
#pragma unroll
            for (int i = 0; i < 3; ++i) { kr[u][i] = *(const f32x4*)(kp + 128 * i); vr[u][i] = *(const f32x4*)(vp + 128 * i); }
        }
#pragma unroll
        for (int u = 0; u < 4; ++u) {
            const bool valid = (it0 + u) * 16 + slot < 387;
#pragma unroll
            for (int i = 0; i < 3; ++i) {
                float sc = (q[i][0] * kr[u][i][0] + q[i][1] * kr[u][i][1]) + (q[i][2] * kr[u][i][2] + q[i][3] * kr[u][i][3]);
                sc += __shfl_xor(sc, 1); sc += __shfl_xor(sc, 2); sc += __shfl_xor(sc, 4); sc += __shfl_xor(sc, 8);
                if (!valid) sc = -INFINITY;
                const float mn = fmaxf(m[i], sc), al = fexp2(m[i] - mn), p = fexp2(sc - mn);
                ls[i] = ls[i] * al + p; o[i] = o[i] * al + vr[u][i] * p; m[i] = mn;
            }
        }
    }
    LAS float* part = (LAS float*)lds;
#pragma unroll
    for (int i = 0; i < 3; ++i) {
        const float mo = __shfl_xor(m[i], 32), lo = __shfl_xor(ls[i], 32);
        f32x4 oo;
#pragma unroll
        for (int e = 0; e < 4; ++e) oo[e] = __shfl_xor(o[i][e], 32);
        const float M = fmaxf(m[i], mo), a0 = fexp2(m[i] - M), a1 = fexp2(mo - M);
        const float L = ls[i] * a0 + lo * a1; const f32x4 O = o[i] * a0 + oo * a1;
        if (half == 0) { LAS float* d = part + ((wave * 96) + l32 + 32 * i) * 6; d[0] = M; d[1] = L; d[2] = O[0]; d[3] = O[1]; d[4] = O[2]; d[5] = O[3]; }
    }
    __syncthreads();
    if (tid < 96) {
        float M = -1e30f;
#pragma unroll
        for (int w = 0; w < 8; ++w) M = fmaxf(M, part[(w * 96 + tid) * 6]);
        float L = 0.f; f32x4 O = (f32x4){0.f, 0.f, 0.f, 0.f};
#pragma unroll
        for (int w = 0; w < 8; ++w) { const LAS float* d = part + (w * 96 + tid) * 6; const float a = fexp2(d[0] - M); L += d[1] * a; O += (f32x4){d[2], d[3], d[4], d[5]} * a; }
        *(u32x2*)(MIX + (size_t)row * DM + 4 * tid) = f4_to_bf4(O * (1.0f / L));
    }
    __syncthreads();
}

__device__ __forceinline__ void p2_copy(KP P, int l, int wave, int lane) {
    constexpr int PER_B = ((CPY_TOT - CPY_R2) / 256 + 63) & ~63;
    const int cum0 = wave < 2 ? 2 * wave : (wave < 6 ? 4 + 5 * (wave - 2) : 24 + 8 * (wave - 6));
    const int cum1 = wave < 2 ? cum0 + 2 : (wave < 6 ? cum0 + 5 : cum0 + 8);
    const int base = CPY_R2 + (int)blockIdx.x * PER_B;
    int lo = base + ((PER_B / 64 * cum0 / 40) * 64), hi = base + ((PER_B / 64 * cum1 / 40) * 64);
    if (wave == 7) hi = base + PER_B;
    lo = lo < CPY_TOT ? lo : CPY_TOT; hi = hi < CPY_TOT ? hi : CPY_TOT;
    copy_range(P, l, lo, hi, lane, 64);
}

__device__ __forceinline__ void phase2(KP P, int l, LAS unsigned char* lds) {
    const int tid = opaque_tid(), lane = tid & 63, wave = tid >> 6;
    const int gw = blockIdx.x * 8 + wave, NGW = gridDim.x * 8;
    const int gt = blockIdx.x * 512 + tid, NGT = gridDim.x * 512;
    constexpr int NT_R = NCH * 6, NT_P = NCH * 4;
    LAS unsigned char* wl = lds + wave * 16384;
    if (wave < 4) { int ln = lane; asm volatile("" : "+v"(ln)); for (int t = blockIdx.x + gridDim.x * wave; t < NT_R + NT_P; t += NGW) { if (t < NT_R) rglru_local_task(P, l, t, ln, wl); else pool_task(P, l, t - NT_R, ln, wl); }
        p2_copy(P, l, wave, ln); }
    {
        int ln = lane; asm volatile("" : "+v"(ln));
        const int xcd = blockIdx.x & 7, jw = (blockIdx.x >> 3) * 8 + wave;
#pragma unroll 1
        for (int tk = 0; tk < 3; ++tk) attn_tile(P, l, 768 * xcd + 256 * tk + jw, gw, NGW, tk, ln, wl);
    }
    if (wave >= 4) { int ln = lane; asm volatile("" : "+v"(ln)); for (int t = blockIdx.x + gridDim.x * wave; t < NT_R + NT_P; t += NGW) { if (t < NT_R) rglru_local_task(P, l, t, ln, wl); else pool_task(P, l, t - NT_R, ln, wl); }
        p2_copy(P, l, wave, ln); }
    {
        const bf16_t* PJ = (const bf16_t*)(P->ws + WS_PJ); float* out = P->out;
        for (int i = gt; i < 2048 * 192; i += NGT) {
            const int r = i / 192, c4 = (i - r * 192) * 4, kv = c4 >= 384, c = c4 - 384 * kv;
            *(f32x4*)(out + (kv ? OFF_PWV : OFF_PWK) + ((size_t)l * 2048 + r) * 384 + c) = bf4_to_f4(*(const u32x2*)(PJ + (size_t)(SEQ - 2048 + r) * PJP + C_K + c4));
        }
        for (int i = gt; i < 256 * 192; i += NGT) {
            const int si = i / 192, c4 = (i - si * 192) * 4, kv = c4 >= 384, c = c4 - 384 * kv;
            *(f32x4*)(out + (kv ? OFF_SWV : OFF_SWK) + (((size_t)l * 32 + (si >> 3)) * 2048 + 2040 + (si & 7)) * 384 + c) = bf4_to_f4(*(const u32x2*)(PJ + (size_t)(SEQ + si) * PJP + C_K + c4));
        }
        for (int i = gt; i < 15 * 64; i += NGT) {
            const int r = i >> 6, c = (i & 63) * 4;
            *(f32x4*)(out + OFF_PPOOL + ((size_t)l * 15 + r) * 256 + c) = bf4_to_f4(*(const u32x2*)(PJ + (size_t)(SEQ - 15 + r) * PJP + C_U + c));
        }
        for (int i = gt; i < 256 * 64; i += NGT) {
            const int si = i >> 6, c = (i & 63) * 4;
            *(f32x4*)(out + OFF_SPOOL + (((size_t)l * 32 + (si >> 3)) * 15 + 7 + (si & 7)) * 256 + c) = bf4_to_f4(*(const u32x2*)(PJ + (size_t)(SEQ + si) * PJP + C_U + c));
        }
        for (int i = gt; i < 3 * 96; i += NGT) {
            const int r = i / 96, c = (i - r * 96) * 4;
            *(f32x4*)(out + OFF_PCONV + ((size_t)l * 3 + r) * 384 + c) = bf4_to_f4(*(const u32x2*)(PJ + (size_t)(SEQ - 3 + r) * PJP + C_XR + c));
        }
        for (int i = gt; i < 32 * 3 * 96; i += NGT) {
            const int br = i / 96, c = (i - br * 96) * 4, b = br / 3, r = br - 3 * b;
            *(f32x4*)(out + OFF_SCONV + (((size_t)l * 32 + b) * 3 + r) * 384 + c) = bf4_to_f4(*(const u32x2*)(PJ + (size_t)(SEQ + 8 * b + 5 + r) * PJP + C_XR + c));
        }
    }
    for (int i = gt; i < 32 * 7 * 256; i += NGT) {
        const int b = i / 1792, rem = i - b * 1792;
        P->out[OFF_SPOOL + ((size_t)l * 32 + b) * 15 * 256 + rem] = P->in[I_SPOOL][((size_t)l * 32 + b) * 15 * 256 + 8 * 256 + rem];
    }
}

__device__ __forceinline__ void phase3(KP P, int l, LAS unsigned char* lds) {
    const int tid = opaque_tid(), lane = tid & 63, wave = tid >> 6;
    const int gw = blockIdx.x * 8 + wave, NGW = gridDim.x * 8;
    rglru_fix_sample(P, l);
    for (int t = blockIdx.x; t < 256 * 3; t += gridDim.x) rglru_fix_task(P, l, t, lds);
    for (int t = blockIdx.x; t < NSMP; t += gridDim.x) sattn_block_task(P, l, (t & 7) * (NSMP >> 3) + (t >> 3), lds);
}

template <int K>
__device__ __forceinline__ void sample_proj(const bf16_t* A, const bf16_t* Bt, const float* base_s, float* X, bf16_t* XB, float* rss_out, LAS unsigned char* lds) {
    const int tid = opaque_tid(), lane = tid & 63, wave = tid >> 6, fr = lane & 15, fq = lane >> 4;
    const int rg = blockIdx.x >> 4, cg_ = blockIdx.x & 15;
    if (blockIdx.x >= 256) return;
    constexpr int KS = K / 8, NK = KS / 32;
    const bf16_t* ap = A + (size_t)(SEQ + 16 * rg + fr) * K + wave * KS + 8 * fq;
    const bf16_t* bp = Bt + (size_t)(64 * cg_ + fr) * K + wave * KS + 8 * fq;
    f32x4 acc[4];
#pragma unroll
    for (int ct = 0; ct < 4; ++ct) acc[ct] = (f32x4){0.f, 0.f, 0.f, 0.f};
#pragma unroll 1
    for (int k0 = 0; k0 < NK; k0 += 4) {
        bf16x8 af[4], bf[4][4];
#pragma unroll
        for (int u = 0; u < 4; ++u) { const int ks = (k0 + u) < NK ? (k0 + u) : (NK - 1); af[u] = *(const bf16x8*)(ap + 32 * ks);
#pragma unroll
            for (int ct = 0; ct < 4; ++ct) bf[u][ct] = *(const bf16x8*)(bp + (size_t)(16 * ct) * K + 32 * ks); }
#pragma unroll
        for (int u = 0; u < 4; ++u) if (k0 + u < NK) {
#pragma unroll
            for (int ct = 0; ct < 4; ++ct) acc[ct] = __builtin_amdgcn_mfma_f32_16x16x32_bf16(bf[u][ct], af[u], acc[ct], 0, 0, 0);
        }
    }
    LAS f32x4* red = (LAS f32x4*)lds;
#pragma unroll
    for (int ct = 0; ct < 4; ++ct) red[(wave * 4 + ct) * 64 + lane] = acc[ct];
    __syncthreads();
    if (wave < 4) {
        f32x4 sacc = (f32x4){0.f, 0.f, 0.f, 0.f};
#pragma unroll
        for (int w = 0; w < 8; ++w) sacc += red[(w * 4 + wave) * 64 + lane];
        const int row = 16 * rg + fr, col = 64 * cg_ + 16 * wave + 4 * fq;
        const f32x4 x = *(const f32x4*)(base_s + (size_t)row * DM + col) + sacc;
        *(f32x4*)(X + (size_t)(SEQ + row) * DM + col) = x;
        *(u32x2*)(XB + (size_t)(SEQ + row) * DM + col) = f4_to_bf4(x);
        float ss = (x[0] * x[0] + x[1] * x[1]) + (x[2] * x[2] + x[3] * x[3]);
        ss += __shfl_xor(ss, 16); ss += __shfl_xor(ss, 32);
        if (fq == 0) unsafeAtomicAdd(rss_out + SEQ + row, ss);
    }
    __syncthreads();
}

__device__ __forceinline__ void final_norm(KP P) {
    const int tid = opaque_tid(), lane = tid & 63, wave = tid >> 6;
    const int gw = blockIdx.x * 8 + wave, NGW = gridDim.x * 8;
    const bf16_t* XB = (const bf16_t*)(P->ws + WS_XB); const float* rss = (const float*)(P->ws + WS_RSS) + 4 * MT;
    const f32x4 g0 = *(const f32x4*)(P->in[I_FING] + 8 * lane), g1 = *(const f32x4*)(P->in[I_FING] + 8 * lane + 4), g2 = *(const f32x4*)(P->in[I_FING] + 512 + 8 * lane), g3 = *(const f32x4*)(P->in[I_FING] + 512 + 8 * lane + 4);
    for (int row0 = gw; row0 < MT; row0 += 4 * NGW) {
        u32x4 v[4][2]; float rs[4];
#pragma unroll
        for (int r = 0; r < 4; ++r) { const int row = row0 + r * NGW; if (row < MT) { v[r][0] = *(const u32x4*)(XB + (size_t)row * DM + 8 * lane); v[r][1] = *(const u32x4*)(XB + (size_t)row * DM + 512 + 8 * lane); rs[r] = rsqrtf(rss[row] * (1.0f / DM) + EPS); } }
#pragma unroll
        for (int r = 0; r < 4; ++r) { const int row = row0 + r * NGW; if (row < MT) {
            float* o = P->out + (size_t)row * DM + 8 * lane;
            *(f32x4*)o = (f32x4){bf_lo(v[r][0].x), bf_hi(v[r][0].x), bf_lo(v[r][0].y), bf_hi(v[r][0].y)} * rs[r] * g0;
            *(f32x4*)(o + 4) = (f32x4){bf_lo(v[r][0].z), bf_hi(v[r][0].z), bf_lo(v[r][0].w), bf_hi(v[r][0].w)} * rs[r] * g1;
            *(f32x4*)(o + 512) = (f32x4){bf_lo(v[r][1].x), bf_hi(v[r][1].x), bf_lo(v[r][1].y), bf_hi(v[r][1].y)} * rs[r] * g2;
            *(f32x4*)(o + 516) = (f32x4){bf_lo(v[r][1].z), bf_hi(v[r][1].z), bf_lo(v[r][1].w), bf_hi(v[r][1].w)} * rs[r] * g3; } }
    }
}

#define XB_TMO      128
#define XB_XCNT(j)  (256  + 64 * (j))
#define XB_XSUB(j)  (1280 + 64 * (j))
#define XB_XGEN(j)  (2304 + 64 * (j))
#define XB_TOP      3328
#define XB_TOPGEN   3392
#define XCD_BAR_WORDS 3456
#define XB_SPIN_CAP (1u << 18)

__device__ __forceinline__ unsigned xb_ld(unsigned* p)              { return __hip_atomic_load(p, __ATOMIC_RELAXED, __HIP_MEMORY_SCOPE_AGENT); }
__device__ __forceinline__ unsigned xb_add(unsigned* p, unsigned v) { return __hip_atomic_fetch_add(p, v, __ATOMIC_RELAXED, __HIP_MEMORY_SCOPE_AGENT); }
__device__ __forceinline__ unsigned xb_xcc_id() { return (unsigned)__builtin_amdgcn_s_getreg((3 << 11) | 20) & 0xFu; }
#define XB_SPIN(cond, bar) do { unsigned _sp = 0; while (cond) { __builtin_amdgcn_s_sleep(1); \
    if ((++_sp & 255u) == 0u) { if (xb_ld(&(bar)[XB_TMO])) break; if (_sp > XB_SPIN_CAP) { atomicAdd(&(bar)[XB_TMO], 1u); break; } } } } while (0)

struct XcdBarrier {
    unsigned* bar; unsigned x;
    volatile LAS unsigned* st;
};

__device__ __forceinline__ XcdBarrier xcd_barrier_post(unsigned* bar, volatile LAS unsigned* st) {
    XcdBarrier b; b.bar = bar; b.x = (unsigned)__builtin_amdgcn_readfirstlane((int)xb_xcc_id()); b.st = st;
    if (threadIdx.x == 0) (void)xb_add(&bar[XB_XCNT(b.x)], 1u);
    return b;
}
__device__ __forceinline__ void xcd_barrier_complete(unsigned* bar, unsigned x, unsigned& nloc, unsigned& nx) {
    const unsigned G = gridDim.x * gridDim.y * gridDim.z;
    unsigned sum, cnt, mine, sp = 0u;
    for (;;) {
        sum = 0u; cnt = 0u; mine = 0u;
#pragma unroll
        for (unsigned j = 0; j < 16; ++j) { const unsigned c = xb_ld(&bar[XB_XCNT(j)]); sum += c; cnt += (c > 0u) ? 1u : 0u; mine = (j == x) ? c : mine; }
        if (sum == G) break;
        __builtin_amdgcn_s_sleep(1);
        if ((++sp & 255u) == 0u) { if (xb_ld(&bar[XB_TMO])) break; if (sp > XB_SPIN_CAP) { atomicAdd(&bar[XB_TMO], 1u); break; } }
    }
    nloc = mine > 0u ? mine : 1u; nx = cnt > 0u ? cnt : 1u;
}

__device__ __forceinline__ void xcd_barrier(const XcdBarrier& b) {
    unsigned bx_ = b.x; asm volatile("" : "+s"(bx_));
    asm volatile("s_waitcnt vmcnt(0)" ::: "memory");
    __syncthreads();
    if (threadIdx.x == 0) {
        unsigned* bar = b.bar; asm volatile("" : "+s"(bar));
        __builtin_amdgcn_s_waitcnt(0);
        unsigned nloc = b.st[0], nx = b.st[1];
        if (nloc == 0u) { xcd_barrier_complete(bar, bx_, nloc, nx); b.st[0] = nloc; b.st[1] = nx; }
        const unsigned old = xb_add(&bar[XB_XSUB(bx_)], 1u);
        const unsigned gen = old / nloc;
        if (old + 1u == (gen + 1u) * nloc) {
            __builtin_amdgcn_fence(__ATOMIC_RELEASE, "agent");
            asm volatile("s_waitcnt vmcnt(0)" ::: "memory");
            const unsigned og = xb_add(&bar[XB_TOP], 1u);
            const unsigned tg = og / nx;
            if (og + 1u == (tg + 1u) * nx) xb_add(&bar[XB_TOPGEN], 1u);
            else XB_SPIN(xb_ld(&bar[XB_TOPGEN]) == tg, bar);
            __builtin_amdgcn_fence(__ATOMIC_ACQUIRE, "agent");
            xb_add(&bar[XB_XGEN(bx_)], 1u);
            asm volatile("s_waitcnt vmcnt(0)" ::: "memory");
        } else {
            XB_SPIN(xb_ld(&bar[XB_XGEN(bx_)]) == gen, bar);
            __builtin_amdgcn_fence(__ATOMIC_ACQUIRE, "agent");
            asm volatile("s_waitcnt vmcnt(0)" ::: "memory");
        }
    }
    __syncthreads();
}

__global__ void __launch_bounds__(512) mega_fwd(Params Pval) {
    extern __shared__ __attribute__((aligned(16))) unsigned char lds_raw[];
    LAS unsigned char* lds = (LAS unsigned char*)lds_raw;
    cg::grid_group grid = cg::this_grid();
    if (Pval.ws == nullptr) grid.sync();
    volatile LAS unsigned* bst = (volatile LAS unsigned*)(lds + pg8::STAGE_BYTES);
    if (threadIdx.x < 2) bst[threadIdx.x] = 0u;
    __syncthreads();
    XcdBarrier bar = xcd_barrier_post((unsigned*)(Pval.ws + WS_BAR), bst);
    prologue(kargs(), lds);
    xcd_barrier(bar);
#pragma unroll 1
    for (int l = 0; l < 2; ++l) {
        {
            KP P = kargs(); unsigned char* ws = P->ws; float* rss = (float*)(ws + WS_RSS);
            pg8::Gemm g{(const bf16_t*)(ws + WS_XB), (const bf16_t*)(ws + WS_WIN) + (size_t)l * DINP * DM, MT, DINP, DM}; pg8::StaticOrder S; S.init(MT, DINP, gridDim.x, blockIdx.x);
            EpiInProj E{(bf16_t*)(ws + WS_PJ), rss + (size_t)(2 * l) * MT, (const float*)(ws + WS_ROPE)};
            pg8::gemm_phase<EpiInProj, pg8::StaticOrder, true, true>(lds, g, S, E);
            { const int nfull = (MT / 256) * (DINP / 256) % (int)gridDim.x; if ((int)blockIdx.x >= nfull) copy_range(P, l, 0, CPY_R1, ((int)blockIdx.x - nfull) * 512 + opaque_tid(), ((int)gridDim.x - nfull) * 512); }
        }
        xcd_barrier(bar);
        phase2(kargs(), l, lds);
        xcd_barrier(bar);
        phase3(kargs(), l, lds);
        xcd_barrier(bar);
        {
            KP P = kargs(); unsigned char* ws = P->ws; float* rss = (float*)(ws + WS_RSS); float* X = (float*)(ws + WS_X);
            pg8::Gemm g{(const bf16_t*)(ws + WS_MIX), (const bf16_t*)(ws + WS_WOUT) + (size_t)l * DM * DM, SEQ, DM, DM}; pg8::StaticOrder S; S.init(SEQ, DM, gridDim.x, blockIdx.x);
            EpiResid E{l == 0 ? P->in[I_XP] : X, l == 0 ? P->in[I_XS] : X + (size_t)SEQ * DM, X, (bf16_t*)(ws + WS_XB), rss + (size_t)(2 * l + 1) * MT, 1};
            pg8::gemm_phase<EpiResid, pg8::StaticOrder, true, true>(lds, g, S, E);
            sample_proj<DM>((const bf16_t*)(ws + WS_MIX), (const bf16_t*)(ws + WS_WOUT) + (size_t)l * DM * DM, l == 0 ? P->in[I_XS] : X + (size_t)SEQ * DM, X, (bf16_t*)(ws + WS_XB), rss + (size_t)(2 * l + 1) * MT, lds);
        }
        xcd_barrier(bar);
        {
            KP P = kargs(); unsigned char* ws = P->ws; float* rss = (float*)(ws + WS_RSS);
            pg8::Gemm g{(const bf16_t*)(ws + WS_XB), (const bf16_t*)(ws + WS_WGU) + (size_t)l * NGU * DM, MT, NGU, DM}; pg8::StaticOrder S; S.init(MT, NGU, gridDim.x, blockIdx.x);
            EpiGateUp E{(bf16_t*)(ws + WS_HB), rss + (size_t)(2 * l + 1) * MT};
            pg8::gemm_phase<EpiGateUp, pg8::StaticOrder, true, true>(lds, g, S, E);
            { const int nfull = (MT / 256) * (NGU / 256) % (int)gridDim.x; if ((int)blockIdx.x >= nfull) copy_range(P, l, CPY_R1, CPY_R2, ((int)blockIdx.x - nfull) * 512 + opaque_tid(), ((int)gridDim.x - nfull) * 512); }
        }
        xcd_barrier(bar);
        {
            KP P = kargs(); unsigned char* ws = P->ws; float* rss = (float*)(ws + WS_RSS); float* X = (float*)(ws + WS_X);
            pg8::Gemm g{(const bf16_t*)(ws + WS_HB), (const bf16_t*)(ws + WS_WDN) + (size_t)l * DM * DFF, SEQ, DM, DFF}; pg8::StaticOrder S; S.init(SEQ, DM, gridDim.x, blockIdx.x);
            EpiResid E{X, X + (size_t)SEQ * DM, X, (bf16_t*)(ws + WS_XB), rss + (size_t)(2 * l + 2) * MT, l == 0};
            pg8::gemm_phase<EpiResid, pg8::StaticOrder, true, true>(lds, g, S, E);
            sample_proj<DFF>((const bf16_t*)(ws + WS_HB), (const bf16_t*)(ws + WS_WDN) + (size_t)l * DM * DFF, X + (size_t)SEQ * DM, X, (bf16_t*)(ws + WS_XB), rss + (size_t)(2 * l + 2) * MT, lds);
        }
        xcd_barrier(bar);
    }
    final_norm(kargs());
}

constexpr int LDS_BYTES = pg8::STAGE_BYTES + 256;

extern "C" void kernel_launch(void* const* d_in, const int* in_sizes, int n_in, void* d_out, int out_size, void* d_ws, size_t ws_size, hipStream_t stream) {
    static int grid = 0;
    if (grid == 0) {
        if (n_in != 23 || (size_t)out_size != OUT_TOTAL || ws_size < WS_END) { fprintf(stderr, "kernel_launch: unexpected shapes (n_in %d out %d ws %zu need %zu)\n", n_in, out_size, ws_size, (size_t)WS_END); grid = -1; return; }
        int dev = 0, cus = 0, per_cu = 0;
        hipGetDevice(&dev); hipDeviceGetAttribute(&cus, hipDeviceAttributeMultiprocessorCount, dev);
        hipFuncSetAttribute((const void*)mega_fwd, hipFuncAttributeMaxDynamicSharedMemorySize, LDS_BYTES);
        hipOccupancyMaxActiveBlocksPerMultiprocessor(&per_cu, (const void*)mega_fwd, 512, LDS_BYTES);
        if (per_cu < 1) { fprintf(stderr, "kernel_launch: occupancy query says %d blocks/CU\n", per_cu); per_cu = 1; }
        grid = 256;
        (void)hipGetLastError();
    }
    if (grid < 0) return;
    if (hipMemsetAsync((unsigned char*)d_ws + WS_BAR, 0, 16384, stream) != hipSuccess) { fprintf(stderr, "kernel_launch: memset of the barrier words failed\n"); return; }
    Params p{};
    for (int i = 0; i < 23; ++i) p.in[i] = (const float*)d_in[i];
    p.out = (float*)d_out; p.ws = (unsigned char*)d_ws;
    void* args[] = {&p};
    hipError_t e = hipLaunchCooperativeKernel((const void*)mega_fwd, dim3(grid), dim3(512), args, LDS_BYTES, stream);
    if (e != hipSuccess) fprintf(stderr, "cooperative launch failed: %s (grid %d)\n", hipGetErrorString(e), grid);
}
```
